# Optimizing an MI355X kernel written in HIP

```python
import math
import jax
import jax.numpy as jnp
from jax import lax
import numpy as np

D_MODEL = 1024
BATCH = 8
SEQ = 4096
DEPTH = 2

HEAD_DIM = 64
N_HEADS_A = 8
N_KV_A = 2
HPG_A = N_HEADS_A // N_KV_A
N_HEADS_B = 8
N_HEADS = N_HEADS_A + N_HEADS_B
WIDTH_A = N_HEADS_A * HEAD_DIM
WIDTH_B = N_HEADS_B * HEAD_DIM
MIX_WIDTH = WIDTH_A + WIDTH_B
KV_A = N_KV_A * HEAD_DIM
IN_SPLITS = (WIDTH_A, KV_A, KV_A, KV_A, KV_A, KV_A, KV_A, N_HEADS_A * 3, WIDTH_B, WIDTH_B, WIDTH_B)
IN_WIDTH = sum(IN_SPLITS)

CMP_LEN = 32
CMP_STRIDE = 16
CMP_HIDDEN = 256
SEL_BLOCK = 64
SEL_TOPK = 16
WIN_A = 512
NSA_QBLOCK = 64

DIL_PAIRS = ((128, 1), (512, 4), (2048, 16))

N_BUCKETS = 32
MAX_DISTANCE = 2048

D_FF = 2816
N_EXPERTS = 8
TOP_K = 2
D_FF_EXPERT = 3584
MOE_CHUNK = 256

RMS_EPS = 1e-6
NEG = -1e30
SCALE = HEAD_DIM ** -0.5

kernel_name = 'hymba_nsa_dilated_moe_trunk'


def rmsnorm(x, g):
    xf = x.astype(jnp.float32)
    y = xf * lax.rsqrt(jnp.mean(xf * xf, axis=-1, keepdims=True) + RMS_EPS)
    return (y * g.astype(jnp.float32)).astype(x.dtype)


def t5_bucket(dist):
    dist = jnp.maximum(dist, 0)
    max_exact = N_BUCKETS // 2
    scaled = jnp.log(jnp.maximum(dist, 1).astype(jnp.float32) / max_exact) / math.log(MAX_DISTANCE / max_exact)
    large = jnp.minimum(max_exact + (scaled * (N_BUCKETS - max_exact)).astype(jnp.int32), N_BUCKETS - 1)
    return jnp.where(dist < max_exact, dist, large)


def masked_softmax(s, mask):
    p = jax.nn.softmax(jnp.where(mask, s, NEG), axis=-1)
    return jnp.where(mask, p, 0.0)


def swiglu(h, w_gate, w_up, w_down):
    return (jax.nn.silu(h @ w_gate) * (h @ w_up)) @ w_down


def compress_tokens(kv, pos_emb, w1, b1, w2):
    B, S, G, dh = kv.shape
    n_cmp = (S - CMP_LEN) // CMP_STRIDE + 1
    idx = jnp.arange(n_cmp)[:, None] * CMP_STRIDE + jnp.arange(CMP_LEN)[None, :]
    blocks = kv[:, idx] + pos_emb[:, None, :]
    flat = blocks.transpose(0, 3, 1, 2, 4).reshape(B, G, n_cmp, CMP_LEN * dh)
    return jax.nn.gelu(flat @ w1 + b1) @ w2


def nsa_mixer(q, k_c, v_c, k_s, v_s, k_w, v_w, gate_logits, q_norm, k_norm,
              cmp_pos, cmp_w1, cmp_b1, cmp_w2, tbl):
    B, S = q.shape[0], q.shape[1]
    G, H, dh, QA = N_KV_A, HPG_A, HEAD_DIM, NSA_QBLOCK
    qh = rmsnorm(q, q_norm).reshape(B, S, G, H, dh).transpose(0, 2, 3, 1, 4)
    kc = rmsnorm(compress_tokens(k_c, cmp_pos[0], cmp_w1[0], cmp_b1[0], cmp_w2[0]), k_norm[0])
    vc = compress_tokens(v_c, cmp_pos[1], cmp_w1[1], cmp_b1[1], cmp_w2[1])
    n_cmp = kc.shape[2]
    n_sb = S // SEL_BLOCK
    ks = rmsnorm(k_s, k_norm[1]).reshape(B, n_sb, SEL_BLOCK, G, dh).transpose(0, 3, 1, 2, 4)
    vs = v_s.reshape(B, n_sb, SEL_BLOCK, G, dh).transpose(0, 3, 1, 2, 4)
    pad = ((0, 0), (0, 0), (WIN_A, 0), (0, 0))
    kw = jnp.pad(rmsnorm(k_w, k_norm[2]).transpose(0, 2, 1, 3), pad)
    vw = jnp.pad(v_w.transpose(0, 2, 1, 3), pad)
    gates = jax.nn.sigmoid(gate_logits.astype(jnp.float32)).reshape(B, S, G, H, 3).transpose(0, 2, 3, 1, 4)
    tbl_g = tbl.reshape(G, H, N_BUCKETS)

    c_start = jnp.arange(n_cmp)[:, None] * CMP_STRIDE
    s_start = jnp.arange(n_sb)[None, :] * SEL_BLOCK
    overlap = jnp.clip(jnp.minimum(c_start + CMP_LEN, s_start + SEL_BLOCK) - jnp.maximum(c_start, s_start), 0, None)
    overlap = overlap.astype(jnp.float32) / CMP_LEN
    c_end = jnp.arange(n_cmp) * CMP_STRIDE + CMP_LEN - 1
    blk_j = jnp.arange(n_sb)
    k_sel = min(SEL_TOPK, n_sb)
    b_ix = jnp.arange(B)[:, None, None, None]
    g_ix = jnp.arange(G)[None, :, None, None]
    g5 = jnp.arange(G)[None, :, None, None, None]
    h5 = jnp.arange(H)[None, None, :, None, None]

    def block(i):
        t0 = i * QA
        t = t0 + jnp.arange(QA)
        qi = lax.dynamic_slice_in_dim(qh, t0, QA, axis=3)
        dist_c = t[:, None] - c_end[None, :]
        bias_c = tbl[:, t5_bucket(dist_c)].reshape(G, H, QA, n_cmp)
        s_c = jnp.einsum('bghqd,bgnd->bghqn', qi, kc).astype(jnp.float32) * SCALE + bias_c
        p_c = masked_softmax(s_c, dist_c >= 0)
        o_c = jnp.einsum('bghqn,bgnd->bghqd', p_c, vc)
        imp = jnp.einsum('bghqn,nj->bgqj', p_c, overlap)
        cur = t // SEL_BLOCK
        forced = (blk_j[None, :] == 0) | (blk_j[None, :] == cur[:, None]) | (blk_j[None, :] == cur[:, None] - 1)
        future = blk_j[None, :] * SEL_BLOCK > t[:, None]
        imp = jnp.where(forced, 1e6, jnp.where(future, -1e6, imp))
        _, sel = lax.top_k(imp, k_sel)
        k_g = ks[b_ix, g_ix, sel].reshape(B, G, QA, k_sel * SEL_BLOCK, dh)
        v_g = vs[b_ix, g_ix, sel].reshape(B, G, QA, k_sel * SEL_BLOCK, dh)
        pos = (sel[..., None] * SEL_BLOCK + jnp.arange(SEL_BLOCK)).reshape(B, G, QA, k_sel * SEL_BLOCK)
        dist_s = t[:, None] - pos
        bias_s = tbl_g[g5, h5, t5_bucket(dist_s)[:, :, None]]
        s_s = jnp.einsum('bghqd,bgqnd->bghqn', qi, k_g).astype(jnp.float32) * SCALE + bias_s
        p_s = masked_softmax(s_s, (dist_s >= 0)[:, :, None])
        o_s = jnp.einsum('bghqn,bgqnd->bghqd', p_s, v_g)
        k_wi = lax.dynamic_slice_in_dim(kw, t0, WIN_A + QA, axis=2)
        v_wi = lax.dynamic_slice_in_dim(vw, t0, WIN_A + QA, axis=2)
        pos_w = t0 - WIN_A + jnp.arange(WIN_A + QA)
        dist_w = t[:, None] - pos_w[None, :]
        mask_w = (dist_w >= 0) & (dist_w < WIN_A) & (pos_w[None, :] >= 0)
        bias_w = tbl[:, t5_bucket(dist_w)].reshape(G, H, QA, WIN_A + QA)
        s_w = jnp.einsum('bghqd,bgkd->bghqk', qi, k_wi).astype(jnp.float32) * SCALE + bias_w
        p_w = masked_softmax(s_w, mask_w)
        o_w = jnp.einsum('bghqk,bgkd->bghqd', p_w, v_wi)
        g = lax.dynamic_slice_in_dim(gates, t0, QA, axis=3)
        return g[..., 0:1] * o_c + g[..., 1:2] * o_s + g[..., 2:3] * o_w

    out = lax.map(block, jnp.arange(S // QA))
    return out.transpose(1, 0, 4, 2, 3, 5).reshape(B, S, WIDTH_A).astype(q.dtype)


def dilated_branch(q, k, v, tbl, window, dil):
    B, S, H, dh = q.shape
    L = S // dil
    band = window // dil
    nb = -(-L // band)
    Lp = nb * band

    def to_blocks(a):
        a = a.reshape(B, L, dil, H, dh).transpose(0, 2, 3, 1, 4)
        a = jnp.pad(a, ((0, 0), (0, 0), (0, 0), (0, Lp - L), (0, 0)))
        return a.reshape(B, dil, H, nb, band, dh)

    def with_prev(a):
        prev = jnp.pad(a[:, :, :, :-1], ((0, 0), (0, 0), (0, 0), (1, 0), (0, 0), (0, 0)))
        return jnp.concatenate([prev, a], axis=4)

    qb = to_blocks(q)
    kk = with_prev(to_blocks(k))
    vv = with_prev(to_blocks(v))
    a_ix = jnp.arange(band)[:, None]
    c_ix = jnp.arange(2 * band)[None, :]
    n = band + a_ix - c_ix
    key_idx = (jnp.arange(nb)[:, None, None] - 1) * band + c_ix[None]
    mask = (n >= 0) & (n <= band) & (key_idx >= 0)
    bias = tbl[:, t5_bucket(n * dil)]
    s = jnp.einsum('brhnqd,brhnkd->brhnqk', qb, kk).astype(jnp.float32) * SCALE + bias[:, None]
    s = jnp.where(mask, s, NEG)
    m = jnp.max(s, axis=-1, keepdims=True)
    e = jnp.exp(s - m)
    den = jnp.sum(e, axis=-1)
    o = jnp.einsum('brhnqk,brhnkd->brhnqd', e, vv) / den[..., None]
    lse = m[..., 0] + jnp.log(den)
    o = o.reshape(B, dil, H, Lp, dh)[:, :, :, :L].transpose(0, 3, 1, 2, 4).reshape(B, S, H, dh)
    lse = lse.reshape(B, dil, H, Lp)[..., :L].transpose(0, 3, 1, 2).reshape(B, S, H)
    return o, lse


def dilated_mixer(q, k, v, q_norm, k_norm, tbl):
    B, S = q.shape[0], q.shape[1]
    qn = rmsnorm(q, q_norm)
    kn = rmsnorm(k, k_norm)
    outs, lses = [], []
    for window, dil in DIL_PAIRS:
        o, lse = dilated_branch(qn, kn, v, tbl, window, dil)
        outs.append(o)
        lses.append(lse)
    w = jax.nn.softmax(jnp.stack(lses), axis=0)
    o = jnp.einsum('ibsh,ibshd->bshd', w, jnp.stack(outs))
    return o.reshape(B, S, WIDTH_B).astype(q.dtype)


def moe_swiglu(h, router_w, w_gate, w_up, w_down):
    B, S, D = h.shape
    hf = h.reshape(-1, D)
    N = hf.shape[0]
    NK = N * TOP_K
    logits = (hf @ router_w).astype(jnp.float32)
    top_logit, top_e = lax.top_k(logits, TOP_K)
    gate = jax.nn.softmax(top_logit, axis=-1)
    e_flat = top_e.reshape(-1)
    tok_flat = jnp.arange(NK) // TOP_K
    order = jnp.argsort(e_flat)
    e_sorted = e_flat[order]
    counts = jnp.bincount(e_flat, length=N_EXPERTS)
    padded = (counts + MOE_CHUNK - 1) // MOE_CHUNK * MOE_CHUNK
    start = jnp.cumsum(counts) - counts
    pend = jnp.cumsum(padded)
    pstart = pend - padded
    dest = pstart[e_sorted] + jnp.arange(NK) - start[e_sorted]
    n_chunks = -(-NK // MOE_CHUNK) + N_EXPERTS
    rows = n_chunks * MOE_CHUNK
    row_tok = jnp.zeros((rows,), jnp.int32).at[dest].set(tok_flat[order])
    row_gate = jnp.zeros((rows,), jnp.float32).at[dest].set(gate.reshape(-1)[order])
    chunk_e = jnp.minimum(jnp.sum(jnp.arange(n_chunks)[:, None] * MOE_CHUNK >= pend[None, :], axis=1), N_EXPERTS - 1)

    def run_chunk(args):
        tok, e = args
        return swiglu(hf[tok], w_gate[e], w_up[e], w_down[e])

    y = lax.map(run_chunk, (row_tok.reshape(n_chunks, MOE_CHUNK), chunk_e))
    out = jnp.zeros((N, D), jnp.float32).at[row_tok].add(y.reshape(rows, D).astype(jnp.float32) * row_gate[:, None])
    return out.astype(h.dtype).reshape(B, S, D)


def setup_inputs(seed: int = 0) -> dict:
    key = jax.random.key(seed)
    k = jax.random.split(key, 24)
    n_dense = (DEPTH + 1) // 2
    n_moe = DEPTH // 2

    def nrm(kk, shape, scale):
        return jax.random.normal(kk, shape, jnp.float32) * scale

    def gain(kk, shape):
        return 1.0 + 0.02 * jax.random.normal(kk, shape, jnp.float32)

    return {
        'x': nrm(k[0], (BATCH, SEQ, D_MODEL), 1.0),
        'rel_bias': nrm(k[1], (N_BUCKETS, N_HEADS), 0.5),
        'attn_norm': gain(k[2], (DEPTH, D_MODEL)),
        'w_in': nrm(k[3], (DEPTH, D_MODEL, IN_WIDTH), D_MODEL ** -0.5),
        'nsa_q_norm': gain(k[4], (DEPTH, HEAD_DIM)),
        'nsa_k_norm': gain(k[5], (DEPTH, 3, HEAD_DIM)),
        'cmp_pos': nrm(k[6], (DEPTH, 2, CMP_LEN, HEAD_DIM), 0.1),
        'cmp_w1': nrm(k[7], (DEPTH, 2, CMP_LEN * HEAD_DIM, CMP_HIDDEN), (CMP_LEN * HEAD_DIM) ** -0.5),
        'cmp_b1': nrm(k[8], (DEPTH, 2, CMP_HIDDEN), 0.01),
        'cmp_w2': nrm(k[9], (DEPTH, 2, CMP_HIDDEN, HEAD_DIM), CMP_HIDDEN ** -0.5),
        'dil_q_norm': gain(k[10], (DEPTH, HEAD_DIM)),
        'dil_k_norm': gain(k[11], (DEPTH, HEAD_DIM)),
        'out_norm': gain(k[12], (DEPTH, MIX_WIDTH)),
        'w_out': nrm(k[13], (DEPTH, MIX_WIDTH, D_MODEL), MIX_WIDTH ** -0.5),
        'ffn_norm': gain(k[14], (DEPTH, D_MODEL)),
        'ffn_w_gate': nrm(k[15], (n_dense, D_MODEL, D_FF), D_MODEL ** -0.5),
        'ffn_w_up': nrm(k[16], (n_dense, D_MODEL, D_FF), D_MODEL ** -0.5),
        'ffn_w_down': nrm(k[17], (n_dense, D_FF, D_MODEL), D_FF ** -0.5),
        'router_w': nrm(k[18], (n_moe, D_MODEL, N_EXPERTS), D_MODEL ** -0.5),
        'exp_w_gate': nrm(k[19], (n_moe, N_EXPERTS, D_MODEL, D_FF_EXPERT), D_MODEL ** -0.5),
        'exp_w_up': nrm(k[20], (n_moe, N_EXPERTS, D_MODEL, D_FF_EXPERT), D_MODEL ** -0.5),
        'exp_w_down': nrm(k[21], (n_moe, N_EXPERTS, D_FF_EXPERT, D_MODEL), D_FF_EXPERT ** -0.5),
    }


def reference(x, rel_bias, attn_norm, w_in, nsa_q_norm, nsa_k_norm, cmp_pos, cmp_w1, cmp_b1, cmp_w2,
              dil_q_norm, dil_k_norm, out_norm, w_out, ffn_norm, ffn_w_gate, ffn_w_up, ffn_w_down,
              router_w, exp_w_gate, exp_w_up, exp_w_down):
    B, S, _ = x.shape
    tbl = rel_bias.astype(jnp.float32).T
    tbl_a = tbl[:N_HEADS_A]
    tbl_b = tbl[N_HEADS_A:]
    split_points = [int(v) for v in np.cumsum(IN_SPLITS)[:-1]]

    def heads(a):
        return a.reshape(B, S, -1, HEAD_DIM)

    h = x
    for layer in range(DEPTH):
        u = rmsnorm(h, attn_norm[layer])
        proj = u @ w_in[layer]
        qa, kca, vca, ksa, vsa, kwa, vwa, ga, qb, kb, vb = jnp.split(proj, split_points, axis=-1)
        o_a = nsa_mixer(heads(qa), heads(kca), heads(vca), heads(ksa), heads(vsa), heads(kwa), heads(vwa), ga,
                        nsa_q_norm[layer], nsa_k_norm[layer], cmp_pos[layer], cmp_w1[layer], cmp_b1[layer],
                        cmp_w2[layer], tbl_a)
        o_b = dilated_mixer(heads(qb), heads(kb), heads(vb), dil_q_norm[layer], dil_k_norm[layer], tbl_b)
        o = jnp.concatenate([rmsnorm(o_a, out_norm[layer, :WIDTH_A]), rmsnorm(o_b, out_norm[layer, WIDTH_A:])], axis=-1)
        h = h + o @ w_out[layer]
        v = rmsnorm(h, ffn_norm[layer])
        if layer % 2 == 0:
            h = h + swiglu(v, ffn_w_gate[layer // 2], ffn_w_up[layer // 2], ffn_w_down[layer // 2])
        else:
            h = h + moe_swiglu(v, router_w[layer // 2], exp_w_gate[layer // 2], exp_w_up[layer // 2], exp_w_down[layer // 2])
    return h
```

```cpp
#include <hip/hip_runtime.h>
#include <cstdio>
#include <cstdint>

#ifndef PHMASK
#define PHMASK 0xFFFFFFFFu
#endif
#ifndef PROBE_DUP
#define PROBE_DUP 0u
#endif
#ifndef PROBE_NSA
#define PROBE_NSA 0
#endif
#ifndef PROBE_BAR
#define PROBE_BAR 0
#endif
#ifndef MK_MULTI
#define MK_MULTI 0
#endif

#define LAS __attribute__((address_space(3)))
#define GAS __attribute__((address_space(1)))
typedef unsigned short bf16_t;
typedef short bf16x8 __attribute__((ext_vector_type(8)));
typedef short s16x4 __attribute__((ext_vector_type(4)));
typedef float f32x2 __attribute__((ext_vector_type(2)));
typedef float f32x4 __attribute__((ext_vector_type(4)));
typedef float f32x16 __attribute__((ext_vector_type(16)));
typedef unsigned u32x2 __attribute__((ext_vector_type(2)));
typedef unsigned u32x4 __attribute__((ext_vector_type(4)));
typedef __bf16 bf16x2_t __attribute__((ext_vector_type(2)));

constexpr int NB = 8, SEQ = 4096, DM = 1024, MTOK = NB * SEQ;
constexpr int HD = 64;
constexpr int IN_W = 2840, INP = 3072;
constexpr int DFF = 2816, DFE = 3584, NEXP = 8;
constexpr int CMPH = 256;
constexpr float RMS_EPS = 1e-6f;
constexpr float LOG2E = 1.4426950408889634f, LN2 = 0.6931471805599453f;
constexpr float QSCALE = 0.125f * LOG2E;
constexpr float NEGF = -1e30f;
constexpr int LUTN = 1664;
constexpr int NWAVES = 8, NTHR = 512;
constexpr int MOE_ROWS_MAX = (256 + 8) * 256;
constexpr int MOE_GROUP = 64;
constexpr int MOE_NGROUPS = 5;
constexpr int DIL_EARLY = 8;

constexpr size_t MiB = 1u << 20;
constexpr size_t WS_CTL = 0, CTL_BYTES = 1 * MiB;
constexpr size_t WS_LUT = 1 * MiB;
constexpr size_t WS_B1P = 1 * MiB + 224 * 1024;
constexpr size_t WS_B1E = WS_B1P + 2 * 2 * 16 * 256 * 4;
constexpr size_t WS_BSH = WS_B1E + 2 * 2 * 256 * 4;
constexpr size_t WS_WC2 = 1 * MiB + 512 * 1024;
static_assert(2 * 16 * LUTN * 4 <= 224 * 1024, "lut region");
constexpr size_t WS_ROUTE = 2 * MiB;
constexpr size_t RT_ROWTOK = WS_ROUTE;
constexpr size_t RT_ROWGATE = RT_ROWTOK + MOE_ROWS_MAX * 4;
constexpr size_t RT_TOPE = RT_ROWGATE + MOE_ROWS_MAX * 4;
constexpr size_t RT_TOPG = RT_TOPE + MTOK * 2 * 4;
constexpr size_t RT_CNT = RT_TOPG + MTOK * 2 * 4;
constexpr size_t RT_PSTART = RT_CNT + 256 * 8 * 4;
constexpr size_t RT_TOKPOS = RT_PSTART + 64;
static_assert(RT_TOKPOS + MTOK * 2 * 4 <= 4 * MiB, "route region");
constexpr size_t WS_WIN = 4 * MiB;
constexpr size_t WS_WC1 = 16 * MiB;
constexpr size_t WS_WO = 20 * MiB;
constexpr size_t WS_WF1 = 24 * MiB;
constexpr size_t WS_WF2 = 35 * MiB;
constexpr size_t SB = 44 * MiB;
constexpr size_t WS_QA = SB + 0 * MiB;
constexpr size_t WS_KC = SB + 32 * MiB, WS_VC = SB + 40 * MiB, WS_KS = SB + 48 * MiB, WS_VS = SB + 56 * MiB, WS_KW = SB + 64 * MiB, WS_VW = SB + 72 * MiB;
constexpr size_t WS_GATES = SB + 80 * MiB;
constexpr size_t WS_QB = SB + 84 * MiB, WS_KB = SB + 116 * MiB, WS_VB = SB + 148 * MiB;
constexpr size_t WS_KCC = SB + 180 * MiB, WS_VCC = SB + 181 * MiB;
constexpr size_t WS_HC = SB + 182 * MiB;
constexpr size_t WS_OA = SB + 186 * MiB;
constexpr size_t WS_OB = SB + 218 * MiB;
constexpr size_t WS_LSE = SB + 314 * MiB;
constexpr size_t WS_HB = SB + 352 * MiB;
constexpr size_t WS_U = SB + 420 * MiB;
constexpr size_t WS_ACT0 = SB + 0 * MiB;
constexpr size_t WS_WE1 = SB + 0 * MiB;
constexpr size_t WS_WE2 = SB + 112 * MiB;
constexpr size_t WS_VSORT = SB + 168 * MiB;
constexpr size_t WS_ACT1 = SB + 300 * MiB;
constexpr size_t WS_END = SB + 484 * MiB;
static_assert(WS_ACT1 + (size_t)MOE_GROUP * 256 * DFE * 2 <= WS_U, "moe act");
static_assert(WS_LSE + 3 * (size_t)MTOK * 8 * 4 <= WS_U, "attn map");

constexpr int CW_BAR = 4096;
constexpr int CTL_WORDS = (int)(CTL_BYTES / 4);

constexpr int RING_BYTES = 131072;
constexpr int LDSCTL_OFF = RING_BYTES;
constexpr int LDS_BYTES = 147456;

#define RLX_AGENT __ATOMIC_RELAXED, __HIP_MEMORY_SCOPE_AGENT
__device__ __forceinline__ unsigned f2bf(float f) { unsigned u = __builtin_bit_cast(unsigned, f); return (u + 0x7fffu + ((u >> 16) & 1u)) >> 16; }
__device__ __forceinline__ unsigned pk2(float lo, float hi) { f32x2 v = {lo, hi}; bf16x2_t b = __builtin_convertvector(v, bf16x2_t); return __builtin_bit_cast(unsigned, b); }
constexpr float FP8_ASCALE = 8.0f, FP8_WSCALE = 64.0f;
constexpr float FP8_UNSCALE = 1.0f / (FP8_ASCALE * FP8_WSCALE);
__device__ __forceinline__ unsigned pk4_fp8(float a, float b, float c, float d) {
    a = __builtin_amdgcn_fmed3f(a, -448.f, 448.f); b = __builtin_amdgcn_fmed3f(b, -448.f, 448.f); c = __builtin_amdgcn_fmed3f(c, -448.f, 448.f); d = __builtin_amdgcn_fmed3f(d, -448.f, 448.f);
    int w = __builtin_amdgcn_cvt_pk_fp8_f32(a, b, 0, false); w = __builtin_amdgcn_cvt_pk_fp8_f32(c, d, w, true); return (unsigned)w; }
__device__ __forceinline__ float bflo(unsigned u) { return __builtin_bit_cast(float, u << 16); }
__device__ __forceinline__ float bfhi(unsigned u) { return __builtin_bit_cast(float, u & 0xffff0000u); }
__device__ __forceinline__ float wave_sum(float v) {
#pragma unroll
    for (int o = 1; o < 64; o <<= 1) v += __shfl_xor(v, o);
    return v;
}
__device__ __forceinline__ float fexp2(float x) { return __builtin_amdgcn_exp2f(x); }
__device__ __forceinline__ float sigmoidf_(float x) { return __builtin_amdgcn_rcpf(1.0f + __builtin_amdgcn_exp2f(-LOG2E * x)); }

#define XB_TMO      128
#define XB_XCNT(j)  (256  + 64 * (j))
#define XB_XSUB(j)  (1280 + 64 * (j))
#define XB_XGEN(j)  (2304 + 64 * (j))
#define XB_TOP      3328
#define XB_TOPGEN   3392
#define XCD_BAR_WORDS 3456
#define XB_SPIN_CAP (1u << 18)
__device__ __forceinline__ unsigned xb_ld(unsigned* p)              { return __hip_atomic_load(p, __ATOMIC_RELAXED, __HIP_MEMORY_SCOPE_AGENT); }
__device__ __forceinline__ unsigned xb_add(unsigned* p, unsigned v) { return __hip_atomic_fetch_add(p, v, __ATOMIC_RELAXED, __HIP_MEMORY_SCOPE_AGENT); }
__device__ __forceinline__ unsigned xb_xcc_id() { return (unsigned)__builtin_amdgcn_s_getreg((3 << 11) | 20) & 0xFu; }
#define XB_SPIN(cond, bar) do { unsigned _sp = 0; while (cond) { __builtin_amdgcn_s_sleep(1); \
    if ((++_sp & 255u) == 0u) { if (xb_ld(&(bar)[XB_TMO])) break; if (_sp > XB_SPIN_CAP) { atomicAdd(&(bar)[XB_TMO], 1u); break; } } } } while (0)
struct XcdBarrier { unsigned* bar; unsigned x; volatile LAS unsigned* st; };
__device__ __forceinline__ XcdBarrier xcd_barrier_post(unsigned* bar, volatile LAS unsigned* st) {
    XcdBarrier b; b.bar = bar; b.x = xb_xcc_id(); b.st = st;
    if (threadIdx.x == 0) (void)xb_add(&bar[XB_XCNT(b.x)], 1u);
    return b;
}
__device__ __forceinline__ void xcd_barrier_complete(unsigned* bar, unsigned x, unsigned& nloc, unsigned& nx) {
    const unsigned G = gridDim.x * gridDim.y * gridDim.z;
    unsigned sum, cnt, mine, sp = 0u;
    for (;;) {
        sum = 0u; cnt = 0u; mine = 0u;
#pragma unroll
        for (unsigned j = 0; j < 16; ++j) { const unsigned c = xb_ld(&bar[XB_XCNT(j)]); sum += c; cnt += (c > 0u) ? 1u : 0u; mine = (j == x) ? c : mine; }
        if (sum == G) break;
        __builtin_amdgcn_s_sleep(1);
        if ((++sp & 255u) == 0u) { if (xb_ld(&bar[XB_TMO])) break; if (sp > XB_SPIN_CAP) { atomicAdd(&bar[XB_TMO], 1u); break; } }
    }
    nloc = mine > 0u ? mine : 1u; nx = cnt > 0u ? cnt : 1u;
}
__device__ __forceinline__ void xcd_barrier(const XcdBarrier& b) {
    asm volatile("s_waitcnt vmcnt(0)" ::: "memory");
    __syncthreads();
    if (threadIdx.x == 0) {
        unsigned* bar = b.bar;
        __builtin_amdgcn_s_waitcnt(0);
        unsigned nloc = b.st[0], nx = b.st[1];
        if (nloc == 0u) { xcd_barrier_complete(bar, b.x, nloc, nx); b.st[0] = nloc; b.st[1] = nx; }
        const unsigned old = xb_add(&bar[XB_XSUB(b.x)], 1u);
        const unsigned gen = old / nloc;
        if (old + 1u == (gen + 1u) * nloc) {
            __builtin_amdgcn_fence(__ATOMIC_RELEASE, "agent");
            asm volatile("s_waitcnt vmcnt(0)" ::: "memory");
            const unsigned og = xb_add(&bar[XB_TOP], 1u);
            const unsigned tg = og / nx;
            if (og + 1u == (tg + 1u) * nx) xb_add(&bar[XB_TOPGEN], 1u);
            else XB_SPIN(xb_ld(&bar[XB_TOPGEN]) == tg, bar);
            __builtin_amdgcn_fence(__ATOMIC_ACQUIRE, "agent");
            xb_add(&bar[XB_XGEN(b.x)], 1u);
            asm volatile("s_waitcnt vmcnt(0)" ::: "memory");
        } else {
            XB_SPIN(xb_ld(&bar[XB_XGEN(b.x)]) == gen, bar);
            __builtin_amdgcn_fence(__ATOMIC_ACQUIRE, "agent");
            asm volatile("s_waitcnt vmcnt(0)" ::: "memory");
        }
    }
    __syncthreads();
}

namespace pg8 {
constexpr int BM = 256, BK = 64, HALF = 128, HTB = HALF * BK * 2, STAGE_BYTES = 8 * HTB, NXCD = 8, WGM = 8;
__host__ __device__ __forceinline__ int lds_byte(int r, int c) { const int st = (r >> 4) * 2 + (c >> 5), rr = r & 15, cc = c & 31, ob = rr * 64 + cc * 2; return st * 1024 + (ob ^ (((ob >> 9) & 1) << 5)); }
__host__ __device__ __forceinline__ void stage_rc(int b, int& R, int& C) { const int st = b / 1024, sb = b % 1024, swz = sb ^ (((sb >> 9) & 1) << 5); R = (st >> 1) * 16 + swz / 64; C = (st & 1) * 32 + (swz % 64) / 2; }
__host__ __device__ __forceinline__ int perm32(int rho) { const int n = rho >> 4, i = rho & 15; return 8 * (i >> 2) + 4 * n + (i & 3); }

struct Unit { int pm, pn; const char* A; const char* B; };
struct Dims { int K, lda, ldb; };

template <class Epi, class Sched, bool ALIGN_EPI = true>
__device__ __forceinline__ void gemm_phase(LAS unsigned char* lds, const Dims g, const Sched& S, const Epi& E) {
    int tid_l = threadIdx.x; asm volatile("" : "+v"(tid_l));
    const int tid = tid_l, wid = __builtin_amdgcn_readfirstlane(tid >> 6), lane = tid & 63, wr = wid >> 2, wc = wid & 3, fr = lane & 15, fq = lane >> 4;
    const int K = g.K, nt = K / BK;
    unsigned voffA[2], voffB[2];
#pragma unroll
    for (int i = 0; i < 2; ++i) { int R, C; stage_rc(tid * 16 + i * 8192, R, C); const int Rb = (R & ~31) + perm32(R & 31);
        voffA[i] = (unsigned)(R * g.lda + C) * 2u; voffB[i] = (unsigned)(Rb * g.ldb + C) * 2u; }
    const size_t kstep = (size_t)(BK * 2);
    const size_t hstepA = (size_t)HALF * g.lda * 2, hstepB = (size_t)HALF * g.ldb * 2;
    const unsigned ldsw = (unsigned)wid * 1024u;
    const int aoff = lds_byte(wr * 64 + fr, fq * 8), boff = lds_byte(wc * 32 + fr, fq * 8);
#define PG8_SA(b, h) (((b) * 2 + (h)) * HTB)
#define PG8_SB(b, h) ((4 + (b) * 2 + (h)) * HTB)
#define PG8_STAGE(bufoff, gbase, voff) do { _Pragma("unroll") for (int _i = 0; _i < 2; ++_i) \
        __builtin_amdgcn_global_load_lds((const unsigned*)((const char*)(gbase) + (voff)[_i]), (LAS unsigned*)(lds + (bufoff) + ldsw + _i * 8192), 16, 0, 0); } while (0)
#define PG8_LDA(dst, b, h) do { _Pragma("unroll") for (int m = 0; m < 4; ++m) _Pragma("unroll") for (int k = 0; k < 2; ++k) dst[m][k] = *(const LAS bf16x8*)(lds + PG8_SA(b, h) + aoff + m * 2048 + k * 1024); } while (0)
#define PG8_LDB(dst, b, h) do { _Pragma("unroll") for (int n = 0; n < 2; ++n) _Pragma("unroll") for (int k = 0; k < 2; ++k) dst[n][k] = *(const LAS bf16x8*)(lds + PG8_SB(b, h) + boff + n * 2048 + k * 1024); } while (0)
#define PG8_MMA(ai, bj, At, Bt) do { __builtin_amdgcn_s_setprio(1); _Pragma("unroll") for (int m = 0; m < 4; ++m) _Pragma("unroll") for (int n = 0; n < 2; ++n) _Pragma("unroll") for (int k = 0; k < 2; ++k) \
        acc[ai][bj][m][n] = __builtin_amdgcn_mfma_f32_16x16x32_bf16(Bt[n][k], At[m][k], acc[ai][bj][m][n], 0, 0, 0); __builtin_amdgcn_s_setprio(0); } while (0)
#define PG8_WAIT_V(n) asm volatile("s_waitcnt vmcnt(" #n ")" ::: "memory")
#define PG8_WAIT_L(n) asm volatile("s_waitcnt lgkmcnt(" #n ")" ::: "memory")
#define PG8_BAR __builtin_amdgcn_s_barrier()
#define PG8_SCHED __builtin_amdgcn_sched_barrier(0)
    Unit cur, nxt; int ui = 0;
    if (!S.next(0, cur)) return;
    f32x4 acc[2][2][4][2];
#pragma unroll
    for (int a = 0; a < 2; ++a)
#pragma unroll
        for (int b = 0; b < 2; ++b)
#pragma unroll
            for (int m = 0; m < 4; ++m)
#pragma unroll
                for (int n = 0; n < 2; ++n) acc[a][b][m][n] = (f32x4){0.f, 0.f, 0.f, 0.f};
    bf16x8 At[4][2], B0[2][2], B1[2][2];
    const char* cA = cur.A; const char* cB = cur.B;
    PG8_STAGE(PG8_SB(0, 0), cB, voffB); PG8_STAGE(PG8_SB(0, 1), cB + hstepB, voffB); PG8_STAGE(PG8_SA(0, 0), cA, voffA); PG8_STAGE(PG8_SA(0, 1), cA + hstepA, voffA);
    if (wr == 1) PG8_BAR;
    PG8_WAIT_V(2); PG8_BAR;
    PG8_STAGE(PG8_SB(1, 0), cB + kstep, voffB); PG8_STAGE(PG8_SA(1, 0), cA + kstep, voffA); PG8_STAGE(PG8_SB(1, 1), cB + hstepB + kstep, voffB);
    PG8_WAIT_V(6); PG8_BAR;
    for (;;) {
        const bool has_next = S.next(ui + 1, nxt);
        const char* nA = has_next ? nxt.A : cA; const char* nB = has_next ? nxt.B : cB;
        for (int t = 0; t < nt; t += 2) {
            const bool last = (t == nt - 2);
            const char* a1 = cA + (size_t)(t + 1) * kstep;
            const char* a2 = last ? nA : cA + (size_t)(t + 2) * kstep; const char* b2 = last ? nB : cB + (size_t)(t + 2) * kstep;
            const char* a3 = a2 + kstep; const char* b3 = b2 + kstep;
            PG8_LDB(B0, 0, 0); PG8_LDB(B1, 0, 1); PG8_SCHED; PG8_LDA(At, 0, 0); PG8_STAGE(PG8_SA(1, 1), a1 + hstepA, voffA);
            PG8_WAIT_V(8); PG8_WAIT_L(0); PG8_BAR; PG8_MMA(0, 0, At, B0); PG8_MMA(0, 1, At, B1); PG8_BAR; PG8_SCHED;
            PG8_LDA(At, 0, 1); PG8_STAGE(PG8_SB(0, 0), b2, voffB); PG8_STAGE(PG8_SB(0, 1), b2 + hstepB, voffB); PG8_STAGE(PG8_SA(0, 0), a2, voffA);
            PG8_WAIT_V(8); PG8_WAIT_L(0); PG8_BAR; PG8_MMA(1, 0, At, B0); PG8_MMA(1, 1, At, B1); PG8_BAR; PG8_SCHED;
            PG8_LDB(B0, 1, 0); PG8_LDB(B1, 1, 1); PG8_SCHED; PG8_LDA(At, 1, 0); PG8_STAGE(PG8_SA(0, 1), a2 + hstepA, voffA);
            PG8_WAIT_V(8); PG8_WAIT_L(0); PG8_BAR; PG8_MMA(0, 0, At, B0); PG8_MMA(0, 1, At, B1); PG8_BAR; PG8_SCHED;
            PG8_LDA(At, 1, 1); PG8_STAGE(PG8_SB(1, 0), b3, voffB); PG8_STAGE(PG8_SB(1, 1), b3 + hstepB, voffB); PG8_STAGE(PG8_SA(1, 0), a3, voffA);
            PG8_WAIT_V(8); PG8_WAIT_L(0); PG8_BAR; PG8_MMA(1, 0, At, B0); PG8_MMA(1, 1, At, B1); PG8_BAR; PG8_SCHED;
        }
        if (ALIGN_EPI) { if (wr == 0) PG8_BAR; }
        E(acc, cur, wr, wc, fr, fq);
        if (!has_next) break;
#pragma unroll
        for (int a = 0; a < 2; ++a)
#pragma unroll
            for (int b = 0; b < 2; ++b)
#pragma unroll
                for (int m = 0; m < 4; ++m)
#pragma unroll
                    for (int n = 0; n < 2; ++n) acc[a][b][m][n] = (f32x4){0.f, 0.f, 0.f, 0.f};
        cur = nxt; cA = nA; cB = nB; ++ui;
        if (ALIGN_EPI) { if (wr == 1) PG8_BAR; }
    }
    PG8_WAIT_V(0);
    if (!ALIGN_EPI) { if (wr == 0) PG8_BAR; }
    PG8_BAR;
#undef PG8_SA
#undef PG8_SB
#undef PG8_STAGE
#undef PG8_LDA
#undef PG8_LDB
#undef PG8_MMA
#undef PG8_WAIT_V
#undef PG8_WAIT_L
#undef PG8_BAR
#undef PG8_SCHED
}

typedef int v8i_t __attribute__((ext_vector_type(8)));
typedef int v4i_t __attribute__((ext_vector_type(4)));
template <class Epi, class Sched>
__device__ __forceinline__ void gemm_phase_f8(LAS unsigned char* lds, const Dims g, const Sched& S, const Epi& E) {
    int tid_l = threadIdx.x; asm volatile("" : "+v"(tid_l));
    const int tid = tid_l, wid = __builtin_amdgcn_readfirstlane(tid >> 6), lane = tid & 63, wr = wid >> 2, wc = wid & 3, fr = lane & 15, fq = lane >> 4;
    const int K = g.K, nt = K / 128;
    unsigned voffA[2], voffB[2];
#pragma unroll
    for (int i = 0; i < 2; ++i) { int R, C; stage_rc(tid * 16 + i * 8192, R, C); const int Rb = (R & ~31) + perm32(R & 31);
        voffA[i] = (unsigned)(R * g.lda) + (unsigned)C * 2u; voffB[i] = (unsigned)(Rb * g.ldb) + (unsigned)C * 2u; }
    const size_t kstep = 128, hstepA = (size_t)HALF * g.lda;
    const unsigned ldsw = (unsigned)wid * 1024u;
    const int aoff = lds_byte(wr * 64 + fr, fq * 8), boff = lds_byte(wc * 32 + fr, fq * 8);
#define F8_SA(b, h) (((b) * 2 + (h)) * HTB)
#define F8_SB(b) ((4 + (b) * 2) * HTB)
#define F8_STAGE(bufoff, gbase, voff) do { _Pragma("unroll") for (int _i = 0; _i < 2; ++_i) \
        __builtin_amdgcn_global_load_lds((const unsigned*)((const char*)(gbase) + (voff)[_i]), (LAS unsigned*)(lds + (bufoff) + ldsw + _i * 8192), 16, 0, 0); } while (0)
#define F8_CAT(x, y) __builtin_shufflevector(x, y, 0, 1, 2, 3, 4, 5, 6, 7)
#define F8_LDA(b, h) do { _Pragma("unroll") for (int m = 0; m < 4; ++m) A8[m] = F8_CAT(*(const LAS v4i_t*)(lds + F8_SA(b, h) + aoff + m * 2048), *(const LAS v4i_t*)(lds + F8_SA(b, h) + aoff + m * 2048 + 1024)); } while (0)
#define F8_LDB(b) do { _Pragma("unroll") for (int n = 0; n < 2; ++n) B8[n] = F8_CAT(*(const LAS v4i_t*)(lds + F8_SB(b) + boff + n * 2048), *(const LAS v4i_t*)(lds + F8_SB(b) + boff + n * 2048 + 1024)); } while (0)
#define F8_MMA(ai) do { __builtin_amdgcn_s_setprio(1); _Pragma("unroll") for (int m = 0; m < 4; ++m) _Pragma("unroll") for (int n = 0; n < 2; ++n) \
        acc[ai][m][n] = __builtin_amdgcn_mfma_scale_f32_16x16x128_f8f6f4(B8[n], A8[m], acc[ai][m][n], 0, 0, 0, 0, 0, 0); __builtin_amdgcn_s_setprio(0); } while (0)
#define F8_WAIT_V(n) asm volatile("s_waitcnt vmcnt(" #n ")" ::: "memory")
#define F8_WAIT_L(n) asm volatile("s_waitcnt lgkmcnt(" #n ")" ::: "memory")
#define F8_BAR __builtin_amdgcn_s_barrier()
#define F8_SCHED __builtin_amdgcn_sched_barrier(0)
    Unit cur, nxt; int ui = 0;
    if (!S.next(0, cur)) return;
    f32x4 acc[2][4][2];
#pragma unroll
    for (int a = 0; a < 2; ++a)
#pragma unroll
        for (int m = 0; m < 4; ++m)
#pragma unroll
            for (int n = 0; n < 2; ++n) acc[a][m][n] = (f32x4){0.f, 0.f, 0.f, 0.f};
    v8i_t A8[4], B8[2];
    const char* cA = cur.A; const char* cB = cur.B;
    F8_STAGE(F8_SB(0), cB, voffB); F8_STAGE(F8_SA(0, 0), cA, voffA); F8_STAGE(F8_SA(0, 1), cA + hstepA, voffA);
    if (wr == 1) F8_BAR;
    F8_WAIT_V(2); F8_BAR;
    F8_STAGE(F8_SB(1), cB + kstep, voffB); F8_STAGE(F8_SA(1, 0), cA + kstep, voffA);
    F8_WAIT_V(6); F8_BAR;
    for (;;) {
        const bool has_next = S.next(ui + 1, nxt);
        const char* nA = has_next ? nxt.A : cA; const char* nB = has_next ? nxt.B : cB;
        for (int t = 0; t < nt; t += 2) {
            const bool last = (t == nt - 2);
            const char* a1 = cA + (size_t)(t + 1) * kstep;
            const char* a2 = last ? nA : cA + (size_t)(t + 2) * kstep; const char* b2 = last ? nB : cB + (size_t)(t + 2) * kstep;
            const char* a3 = a2 + kstep; const char* b3 = b2 + kstep;
            F8_LDB(0); F8_SCHED; F8_LDA(0, 0); F8_STAGE(F8_SA(1, 1), a1 + hstepA, voffA);
            F8_WAIT_V(6); F8_WAIT_L(0); F8_BAR; F8_MMA(0); F8_BAR; F8_SCHED;
            F8_LDA(0, 1); F8_STAGE(F8_SB(0), b2, voffB); F8_STAGE(F8_SA(0, 0), a2, voffA);
            F8_WAIT_V(6); F8_WAIT_L(0); F8_BAR; F8_MMA(1); F8_BAR; F8_SCHED;
            F8_LDB(1); F8_SCHED; F8_LDA(1, 0); F8_STAGE(F8_SA(0, 1), a2 + hstepA, voffA);
            F8_WAIT_V(6); F8_WAIT_L(0); F8_BAR; F8_MMA(0); F8_BAR; F8_SCHED;
            F8_LDA(1, 1); F8_STAGE(F8_SB(1), b3, voffB); F8_STAGE(F8_SA(1, 0), a3, voffA);
            F8_WAIT_V(6); F8_WAIT_L(0); F8_BAR; F8_MMA(1); F8_BAR; F8_SCHED;
        }
        if (wr == 0) F8_BAR;
        E(acc, cur, wr, wc, fr, fq);
        if (!has_next) break;
#pragma unroll
        for (int a = 0; a < 2; ++a)
#pragma unroll
            for (int m = 0; m < 4; ++m)
#pragma unroll
                for (int n = 0; n < 2; ++n) acc[a][m][n] = (f32x4){0.f, 0.f, 0.f, 0.f};
        cur = nxt; cA = nA; cB = nB; ++ui;
        if (wr == 1) F8_BAR;
    }
    F8_WAIT_V(0);
    F8_BAR;
#undef F8_SA
#undef F8_SB
#undef F8_STAGE
#undef F8_CAT
#undef F8_LDA
#undef F8_LDB
#undef F8_MMA
#undef F8_WAIT_V
#undef F8_WAIT_L
#undef F8_BAR
#undef F8_SCHED
}

template <class Epi, class Sched>
__device__ __forceinline__ void gemm_phase_f8d(LAS unsigned char* lds, const Dims g, const Sched& S, const Epi& E) {
    int tid_l = threadIdx.x; asm volatile("" : "+v"(tid_l));
    const int tid = tid_l, wid = __builtin_amdgcn_readfirstlane(tid >> 6), lane = tid & 63, wr = wid >> 2, wq = wid >> 1, wh = wid & 1, fr = lane & 15, fq = lane >> 4;
    const int K = g.K, nt = K / 128;
    unsigned voffA[2], voffB[2];
#pragma unroll
    for (int i = 0; i < 2; ++i) { int R, C; stage_rc(tid * 16 + i * 8192, R, C); const int Rb = (R & ~31) + perm32(R & 31);
        voffA[i] = (unsigned)(R * g.lda) + (unsigned)C * 2u; voffB[i] = (unsigned)(Rb * g.ldb) + (unsigned)C * 2u; }
    const size_t hstepA = (size_t)HALF * g.lda, hstepB = (size_t)HALF * g.ldb;
    const unsigned ldsw = (unsigned)wid * 1024u;
    const int aoff = (wq >> 1) * HTB + lds_byte((wq & 1) * 64 + fr, fq * 8), boff = 2 * HTB + lds_byte(wh * 64 + fr, fq * 8);
    constexpr int STG = 4 * HTB;
#define FD_STAGE1(bufoff, gptr, voff) do { const char* gp_ = (const char*)(gptr); asm volatile("" : "+s"(gp_));     \
        _Pragma("unroll") for (int _i = 0; _i < 2; ++_i) \
        __builtin_amdgcn_global_load_lds((const unsigned*)(gp_ + (voff)[_i]), (LAS unsigned*)(lds + (bufoff) + ldsw + _i * 8192), 16, 0, 0); } while (0)
#define FD_STAGE_AB0(sb, pa, pb) do { FD_STAGE1((sb), pa, voffA); FD_STAGE1((sb) + HTB, (pa) + hstepA, voffA); FD_STAGE1((sb) + 2 * HTB, pb, voffB); } while (0)
#define FD_STAGE_B1(sb, pb) FD_STAGE1((sb) + 3 * HTB, (pb) + hstepB, voffB)
#define FD_CAT(x, y) __builtin_shufflevector(x, y, 0, 1, 2, 3, 4, 5, 6, 7)
#define FD_WAIT_V(n) asm volatile("s_waitcnt vmcnt(" #n ")" ::: "memory")
#define FD_WAIT_L(n) asm volatile("s_waitcnt lgkmcnt(" #n ")" ::: "memory")
#define FD_BAR __builtin_amdgcn_s_barrier()
#define FD_SCHED __builtin_amdgcn_sched_barrier(0)
#define FD_TILEP(base, nbase, tt) (((tt) < nt) ? (base) + (size_t)(tt) * 128 : (nbase) + (size_t)((tt) - nt) * 128)
    Unit cur, nxt; int ui = 0;
    if (!S.next(0, cur)) return;
    f32x4 acc[2][4][4];
#pragma unroll
    for (int p = 0; p < 2; ++p)
#pragma unroll
        for (int m = 0; m < 4; ++m)
#pragma unroll
            for (int n = 0; n < 4; ++n) acc[p][m][n] = (f32x4){0.f, 0.f, 0.f, 0.f};
    v8i_t A8[4], B8[4];
    const char* cA = cur.A; const char* cB = cur.B;
    int sb = 0;
    FD_STAGE_AB0(0, cA, cB); FD_STAGE_B1(0, cB); FD_STAGE_AB0(STG, cA + 128, cB + 128);
    if (wr == 1) FD_BAR;
    FD_WAIT_V(8); FD_BAR; FD_BAR;
    for (;;) {
        const bool has_next = S.next(ui + 1, nxt);
        const char* nA = has_next ? nxt.A : cA; const char* nB = has_next ? nxt.B : cB;
        _Pragma("unroll 1") for (int t = 0; t < nt; ++t) {
            const int so = STG - sb;
#pragma unroll
            for (int n = 0; n < 4; ++n) B8[n] = FD_CAT(*(const LAS v4i_t*)(lds + sb + boff + n * 2048), *(const LAS v4i_t*)(lds + sb + boff + n * 2048 + 1024));
#pragma unroll
            for (int m = 0; m < 4; ++m) A8[m] = FD_CAT(*(const LAS v4i_t*)(lds + sb + aoff + m * 2048), *(const LAS v4i_t*)(lds + sb + aoff + m * 2048 + 1024));
            { const char* pb = FD_TILEP(cB, nB, t + 1); FD_STAGE_B1(so, pb); }
            FD_WAIT_V(8); FD_WAIT_L(0); FD_BAR;
            __builtin_amdgcn_s_setprio(1);
#pragma unroll
            for (int m = 0; m < 4; ++m)
#pragma unroll
                for (int n = 0; n < 4; ++n) acc[0][m][n] = __builtin_amdgcn_mfma_scale_f32_16x16x128_f8f6f4(B8[n], A8[m], acc[0][m][n], 0, 0, 0, 0, 0, 0);
            __builtin_amdgcn_s_setprio(0);
            FD_BAR; FD_SCHED;
#pragma unroll
            for (int n = 0; n < 4; ++n) B8[n] = FD_CAT(*(const LAS v4i_t*)(lds + sb + HTB + boff + n * 2048), *(const LAS v4i_t*)(lds + sb + HTB + boff + n * 2048 + 1024));
            { const char* pa = FD_TILEP(cA, nA, t + 2); const char* pb = FD_TILEP(cB, nB, t + 2); FD_STAGE_AB0(sb, pa, pb); }
            FD_WAIT_V(8); FD_WAIT_L(0); FD_BAR;
            __builtin_amdgcn_s_setprio(1);
#pragma unroll
            for (int m = 0; m < 4; ++m)
#pragma unroll
                for (int n = 0; n < 4; ++n) acc[1][m][n] = __builtin_amdgcn_mfma_scale_f32_16x16x128_f8f6f4(B8[n], A8[m], acc[1][m][n], 0, 0, 0, 0, 0, 0);
            __builtin_amdgcn_s_setprio(0);
            FD_BAR; FD_SCHED;
            sb = so;
        }
        if (wr == 0) FD_BAR;
        E(acc, cur, wq, wh, fr, fq);
        if (!has_next) break;
#pragma unroll
        for (int p = 0; p < 2; ++p)
#pragma unroll
            for (int m = 0; m < 4; ++m)
#pragma unroll
                for (int n = 0; n < 4; ++n) acc[p][m][n] = (f32x4){0.f, 0.f, 0.f, 0.f};
        cur = nxt; cA = nA; cB = nB; ++ui;
        if (wr == 1) FD_BAR;
    }
    FD_WAIT_V(0);
    FD_BAR;
#undef FD_STAGE1
#undef FD_STAGE_AB0
#undef FD_STAGE_B1
#undef FD_CAT
#undef FD_WAIT_V
#undef FD_WAIT_L
#undef FD_BAR
#undef FD_SCHED
#undef FD_TILEP
}

struct StaticOrder {
    int nM, nN, nwg, G, c; const char* A; const char* B; size_t tsA, tsB;
    __device__ void init(int M, int N, int G_, int c_, const void* A_, const void* B_, int lda, int ldb, int es = 2, int bn = BM) { nM = M / BM; nN = N / bn; nwg = nM * nN; G = G_; c = c_; A = (const char*)A_; B = (const char*)B_; tsA = (size_t)BM * lda * es; tsB = (size_t)bn * ldb * es; }
    __device__ bool next(int i, Unit& u) const {
        const long L = (long)i * G + c; if (L >= nwg) return false;
        int wgid = (int)L; { const int q = nwg / NXCD, r = nwg % NXCD, xcd = wgid % NXCD, off = wgid / NXCD; wgid = (xcd < r ? xcd * (q + 1) : r * (q + 1) + (xcd - r) * q) + off; }
        const int nig = WGM * nN, gid = wgid / nig, fm = gid * WGM, gsz = (nM - fm) < WGM ? (nM - fm) : WGM;
        u.pm = fm + ((wgid % nig) % gsz); u.pn = (wgid % nig) / gsz; u.A = A + (size_t)u.pm * tsA; u.B = B + (size_t)u.pn * tsB; return true;
    }
};
}

struct Args {
    const float* in[22]; float* out; unsigned char* ws; int ph_lo, ph_hi, li, pad;
};
enum { I_X = 0, I_RELB, I_ANORM, I_WIN, I_QN, I_KN, I_CPOS, I_CW1, I_CB1, I_CW2, I_DQN, I_DKN, I_ONORM, I_WOUT, I_FNORM, I_FG, I_FU, I_FD, I_RW, I_EG, I_EU, I_ED };

struct Frame {
    LAS unsigned char* lds;
    int tid, lane, wave, G, wg;
    unsigned char* ws; const float* const* in; float* out;
};

struct EpiInProj {
    unsigned char* ws; const float* qn; const float* kn; const float* dqn; const float* dkn;
    __device__ __forceinline__ void operator()(const f32x4 (&acc)[2][2][4][2], const pg8::Unit& u, int wr, int wc, int fr, int fq) const {
        const int rowb = u.pm * 256 + wr * 64 + fr;
        if (u.pn == 11) {
            if (wc != 0 || fq >= 3) return;
            float* G = (float*)(ws + WS_GATES);
#pragma unroll
            for (int ai = 0; ai < 2; ++ai)
#pragma unroll
                for (int m = 0; m < 4; ++m) { const int row = rowb + ai * 128 + m * 16;
#pragma unroll
                    for (int n = 0; n < 2; ++n) { f32x4 v = acc[ai][0][m][n]; f32x4 o; o[0] = sigmoidf_(v[0]); o[1] = sigmoidf_(v[1]); o[2] = sigmoidf_(v[2]); o[3] = sigmoidf_(v[3]);
                        *(f32x4*)(G + (size_t)row * 24 + 8 * fq + 4 * n) = o; } }
            return;
        }
        const int vh = 4 * u.pn + wc;
        size_t base; int nh, hidx; const float* gain = nullptr; float scale = 1.f;
        if (vh < 8)       { base = WS_QA; nh = 8; hidx = vh; gain = qn; scale = QSCALE; }
        else if (vh < 20) { const int k = (vh - 8) >> 1; nh = 2; hidx = (vh - 8) & 1;
                            base = (k == 0) ? WS_KC : (k == 1) ? WS_VC : (k == 2) ? WS_KS : (k == 3) ? WS_VS : (k == 4) ? WS_KW : WS_VW;
                            if (k == 2) gain = kn + 64; else if (k == 4) gain = kn + 128; }
        else if (vh < 28) { base = WS_QB; nh = 8; hidx = vh - 20; gain = dqn; scale = QSCALE; }
        else if (vh < 36) { base = WS_KB; nh = 8; hidx = vh - 28; gain = dkn; }
        else              { base = WS_VB; nh = 8; hidx = vh - 36; }
        bf16_t* O = (bf16_t*)(ws + base);
        f32x4 gv[2][2];
#pragma unroll
        for (int bj = 0; bj < 2; ++bj)
#pragma unroll
            for (int n = 0; n < 2; ++n) gv[bj][n] = gain ? *(const f32x4*)(gain + 32 * bj + 8 * fq + 4 * n) : (f32x4){1.f, 1.f, 1.f, 1.f};
#pragma unroll
        for (int ai = 0; ai < 2; ++ai)
#pragma unroll
            for (int m = 0; m < 4; ++m) {
                const int row = rowb + ai * 128 + m * 16, b = row >> 12, t = row & 4095;
                float rs = scale;
                if (gain) {
                    float ss = 0.f;
#pragma unroll
                    for (int bj = 0; bj < 2; ++bj)
#pragma unroll
                        for (int n = 0; n < 2; ++n) { const f32x4 v = acc[ai][bj][m][n]; ss += (v[0] * v[0] + v[1] * v[1]) + (v[2] * v[2] + v[3] * v[3]); }
                    ss += __shfl_xor(ss, 16); ss += __shfl_xor(ss, 32);
                    rs = scale * __builtin_amdgcn_rsqf(ss * (1.0f / 64.0f) + RMS_EPS);
                }
                bf16_t* dst = O + ((size_t)(b * nh + hidx) * SEQ + t) * 64 + 8 * fq;
#pragma unroll
                for (int bj = 0; bj < 2; ++bj) { const f32x4 v0 = acc[ai][bj][m][0] * gv[bj][0] * rs, v1 = acc[ai][bj][m][1] * gv[bj][1] * rs;
                    u32x4 w; w.x = pk2(v0[0], v0[1]); w.y = pk2(v0[2], v0[3]); w.z = pk2(v1[0], v1[1]); w.w = pk2(v1[2], v1[3]);
                    *(u32x4*)(dst + 32 * bj) = w; }
            }
    }
};
__device__ __forceinline__ float gelu_tanh(float x) { const float y = 0.7978845608028654f * (x + 0.044715f * x * x * x); const float e = __builtin_amdgcn_exp2f((2.f * LOG2E) * y); return x - x * __builtin_amdgcn_rcpf(e + 1.f); }
struct EpiCmp1 {
    bf16_t* HC; const float* b1e;
    __device__ __forceinline__ void operator()(const f32x4 (&acc)[2][2][4][2], const pg8::Unit& u, int wr, int wc, int fr, int fq) const {
        const int kv = u.pm >> 4, bg = u.pm & 15;
        bf16_t* O = HC + ((size_t)kv * 4096 + bg * 256) * 256; const float* bias = b1e + kv * 256;
        const int col0 = wc * 32 + 8 * fq;
#pragma unroll
        for (int ai = 0; ai < 2; ++ai)
#pragma unroll
            for (int m = 0; m < 4; ++m) { const int r = ai * 128 + wr * 64 + m * 16 + fr;
#pragma unroll
                for (int bj = 0; bj < 2; ++bj) { const f32x4 b0 = *(const f32x4*)(bias + col0 + bj * 128), b1 = *(const f32x4*)(bias + col0 + bj * 128 + 4);
                    const f32x4 v0 = acc[ai][bj][m][0] + b0, v1 = acc[ai][bj][m][1] + b1;
                    u32x4 w; w.x = pk2(gelu_tanh(v0[0]), gelu_tanh(v0[1])); w.y = pk2(gelu_tanh(v0[2]), gelu_tanh(v0[3])); w.z = pk2(gelu_tanh(v1[0]), gelu_tanh(v1[1])); w.w = pk2(gelu_tanh(v1[2]), gelu_tanh(v1[3]));
                    *(u32x4*)(O + (size_t)r * 256 + col0 + bj * 128) = w; } }
    }
};
template <bool RESF32> struct EpiRes {
    const void* res; bf16_t* out;
    __device__ __forceinline__ void operator()(const f32x4 (&acc)[2][2][4][2], const pg8::Unit& u, int wr, int wc, int fr, int fq) const {
        const int row0 = u.pm * 256 + wr * 64 + fr, col0 = u.pn * 256 + wc * 32 + 8 * fq;
#pragma unroll
        for (int ai = 0; ai < 2; ++ai)
#pragma unroll
            for (int m = 0; m < 4; ++m) { const size_t ro = (size_t)(row0 + ai * 128 + m * 16) * DM + col0;
#pragma unroll
                for (int bj = 0; bj < 2; ++bj) {
                    f32x4 r0, r1;
                    if (RESF32) { r0 = *(const f32x4*)((const float*)res + ro + bj * 128); r1 = *(const f32x4*)((const float*)res + ro + bj * 128 + 4); }
                    else { const u32x4 rb = *(const u32x4*)((const bf16_t*)res + ro + bj * 128); r0 = (f32x4){bflo(rb.x), bfhi(rb.x), bflo(rb.y), bfhi(rb.y)}; r1 = (f32x4){bflo(rb.z), bfhi(rb.z), bflo(rb.w), bfhi(rb.w)}; }
                    const f32x4 v0 = r0 + acc[ai][bj][m][0], v1 = r1 + acc[ai][bj][m][1];
                    u32x4 w; w.x = pk2(v0[0], v0[1]); w.y = pk2(v0[2], v0[3]); w.z = pk2(v1[0], v1[1]); w.w = pk2(v1[2], v1[3]);
                    *(u32x4*)(out + ro + bj * 128) = w; } }
    }
};
__device__ __forceinline__ float silu_mul(float g, float u) { return g * u * __builtin_amdgcn_rcpf(1.0f + __builtin_amdgcn_exp2f(-LOG2E * g)); }
template <bool FP8OUT> struct EpiSwiglu {
    void* Ov; int ldc; int pm0;
    __device__ __forceinline__ void operator()(const f32x4 (&acc)[2][2][4][2], const pg8::Unit& u, int wr, int wc, int fr, int fq) const {
        const int row0 = (u.pm - pm0) * 256 + wr * 64 + fr, col0 = u.pn * 128 + wc * 32 + 8 * fq;
#pragma unroll
        for (int ai = 0; ai < 2; ++ai)
#pragma unroll
            for (int m = 0; m < 4; ++m) { const f32x4 g0 = acc[ai][0][m][0], g1 = acc[ai][0][m][1], u0 = acc[ai][1][m][0], u1 = acc[ai][1][m][1];
                if constexpr (FP8OUT) { const f32x4 s0 = u0 * FP8_ASCALE, s1 = u1 * FP8_ASCALE;
                    u32x2 w; w.x = pk4_fp8(silu_mul(g0[0], s0[0]), silu_mul(g0[1], s0[1]), silu_mul(g0[2], s0[2]), silu_mul(g0[3], s0[3]));
                    w.y = pk4_fp8(silu_mul(g1[0], s1[0]), silu_mul(g1[1], s1[1]), silu_mul(g1[2], s1[2]), silu_mul(g1[3], s1[3]));
                    *(u32x2*)((unsigned char*)Ov + (size_t)(row0 + ai * 128 + m * 16) * ldc + col0) = w; }
                else { u32x4 w; w.x = pk2(silu_mul(g0[0], u0[0]), silu_mul(g0[1], u0[1])); w.y = pk2(silu_mul(g0[2], u0[2]), silu_mul(g0[3], u0[3]));
                    w.z = pk2(silu_mul(g1[0], u1[0]), silu_mul(g1[1], u1[1])); w.w = pk2(silu_mul(g1[2], u1[2]), silu_mul(g1[3], u1[3]));
                    *(u32x4*)((bf16_t*)Ov + (size_t)(row0 + ai * 128 + m * 16) * ldc + col0) = w; } }
    }
};
struct EpiResF8 {
    bf16_t* h;
    __device__ __forceinline__ void operator()(const f32x4 (&acc)[2][4][4], const pg8::Unit& u, int wq, int wh, int fr, int fq) const {
        const int row0 = u.pm * 256 + wq * 64 + fr, col0 = u.pn * 256 + wh * 64 + 8 * fq;
#pragma unroll
        for (int p = 0; p < 2; ++p)
#pragma unroll
        for (int m = 0; m < 4; ++m)
#pragma unroll
            for (int G = 0; G < 2; ++G) { bf16_t* q = h + (size_t)(row0 + m * 16) * DM + col0 + 128 * p + 32 * G; const u32x4 rb = *(const u32x4*)q;
                const f32x4 v0 = (f32x4){bflo(rb.x), bfhi(rb.x), bflo(rb.y), bfhi(rb.y)} + acc[p][m][2 * G] * FP8_UNSCALE, v1 = (f32x4){bflo(rb.z), bfhi(rb.z), bflo(rb.w), bfhi(rb.w)} + acc[p][m][2 * G + 1] * FP8_UNSCALE;
                u32x4 w; w.x = pk2(v0[0], v0[1]); w.y = pk2(v0[2], v0[3]); w.z = pk2(v1[0], v1[1]); w.w = pk2(v1[2], v1[3]);
                *(u32x4*)q = w; }
    }
    __device__ __forceinline__ void operator()(const f32x4 (&acc)[2][4][2], const pg8::Unit& u, int wr, int wc, int fr, int fq) const {
        const int row0 = u.pm * 256 + wr * 64 + fr, col0 = u.pn * 128 + wc * 32 + 8 * fq;
#pragma unroll
        for (int ai = 0; ai < 2; ++ai)
#pragma unroll
            for (int m = 0; m < 4; ++m) { bf16_t* p = h + (size_t)(row0 + ai * 128 + m * 16) * DM + col0; const u32x4 rb = *(const u32x4*)p;
                const f32x4 v0 = (f32x4){bflo(rb.x), bfhi(rb.x), bflo(rb.y), bfhi(rb.y)} + acc[ai][m][0] * FP8_UNSCALE, v1 = (f32x4){bflo(rb.z), bfhi(rb.z), bflo(rb.w), bfhi(rb.w)} + acc[ai][m][1] * FP8_UNSCALE;
                u32x4 w; w.x = pk2(v0[0], v0[1]); w.y = pk2(v0[2], v0[3]); w.z = pk2(v1[0], v1[1]); w.w = pk2(v1[2], v1[3]);
                *(u32x4*)p = w; }
    }
};
struct EpiSwigluF8 {
    unsigned char* O; int ldc; int pm0;
    __device__ __forceinline__ void operator()(const f32x4 (&acc)[2][4][4], const pg8::Unit& u, int wq, int wh, int fr, int fq) const {
        const int row0 = (u.pm - pm0) * 256 + wq * 64 + fr, col0 = u.pn * 128 + wh * 32 + 4 * fq;
        constexpr float KE = -LOG2E * FP8_UNSCALE, KP = FP8_UNSCALE * FP8_UNSCALE * FP8_ASCALE;
#pragma unroll
        for (int p = 0; p < 2; ++p)
#pragma unroll
        for (int m = 0; m < 4; ++m)
#pragma unroll
            for (int G = 0; G < 2; ++G) { const f32x4 ga = acc[p][m][2 * G], ua = acc[p][m][2 * G + 1]; float r[4];
#pragma unroll
                for (int c = 0; c < 4; ++c) r[c] = (ga[c] * ua[c]) * KP * __builtin_amdgcn_rcpf(1.0f + __builtin_amdgcn_exp2f(KE * ga[c]));
                *(unsigned*)(O + (size_t)(row0 + m * 16) * ldc + col0 + 64 * p + 16 * G) = pk4_fp8(r[0], r[1], r[2], r[3]); }
    }
    __device__ __forceinline__ void operator()(const f32x4 (&acc)[2][4][2], const pg8::Unit& u, int wr, int wc, int fr, int fq) const {
        const int row0 = (u.pm - pm0) * 256 + wr * 64 + fr, col0 = u.pn * 64 + wc * 16 + 4 * fq;
#pragma unroll
        for (int ai = 0; ai < 2; ++ai)
#pragma unroll
            for (int m = 0; m < 4; ++m) { const f32x4 ga = acc[ai][m][0], ua = acc[ai][m][1];
                constexpr float KE = -LOG2E * FP8_UNSCALE, KP = FP8_UNSCALE * FP8_UNSCALE * FP8_ASCALE;
                float r[4];
#pragma unroll
                for (int c = 0; c < 4; ++c) r[c] = (ga[c] * ua[c]) * KP * __builtin_amdgcn_rcpf(1.0f + __builtin_amdgcn_exp2f(KE * ga[c]));
                *(unsigned*)(O + (size_t)(row0 + ai * 128 + m * 16) * ldc + col0) = pk4_fp8(r[0], r[1], r[2], r[3]); }
    }
};
struct EpiMoe2F8 {
    bf16_t* Y; int pm0;
    __device__ __forceinline__ void operator()(const f32x4 (&acc)[2][4][4], const pg8::Unit& u, int wq, int wh, int fr, int fq) const {
        const int row0 = (pm0 + u.pm) * 256 + wq * 64 + fr, col0 = u.pn * 256 + wh * 64 + 8 * fq;
#pragma unroll
        for (int p = 0; p < 2; ++p)
#pragma unroll
        for (int m = 0; m < 4; ++m)
#pragma unroll
            for (int G = 0; G < 2; ++G) { const f32x4 v0 = acc[p][m][2 * G] * FP8_UNSCALE, v1 = acc[p][m][2 * G + 1] * FP8_UNSCALE;
                u32x4 w; w.x = pk2(v0[0], v0[1]); w.y = pk2(v0[2], v0[3]); w.z = pk2(v1[0], v1[1]); w.w = pk2(v1[2], v1[3]);
                *(u32x4*)(Y + (size_t)(row0 + m * 16) * DM + col0 + 128 * p + 32 * G) = w; }
    }
    __device__ __forceinline__ void operator()(const f32x4 (&acc)[2][4][2], const pg8::Unit& u, int wr, int wc, int fr, int fq) const {
        const int row0 = (pm0 + u.pm) * 256 + wr * 64 + fr, col0 = u.pn * 128 + wc * 32 + 8 * fq;
#pragma unroll
        for (int ai = 0; ai < 2; ++ai)
#pragma unroll
            for (int m = 0; m < 4; ++m) { const f32x4 v0 = acc[ai][m][0] * FP8_UNSCALE, v1 = acc[ai][m][1] * FP8_UNSCALE;
                u32x4 w; w.x = pk2(v0[0], v0[1]); w.y = pk2(v0[2], v0[3]); w.z = pk2(v1[0], v1[1]); w.w = pk2(v1[2], v1[3]);
                *(u32x4*)(Y + (size_t)(row0 + ai * 128 + m * 16) * DM + col0) = w; }
    }
};
struct EpiMoe2 {
    bf16_t* Y; int pm0;
    __device__ __forceinline__ void operator()(const f32x4 (&acc)[2][2][4][2], const pg8::Unit& u, int wr, int wc, int fr, int fq) const {
        const int row0 = (pm0 + u.pm) * 256 + wr * 64 + fr, col0 = u.pn * 256 + wc * 32 + 8 * fq;
#pragma unroll
        for (int ai = 0; ai < 2; ++ai)
#pragma unroll
            for (int m = 0; m < 4; ++m) { bf16_t* o = Y + (size_t)(row0 + ai * 128 + m * 16) * DM + col0;
#pragma unroll
                for (int bj = 0; bj < 2; ++bj) { const f32x4 v0 = acc[ai][bj][m][0], v1 = acc[ai][bj][m][1];
                    u32x4 w; w.x = pk2(v0[0], v0[1]); w.y = pk2(v0[2], v0[3]); w.z = pk2(v1[0], v1[1]); w.w = pk2(v1[2], v1[3]);
                    *(u32x4*)(o + bj * 128) = w; } }
    }
};

struct SchedCmp {
    int wg; const char* KC; const char* VC; const char* W;
    __device__ bool next(int i, pg8::Unit& u) const { if (i > 0 || wg >= 32) return false; const int kv = wg >> 4, bg = wg & 15; u.pm = wg; u.pn = 0;
        u.A = (kv ? VC : KC) + (size_t)bg * SEQ * 64 * 2; u.B = W + (size_t)kv * 256 * 2048 * 2; return true; }
};
struct SchedMoe1 {
    int wg, G, c0, ncg, nchunks; const int* pstart; const char* A; const char* W;
    __device__ bool next(int i, pg8::Unit& u) const {
        if (ncg <= 0) return false;
        const int L = i * G + wg; const int cl = __builtin_amdgcn_readfirstlane(L % ncg), pn = __builtin_amdgcn_readfirstlane(L / ncg); if (pn >= 28) return false; const int c = c0 + cl; if (c >= nchunks) return false;
        int e = 0;
#pragma unroll
        for (int k = 1; k < 8; ++k) e += (c * 256 >= __builtin_amdgcn_readfirstlane(pstart[k])) ? 1 : 0;
        u.pm = c; u.pn = pn; u.A = A + (size_t)c * 256 * DM * 2; u.B = W + ((size_t)e * 7168 + (size_t)pn * 256) * DM; return true; }
};
struct SchedMoe2 {
    int wg, G, c0, ncg, nchunks; const int* pstart; const char* A; const char* W;
    __device__ bool next(int i, pg8::Unit& u) const {
        if (ncg <= 0) return false;
        const int L = i * G + wg; const int cl = __builtin_amdgcn_readfirstlane(L % ncg), pn = __builtin_amdgcn_readfirstlane(L / ncg); if (pn >= 4) return false; const int c = c0 + cl; if (c >= nchunks) return false;
        int e = 0;
#pragma unroll
        for (int k = 1; k < 8; ++k) e += (c * 256 >= __builtin_amdgcn_readfirstlane(pstart[k])) ? 1 : 0;
        u.pm = cl; u.pn = pn; u.A = A + (size_t)cl * 256 * DFE; u.B = W + ((size_t)e * 1024 + (size_t)pn * 256) * DFE; return true; }
};

__device__ __forceinline__ void transpose_block(const float* src, int ldw, bf16_t* dst, int ldt, int nvalid, LAS float* scr, int lane) {
    if (nvalid == 32) {
#pragma unroll
        for (int i = 0; i < 8; ++i) { const int kk = 8 * i + (lane >> 3), n = (lane & 7) * 4; const f32x4 v = *(const f32x4*)(src + (size_t)kk * ldw + n);
            LAS float* d = scr + kk * 33 + n; d[0] = v[0]; d[1] = v[1]; d[2] = v[2]; d[3] = v[3]; }
    } else {
#pragma unroll 8
        for (int i = 0; i < 32; ++i) { const int kk = 2 * i + (lane >> 5), n = lane & 31; scr[kk * 33 + n] = (n < nvalid) ? src[(size_t)kk * ldw + n] : 0.f; }
    }
    asm volatile("s_waitcnt lgkmcnt(0)" ::: "memory");
    const int c = lane & 7;
#pragma unroll
    for (int j = 0; j < 4; ++j) { const int n = (lane >> 3) + 8 * j; const LAS float* s = scr + (8 * c) * 33 + n;
        u32x4 o; o.x = pk2(s[0 * 33], s[1 * 33]); o.y = pk2(s[2 * 33], s[3 * 33]); o.z = pk2(s[4 * 33], s[5 * 33]); o.w = pk2(s[6 * 33], s[7 * 33]);
        *(u32x4*)(dst + (size_t)n * ldt + 8 * c) = o; }
    asm volatile("s_waitcnt lgkmcnt(0)" ::: "memory");
}
__device__ __forceinline__ void tb_load(f32x4 (&r)[8], const float* src, int ldw, int lane) {
#pragma unroll
    for (int i = 0; i < 8; ++i) r[i] = *(const f32x4*)(src + (size_t)(8 * i + (lane >> 3)) * ldw + (lane & 7) * 4);
}
template <bool FP8> __device__ __forceinline__ void tb_emit(const f32x4 (&r)[8], void* dstv, int ldt, LAS float* scr, int lane) {
#pragma unroll
    for (int i = 0; i < 8; ++i) { LAS float* d = scr + (8 * i + (lane >> 3)) * 33 + (lane & 7) * 4; d[0] = r[i][0]; d[1] = r[i][1]; d[2] = r[i][2]; d[3] = r[i][3]; }
    asm volatile("s_waitcnt lgkmcnt(0)" ::: "memory");
    const int c = lane & 7;
#pragma unroll
    for (int j = 0; j < 4; ++j) { const int n = (lane >> 3) + 8 * j; const LAS float* s = scr + (8 * c) * 33 + n;
        if constexpr (FP8) { u32x2 o; o.x = pk4_fp8(s[0 * 33] * FP8_WSCALE, s[1 * 33] * FP8_WSCALE, s[2 * 33] * FP8_WSCALE, s[3 * 33] * FP8_WSCALE); o.y = pk4_fp8(s[4 * 33] * FP8_WSCALE, s[5 * 33] * FP8_WSCALE, s[6 * 33] * FP8_WSCALE, s[7 * 33] * FP8_WSCALE);
            *(u32x2*)((unsigned char*)dstv + (size_t)n * ldt + 8 * c) = o; }
        else { u32x4 o; o.x = pk2(s[0 * 33], s[1 * 33]); o.y = pk2(s[2 * 33], s[3 * 33]); o.z = pk2(s[4 * 33], s[5 * 33]); o.w = pk2(s[6 * 33], s[7 * 33]);
            *(u32x4*)((bf16_t*)dstv + (size_t)n * ldt + 8 * c) = o; } }
    asm volatile("s_waitcnt lgkmcnt(0)" ::: "memory");
}
template <bool FP8 = false> __device__ __forceinline__ void conv_plain(const float* W, int K, int N, void* WTv, LAS float* scr, int gw, int ngw, int lane) {
    unsigned char* WT = (unsigned char*)WTv; constexpr int ES = FP8 ? 1 : 2;
    const int nkb = K / 64, nnb = N / 32, nit = nkb * nnb;
    f32x4 cur[8], nxt[8];
    int it = gw;
    if (it < nit) { const int kb = it / nnb, nb = it % nnb; tb_load(cur, W + (size_t)kb * 64 * N + nb * 32, N, lane); }
    for (; it < nit; it += ngw) {
        const int kb = it / nnb, nb = it % nnb;
        if (it + ngw < nit) { const int kb2 = (it + ngw) / nnb, nb2 = (it + ngw) % nnb; tb_load(nxt, W + (size_t)kb2 * 64 * N + nb2 * 32, N, lane); }
        tb_emit<FP8>(cur, WT + ((size_t)nb * 32 * K + kb * 64) * ES, K, scr, lane);
#pragma unroll
        for (int i = 0; i < 8; ++i) cur[i] = nxt[i];
    }
}
__device__ __forceinline__ void conv_gateup(const float* Wg, const float* Wu, int K, int N, bf16_t* WT, LAS float* scr, int gw, int ngw, int lane) {
    const int nkb = K / 64, nvb = 2 * N / 32, nit = nkb * nvb;
    f32x4 cur[8], nxt[8];
    int it = gw;
#define GU_SRC(itx) ((((((itx) % nvb) * 32) >> 7) & 1 ? Wu : Wg) + (size_t)((itx) / nvb) * 64 * N + (((((itx) % nvb) * 32) >> 8) * 128) + ((((itx) % nvb) * 32) & 127))
    if (it < nit) tb_load(cur, GU_SRC(it), N, lane);
    for (; it < nit; it += ngw) {
        const int kb = it / nvb, vb = it % nvb;
        if (it + ngw < nit) tb_load(nxt, GU_SRC(it + ngw), N, lane);
        tb_emit<false>(cur, WT + (size_t)vb * 32 * K + kb * 64, K, scr, lane);
#pragma unroll
        for (int i = 0; i < 8; ++i) cur[i] = nxt[i];
    }
#undef GU_SRC
}
__device__ __forceinline__ void conv_gateup_f8(const float* Wg, const float* Wu, int K, int N, unsigned char* WT, LAS float* scr, int gw, int ngw, int lane) {
    const int nkb = K / 64, nvb = 2 * N / 32, nit = nkb * nvb;
    f32x4 cur[8], nxt[8];
    int it = gw;
#define GU8_LOAD(r, itx) do { const int kb_ = (itx) / nvb, vb_ = (itx) % nvb, q8_ = lane & 7; const float* W_ = (q8_ & 1) ? Wu : Wg; \
        const float* src_ = W_ + (size_t)kb_ * 64 * N + (vb_ >> 2) * 64 + (vb_ & 3) * 16 + (q8_ >> 1) * 4; \
        _Pragma("unroll") for (int i = 0; i < 8; ++i) r[i] = *(const f32x4*)(src_ + (size_t)(8 * i + (lane >> 3)) * N); } while (0)
    if (it < nit) GU8_LOAD(cur, it);
    for (; it < nit; it += ngw) {
        const int kb = it / nvb, vb = it % nvb;
        if (it + ngw < nit) GU8_LOAD(nxt, it + ngw);
        tb_emit<true>(cur, WT + (size_t)vb * 32 * K + kb * 64, K, scr, lane);
#pragma unroll
        for (int i = 0; i < 8; ++i) cur[i] = nxt[i];
    }
#undef GU8_LOAD
}
__device__ __forceinline__ void conv_inproj(const float* W, bf16_t* WT, LAS float* scr, int gw, int ngw, int lane) {
    const int nkb = DM / 64, nvb = INP / 32;
    for (int it = gw; it < nkb * nvb; it += ngw) { const int kb = it / nvb, vb = it % nvb; const int v0 = vb * 32, pn = v0 >> 8, bj = (v0 >> 7) & 1, wc = (v0 >> 5) & 3;
        int col, nvalid = 32;
        if (pn < 11) { const int vh = 4 * pn + wc; col = (vh < 20 ? 64 * vh : 1304 + 64 * (vh - 20)) + 32 * bj; }
        else { col = 1280; nvalid = (bj == 0 && wc == 0) ? 24 : 0; }
        transpose_block(W + (size_t)kb * 64 * IN_W + col, IN_W, WT + (size_t)v0 * DM + kb * 64, DM, nvalid, scr, lane); }
}

__device__ __forceinline__ f32x16 mfma32(bf16x8 a, bf16x8 b, f32x16 c) { return __builtin_amdgcn_mfma_f32_32x32x16_bf16(a, b, c, 0, 0, 0); }
typedef short v4i16_t __attribute__((ext_vector_type(4)));
__device__ __forceinline__ s16x4 vtr(const LAS char* p) { return __builtin_bit_cast(s16x4, __builtin_amdgcn_ds_read_tr16_b64_v4i16((LAS v4i16_t*)p)); }

__device__ __forceinline__ void init_scores(f32x16& p0, f32x16& p1, int dbase, int dstep, int dmaxv, bool lanevalid, const LAS float* lut) {
#pragma unroll
    for (int r = 0; r < 16; ++r) {
        const int kk = (r & 3) + 8 * (r >> 2);
        const int d0 = dbase - dstep * kk, d1 = dbase - dstep * (kk + 32);
        const bool v0 = lanevalid && ((unsigned)d0 <= (unsigned)dmaxv), v1 = lanevalid && ((unsigned)d1 <= (unsigned)dmaxv);
        const int i0 = min(max(d0, 0), LUTN - 1), i1 = min(max(d1, 0), LUTN - 1);
        const float b0 = lut[(LUTN - 1) - i0], b1 = lut[(LUTN - 1) - i1];
        p0[r] = v0 ? b0 : NEGF; p1[r] = v1 ? b1 : NEGF;
    }
}
__device__ __forceinline__ void qk_tile(f32x16& p0, f32x16& p1, const LAS char* Ks, const bf16x8 (&qr)[4], int r32, int hi) {
    const LAS char* kb = Ks + hi * 1024 + r32 * 16;
#pragma unroll
    for (int d0 = 0; d0 < 4; ++d0) {
        const bf16x8 b0 = *(const LAS bf16x8*)(kb + d0 * 2048), b1 = *(const LAS bf16x8*)(kb + d0 * 2048 + 512);
        p0 = mfma32(b0, qr[d0], p0); p1 = mfma32(b1, qr[d0], p1);
    }
}
__device__ __forceinline__ void k_load(bf16x8 (&kf)[8], const LAS char* kb) {
#pragma unroll
    for (int d0 = 0; d0 < 4; ++d0) { kf[2 * d0] = *(const LAS bf16x8*)(kb + d0 * 2048); kf[2 * d0 + 1] = *(const LAS bf16x8*)(kb + d0 * 2048 + 512); }
}
__device__ __forceinline__ void qk_mma(f32x16& p0, f32x16& p1, const bf16x8 (&kf)[8], const bf16x8 (&qr)[4]) {
#pragma unroll
    for (int d0 = 0; d0 < 4; ++d0) { p0 = mfma32(kf[2 * d0], qr[d0], p0); p1 = mfma32(kf[2 * d0 + 1], qr[d0], p1); }
}
__device__ __forceinline__ bf16x8 pack8(const f32x16& p, int s) {
    u32x4 w; w.x = pk2(p[8 * s], p[8 * s + 1]); w.y = pk2(p[8 * s + 2], p[8 * s + 3]); w.z = pk2(p[8 * s + 4], p[8 * s + 5]); w.w = pk2(p[8 * s + 6], p[8 * s + 7]);
    return __builtin_bit_cast(bf16x8, w);
}
__device__ __forceinline__ void pv_tile(f32x16 (&o)[2], const LAS char* vb, const f32x16& p0, const f32x16& p1) {
    bf16x8 pf[4]; pf[0] = pack8(p0, 0); pf[1] = pack8(p0, 1); pf[2] = pack8(p1, 0); pf[3] = pack8(p1, 1);
#pragma unroll
    for (int db = 0; db < 2; ++db)
#pragma unroll
        for (int ks = 0; ks < 4; ++ks) {
            const s16x4 lo = vtr(vb + db * 4096 + ks * 1024), hh = vtr(vb + db * 4096 + ks * 1024 + 512);
            const bf16x8 vf = (bf16x8){lo[0], lo[1], lo[2], lo[3], hh[0], hh[1], hh[2], hh[3]};
            o[db] = mfma32(vf, pf[ks], o[db]);
        }
}
__device__ __forceinline__ void v_load(bf16x8 (&vf)[8], const LAS char* vb) {
#pragma unroll
    for (int db = 0; db < 2; ++db)
#pragma unroll
        for (int ks = 0; ks < 4; ++ks) {
            const s16x4 lo = vtr(vb + db * 4096 + ks * 1024), hh = vtr(vb + db * 4096 + ks * 1024 + 512);
            vf[db * 4 + ks] = (bf16x8){lo[0], lo[1], lo[2], lo[3], hh[0], hh[1], hh[2], hh[3]};
        }
}
__device__ __forceinline__ void pv_mma(f32x16 (&o)[2], const bf16x8 (&vf)[8], const f32x16& p0, const f32x16& p1) {
    bf16x8 pf[4]; pf[0] = pack8(p0, 0); pf[1] = pack8(p0, 1); pf[2] = pack8(p1, 0); pf[3] = pack8(p1, 1);
#pragma unroll
    for (int ks = 0; ks < 4; ++ks) { o[0] = mfma32(vf[ks], pf[ks], o[0]); o[1] = mfma32(vf[4 + ks], pf[ks], o[1]); }
}
#define SCHED_FENCE() __builtin_amdgcn_sched_barrier(0)
__device__ __forceinline__ float max16x2(const f32x16& a, const f32x16& b) {
    float m = fmaxf(a[0], b[0]);
#pragma unroll
    for (int r = 1; r < 16; ++r) m = fmaxf(m, fmaxf(a[r], b[r]));
    return m;
}
__device__ __forceinline__ void init_direct(f32x16& p0, f32x16& p1, const LAS float* base) {
#pragma unroll
    for (int r = 0; r < 16; ++r) { const int kk = (r & 3) + 8 * (r >> 2); p0[r] = base[kk]; p1[r] = base[kk + 32]; }
}
__device__ __forceinline__ float exp_tile(f32x16& p0, f32x16& p1) {
    float rs = 0.f;
#pragma unroll
    for (int r = 0; r < 16; ++r) { p0[r] = fexp2(p0[r]); p1[r] = fexp2(p1[r]); rs += p0[r] + p1[r]; }
    return rs;
}

constexpr int AL_KV = 0;
constexpr int LUTS_N = 64 + LUTN, LUTW_N = 64 + 512 + 128;
constexpr int AL_LUTS = 65536;
constexpr int AL_LUTW = AL_LUTS + 4 * LUTS_N * 4, AL_NEGP = AL_LUTW + 4 * LUTW_N * 4;
constexpr int AL_IMP = AL_NEGP + 512;
constexpr int AL_SEL = LDSCTL_OFF + 1024;
constexpr int AL_DLUT = 65536;
constexpr int AL_STA = AL_IMP, AL_STB = AL_SEL + 2048;
static_assert(AL_STB + 2 * 4096 <= LDS_BYTES && AL_STA + 6 * 4096 <= RING_BYTES && AL_IMP + 64 * 65 * 4 <= RING_BYTES, "attention LDS map");

__device__ __forceinline__ void glds16(const void* gsrc, unsigned lds_dst) { unsigned keep;
    asm volatile("s_mov_b32 %0, m0\n\ts_mov_b32 m0, %2\n\ts_nop 0\n\tglobal_load_lds_dwordx4 %1, off\n\ts_mov_b32 m0, %0" : "=&s"(keep) : "v"(gsrc), "s"(lds_dst) : "memory"); }
__device__ __forceinline__ void kv_dma(const bf16_t* Kt, const bf16_t* Vt, LAS char* slot, int w, int lane) {
    const unsigned base = (unsigned)__builtin_amdgcn_readfirstlane((int)(unsigned)(size_t)slot + w * 1024);
    glds16(Kt + lane * 64 + w * 8, base);
    glds16(Vt + ((w & 3) * 16 + (lane >> 2)) * 64 + (w >> 2) * 32 + (lane & 3) * 8, base + 8192u);
}
#define WAITBAR(N) asm volatile("s_waitcnt vmcnt(" #N ") lgkmcnt(0)\n\ts_barrier" ::: "memory")

__device__ __forceinline__ void stash_store(LAS char* st, const f32x16 (&o)[2]) {
#pragma unroll
    for (int k = 0; k < 4; ++k) { const f32x16& v = o[k >> 1]; const int b = 8 * (k & 1);
        u32x4 wv; wv.x = pk2(v[b], v[b + 1]); wv.y = pk2(v[b + 2], v[b + 3]); wv.z = pk2(v[b + 4], v[b + 5]); wv.w = pk2(v[b + 6], v[b + 7]); *(LAS u32x4*)(st + k * 1024) = wv; }
}
__device__ __forceinline__ void stash_load(const LAS char* st, f32x16 (&o)[2]) {
#pragma unroll
    for (int k = 0; k < 4; ++k) { const u32x4 wv = *(const LAS u32x4*)(st + k * 1024); f32x16& v = o[k >> 1]; const int b = 8 * (k & 1);
        v[b] = bflo(wv.x); v[b + 1] = bfhi(wv.x); v[b + 2] = bflo(wv.y); v[b + 3] = bfhi(wv.y); v[b + 4] = bflo(wv.z); v[b + 5] = bfhi(wv.z); v[b + 6] = bflo(wv.w); v[b + 7] = bfhi(wv.w); }
}
__device__ __forceinline__ void nsa_prepare(const Frame& F, int L, int g) {
    LAS char* lds = (LAS char*)F.lds; int tid_l = F.tid; asm volatile("" : "+v"(tid_l)); const int tid = tid_l;
    const float* LUTG = (const float*)(F.ws + WS_LUT) + (size_t)(L * 16 + g * 4) * LUTN;
    LAS float* ls = (LAS float*)(lds + AL_LUTS); LAS float* lw = (LAS float*)(lds + AL_LUTW); LAS float* np = (LAS float*)(lds + AL_NEGP);
    __syncthreads();
    for (int h = 0; h < 4; ++h) {
        for (int x = tid; x < LUTS_N; x += NTHR) ls[h * LUTS_N + x] = (x >= LUTN) ? NEGF : LUTG[h * LUTN + (LUTN - 1 - x)];
        for (int x = tid; x < LUTW_N; x += NTHR) { const int d = 639 - x; lw[h * LUTW_N + x] = (d < 0 || d > 511) ? NEGF : LUTG[h * LUTN + d]; }
    }
    if (tid < 128) np[tid] = NEGF;
    __syncthreads();
}

__device__ __forceinline__ void nsa_unit(const Frame& F, int L, int b, int g, int i) {
    LAS char* lds = (LAS char*)F.lds;
    int tid_l = F.tid; asm volatile("" : "+v"(tid_l));
    const int tid = tid_l, lane = tid & 63, w = __builtin_amdgcn_readfirstlane(tid >> 6), r32 = lane & 31, hi = lane >> 5;
    const int hh = w >> 1, qh = w & 1, head = g * 4 + hh;
    const int t0 = i * 64, tq = t0 + 32 * qh + r32;
    unsigned char* ws = F.ws;
    const bf16_t* QA = (const bf16_t*)(ws + WS_QA);
    const size_t bgoff = (size_t)(b * 2 + g) * SEQ * 64;
    const bf16_t *KS = (const bf16_t*)(ws + WS_KS) + bgoff, *VS = (const bf16_t*)(ws + WS_VS) + bgoff, *KW = (const bf16_t*)(ws + WS_KW) + bgoff, *VW = (const bf16_t*)(ws + WS_VW) + bgoff;
    const bf16_t *KCC = (const bf16_t*)(ws + WS_KCC) + (size_t)(b * 2 + g) * 256 * 64, *VCC = (const bf16_t*)(ws + WS_VCC) + (size_t)(b * 2 + g) * 256 * 64;
    LAS char* ring = lds + AL_KV;
    const LAS float* luts = (const LAS float*)(lds + AL_LUTS) + hh * LUTS_N;
    const LAS float* lutw = (const LAS float*)(lds + AL_LUTW) + hh * LUTW_N;
    const LAS float* negp = (const LAS float*)(lds + AL_NEGP);
    WAITBAR(0);
    const int ntc = (4 * i + 3 + 63) >> 6;
#pragma unroll
    for (int p = 0; p < 4; ++p) if (p < ntc) kv_dma(KCC + (size_t)p * 4096, VCC + (size_t)p * 4096, ring + p * 16384, w, lane);
    bf16x8 qr[4];
    { const bf16_t* Qp = QA + ((size_t)(b * 8 + head) * SEQ + tq) * 64;
#pragma unroll
      for (int d0 = 0; d0 < 4; ++d0) qr[d0] = *(const bf16x8*)(Qp + d0 * 16 + hi * 8); }
    const int vlane = ((lane >> 4) & 1) * 32 + (lane & 3) * 8 + (4 * hi + ((lane & 15) >> 2)) * 64 + 8192;
    const float* GT = (const float*)(ws + WS_GATES) + (size_t)(b * SEQ + tq) * 24 + head * 3;
    const float g_c = GT[0], g_s = GT[1], g_w = GT[2];
    const float cfar = luts[0];
    LAS char* stash = lds + ((w < 6) ? AL_STA + w * 4096 : AL_STB + (w - 6) * 4096) + lane * 16;
    const int j0 = (i >= 8) ? i - 8 : 0, nw = i - j0 + 1;
    f32x16 oc[2];
    {
#pragma unroll
        for (int r = 0; r < 16; ++r) { oc[0][r] = 0.f; oc[1][r] = 0.f; }
        float lc = 0.f, carry = 0.f;
        { LAS int* iz = (LAS int*)(lds + AL_IMP); for (int k = tid; k < 64 * 65; k += NTHR) iz[k] = 0; }
        WAITBAR(0);
        for (int t = 0; t < ntc; ++t) {
            f32x16 p0, p1;
            init_scores(p0, p1, (tq - 31) - 16 * (64 * t + 4 * hi), 16, 1 << 20, true, luts);
            qk_tile(p0, p1, ring + t * 16384, qr, r32, hi);
            lc += exp_tile(p0, p1);
        }
        lc += __shfl_xor(lc, 32);
        const float lcinv = (tq >= 31) ? 1.0f / lc : 0.f;
        LAS int* impq = (LAS int*)(lds + AL_IMP) + (32 * qh + r32);
        for (int t = 0; t < ntc; ++t) {
            const LAS char* buf = ring + t * 16384;
            f32x16 p0, p1; bf16x8 vf[8];
            init_scores(p0, p1, (tq - 31) - 16 * (64 * t + 4 * hi), 16, 1 << 20, true, luts);
            qk_tile(p0, p1, buf, qr, r32, hi);
            v_load(vf, buf + vlane); SCHED_FENCE();
#pragma unroll
            for (int r = 0; r < 16; ++r) { p0[r] = fexp2(p0[r]) * lcinv; p1[r] = fexp2(p1[r]) * lcinv; }
#pragma unroll
            for (int blk = 0; blk < 2; ++blk)
#pragma unroll
                for (int g4 = 0; g4 < 4; ++g4) {
                    const f32x16& p = blk ? p1 : p0;
                    const float a = p[4 * g4] + p[4 * g4 + 1] + p[4 * g4 + 2] + 0.5f * p[4 * g4 + 3], bn = 0.5f * p[4 * g4 + 3];
                    const float pb = __shfl_xor(bn, 32);
                    const float v = hi ? (a + pb) : (a + carry); carry = pb;
                    const int j = 16 * t + 8 * blk + 2 * g4 + hi;
                    (void)__hip_atomic_fetch_add(impq + j * 65, (int)(v * 67108864.0f + 0.5f), __ATOMIC_RELAXED, __HIP_MEMORY_SCOPE_WORKGROUP);
                }
            pv_mma(oc, vf, p0, p1);
        }
#pragma unroll
        for (int r = 0; r < 16; ++r) { oc[0][r] *= g_c; oc[1][r] *= g_c; }
        WAITBAR(0);
#pragma unroll
        for (int p = 0; p < 3; ++p) if (p < nw) kv_dma(KW + (size_t)(j0 + p) * 4096, VW + (size_t)(j0 + p) * 4096, ring + p * 16384, w, lane);
    }
    {
        const LAS int* imp = (const LAS int*)(lds + AL_IMP);
        LAS unsigned* selm = (LAS unsigned*)(lds + AL_SEL);
        unsigned um0 = 0u, um1 = 0u;
        for (int qq = 0; qq < 8; ++qq) {
            const int q = w * 8 + qq;
            int v = imp[lane * 65 + q];
            if (lane == 0 || lane == i || lane == i - 1) v = 0x7fffffff; else if (lane > i) v = -1;
            int thr = 0;
#pragma unroll
            for (int bit = 30; bit >= 0; --bit) { const int cand = thr | (1 << bit); if (__popcll(__ballot(v >= cand)) >= 16) thr = cand; }
            const unsigned long long gtm = __ballot(v > thr), eqm = __ballot(v == thr);
            const int need = 16 - __popcll(gtm);
            const bool sel = ((v > thr) || (v == thr && __popcll(eqm & ((1ull << lane) - 1ull)) < need)) && (lane <= i);
            const unsigned long long mk = __ballot(sel);
            if (lane == 0) { selm[q * 2] = (unsigned)mk; selm[q * 2 + 1] = (unsigned)(mk >> 32); }
            um0 |= (unsigned)mk; um1 |= (unsigned)(mk >> 32);
        }
        if (lane == 0) { selm[128 + w * 2] = um0; selm[128 + w * 2 + 1] = um1; }
        asm volatile("s_waitcnt lgkmcnt(0)\n\ts_barrier" ::: "memory");
        stash_store(stash, oc);
        if (w == 0) {
            unsigned a0 = 0u, a1 = 0u;
#pragma unroll
            for (int k = 0; k < 8; ++k) { a0 |= selm[128 + 2 * k]; a1 |= selm[128 + 2 * k + 1]; }
            const unsigned long long um = ((unsigned long long)a1 << 32) | a0;
            LAS int* ul = (LAS int*)(lds + AL_SEL + 1024);
            if ((um >> lane) & 1ull) ul[__popcll(um & ((1ull << lane) - 1ull))] = lane;
            if (lane == 0) ul[64] = __popcll(um);
        }
    }
    const int koff = hi * 1024 + r32 * 16;
#define BAR_V(N) asm volatile("s_waitcnt vmcnt(" #N ")\n\ts_barrier" ::: "memory")
#define NSA_STEP(T, C0, C1, N0, N1) do { const int t_ = (T); \
        if (t_ > 0) asm volatile("s_barrier" ::: "memory");                \
        if (t_ + 3 < n_) { NSA_DMA(t_ + 3); } \
        const int tn_ = min(t_ + 1, n_ - 1); \
        NSA_INIT(tn_, N0, N1); \
        bf16x8 kf_[8], vf_[8]; \
        k_load(kf_, ring + (tn_ & 3) * 16384 + koff); \
        v_load(vf_, ring + (t_ & 3) * 16384 + vlane); \
        if (t_ + 3 < n_) WAITBAR(2); else WAITBAR(0);                           \
        SCHED_FENCE(); \
        lsum_ += exp_tile(C0, C1); \
        qk_mma(N0, N1, kf_, qr); \
        pv_mma(o_, vf_, C0, C1); \
    } while (0)
#define NSA_STREAM() do { \
        WAITBAR(0); \
        f32x16 a0, a1, b0, b1; \
        NSA_INIT(0, a0, a1); \
        qk_tile(a0, a1, ring, qr, r32, hi); \
        if (w >= 4) asm volatile("s_barrier" ::: "memory"); \
        _Pragma("unroll 1") for (int t = 0; t < n_; t += 2) { NSA_STEP(t, a0, a1, b0, b1); if (t + 1 < n_) NSA_STEP(t + 1, b0, b1, a0, a1); } \
        if (w < 4) asm volatile("s_barrier" ::: "memory"); \
    } while (0)
    {
        f32x16 o_[2];
#pragma unroll
        for (int r = 0; r < 16; ++r) { o_[0][r] = 0.f; o_[1][r] = 0.f; }
        float lsum_ = 0.f;
        const int n_ = nw;
#define NSA_DMA(tt) kv_dma(KW + (size_t)(j0 + (tt)) * 4096, VW + (size_t)(j0 + (tt)) * 4096, ring + ((tt) & 3) * 16384, w, lane)
#define NSA_INIT(tt, S0, S1) init_direct(S0, S1, lutw + (639 - (tq - 64 * (j0 + (tt)) - 4 * hi)))
        NSA_STREAM();
#undef NSA_DMA
#undef NSA_INIT
        lsum_ += __shfl_xor(lsum_, 32); const float sc = g_w / lsum_;
        f32x16 ot[2]; stash_load(stash, ot);
#pragma unroll
        for (int r = 0; r < 16; ++r) { ot[0][r] += sc * o_[0][r]; ot[1][r] += sc * o_[1][r]; }
        stash_store(stash, ot);
    }
    WAITBAR(0);
    f32x16 ot[2];
    {
        const LAS unsigned* selm = (const LAS unsigned*)(lds + AL_SEL);
        const LAS int* ul = (const LAS int*)(lds + AL_SEL + 1024);
        const int n_ = __builtin_amdgcn_readfirstlane(ul[64]);
        const unsigned sm0 = selm[(32 * qh + r32) * 2], sm1 = selm[(32 * qh + r32) * 2 + 1];
        f32x16 o_[2];
#pragma unroll
        for (int r = 0; r < 16; ++r) { o_[0][r] = 0.f; o_[1][r] = 0.f; }
        float lsum_ = 0.f;
#define NSA_DMA(tt) do { const int jn_ = __builtin_amdgcn_readfirstlane(ul[(tt)]); kv_dma(KS + (size_t)jn_ * 4096, VS + (size_t)jn_ * 4096, ring + ((tt) & 3) * 16384, w, lane); } while (0)
#define NSA_INIT(tt, S0, S1) do { const int jA_ = __builtin_amdgcn_readfirstlane(ul[(tt)]); \
            const bool selbit_ = (jA_ < 32) ? ((sm0 >> jA_) & 1u) : ((sm1 >> (jA_ - 32)) & 1u); \
            if (t0 + 32 * qh - (64 * jA_ + 63) >= 1513) { const float c_ = selbit_ ? cfar : NEGF; \
                _Pragma("unroll") for (int r = 0; r < 16; ++r) { S0[r] = c_; S1[r] = c_; } } \
            else init_direct(S0, S1, selbit_ ? (luts + ((LUTN - 1) - (tq - 64 * jA_ - 4 * hi))) : negp); } while (0)
        for (int p = 0; p < 3; ++p) if (p < n_) NSA_DMA(p);
        NSA_STREAM();
#undef NSA_DMA
#undef NSA_INIT
        lsum_ += __shfl_xor(lsum_, 32); const float sc = g_s / lsum_;
        stash_load(stash, ot);
#pragma unroll
        for (int r = 0; r < 16; ++r) { ot[0][r] += sc * o_[0][r]; ot[1][r] += sc * o_[1][r]; }
    }
#undef NSA_STEP
#undef NSA_STREAM
    { bf16_t* O = (bf16_t*)(ws + WS_OA) + (size_t)(b * SEQ + tq) * 512 + head * 64 + 4 * hi;
#pragma unroll
      for (int db = 0; db < 2; ++db)
#pragma unroll
          for (int g4 = 0; g4 < 4; ++g4) { u32x2 v; v.x = pk2(ot[db][4 * g4], ot[db][4 * g4 + 1]); v.y = pk2(ot[db][4 * g4 + 2], ot[db][4 * g4 + 3]); *(u32x2*)(O + 32 * db + 8 * g4) = v; } }
}

__device__ __forceinline__ void dil_unit(const Frame& F, int L, int u) {
    LAS char* lds = (LAS char*)F.lds;
    int tid_l = F.tid; asm volatile("" : "+v"(tid_l));
    const int tid = tid_l, lane = tid & 63, w = __builtin_amdgcn_readfirstlane(tid >> 6), r32 = lane & 31, hi = lane >> 5;
    const int half = w >> 2, wh = w & 3, th = tid & 255;
    const int pair = u & 15, br = (u >> 4) % 3, head = (u / 48) & 7, b = u / 384;
    const int dil = (br == 0) ? 1 : (br == 1) ? 4 : 16, nb = 32 / dil;
    const int beta = 2 * pair + half, res = beta / nb, n = beta % nb;
    unsigned char* ws = F.ws;
    const size_t hoff = (size_t)(b * 8 + head) * SEQ * 64;
    const bf16_t *Q = (const bf16_t*)(ws + WS_QB) + hoff, *K = (const bf16_t*)(ws + WS_KB) + hoff, *V = (const bf16_t*)(ws + WS_VB) + hoff;
    const float* LUTG = (const float*)(ws + WS_LUT) + (size_t)(L * 16 + 8 + head) * LUTN;
    LAS float* lutd = (LAS float*)(lds + AL_DLUT);
    __syncthreads();
    if (tid < 321) { const int nd = 224 - tid; lutd[tid] = (nd < 0 || nd > 128) ? NEGF : LUTG[min(nd * dil, LUTN - 1)]; }
    const int P = 128 * n + 32 * wh + r32, tq = P * dil + res;
    bf16x8 qr[4];
    { const bf16_t* Qp = Q + (size_t)tq * 64;
#pragma unroll
      for (int d0 = 0; d0 < 4; ++d0) qr[d0] = *(const bf16x8*)(Qp + d0 * 16 + hi * 8); }
    LAS char* kvb = lds + AL_KV + half * 32768;
    const LAS char* vboff = (const LAS char*)(kvb + 8192 + ((lane >> 4) & 1) * 32 + (lane & 3) * 8 + (4 * hi + ((lane & 15) >> 2)) * 64);
    f32x16 o[2];
#pragma unroll
    for (int r = 0; r < 16; ++r) { o[0][r] = 0.f; o[1][r] = 0.f; }
    float lsum = 0.f;
    const int tt0 = (n == 0) ? 2 : 0;
    u32x4 rk[2], rv[2];
#define DIL_LOAD(tt) do { const int Pk0 = 128 * (n - 1) + 64 * (tt); if (Pk0 >= 0) { _Pragma("unroll") for (int k = 0; k < 2; ++k) { const int c = th + 256 * k; \
        rk[k] = *(const u32x4*)(K + (size_t)((Pk0 + (c & 63)) * dil + res) * 64 + (c >> 6) * 8); \
        rv[k] = *(const u32x4*)(V + (size_t)((Pk0 + ((c >> 2) & 63)) * dil + res) * 64 + (c >> 8) * 32 + (c & 3) * 8); } } } while (0)
#define DIL_STORE(bufi) do { _Pragma("unroll") for (int k = 0; k < 2; ++k) { const int c = th + 256 * k; *(LAS u32x4*)(kvb + (bufi) * 16384 + c * 16) = rk[k]; *(LAS u32x4*)(kvb + (bufi) * 16384 + 8192 + c * 16) = rv[k]; } } while (0)
    DIL_LOAD(0); DIL_STORE(0); __syncthreads();
#pragma unroll 1
    for (int tt = 0; tt < 4; ++tt) {
        if (tt + 1 < 4) DIL_LOAD(tt + 1);
        const int ndmax = 128 + 32 * wh + 31 - 64 * tt, ndmin = 128 + 32 * wh - 64 * tt - 63;
        if (tt >= tt0 && ndmax >= 0 && ndmin <= 128) {
            const LAS char* buf = kvb + (tt & 1) * 16384;
            f32x16 p0, p1;
            init_direct(p0, p1, lutd + (224 - (128 + 32 * wh + r32 - 64 * tt - 4 * hi)));
            bf16x8 vf[8];
            qk_tile(p0, p1, buf, qr, r32, hi);
            v_load(vf, vboff + (tt & 1) * 16384); SCHED_FENCE();
            lsum += exp_tile(p0, p1);
            pv_mma(o, vf, p0, p1);
        }
        if (tt + 1 < 4) DIL_STORE((tt + 1) & 1);
        __syncthreads();
    }
#undef DIL_LOAD
#undef DIL_STORE
    const float lt = lsum + __shfl_xor(lsum, 32), linv = 1.0f / lt;
    const size_t tok = (size_t)b * SEQ + tq;
    if (hi == 0) ((float*)(ws + WS_LSE))[((size_t)br * MTOK + tok) * 8 + head] = (((const float*)(ws + WS_BSH))[L] + __log2f(lt)) * LN2;
    bf16_t* O = (bf16_t*)(ws + WS_OB) + ((size_t)br * MTOK + tok) * 512 + head * 64 + 4 * hi;
#pragma unroll
    for (int db = 0; db < 2; ++db)
#pragma unroll
        for (int g4 = 0; g4 < 4; ++g4) { u32x2 v; v.x = pk2(o[db][4 * g4] * linv, o[db][4 * g4 + 1] * linv); v.y = pk2(o[db][4 * g4 + 2] * linv, o[db][4 * g4 + 3] * linv); *(u32x2*)(O + 32 * db + 8 * g4) = v; }
}

__device__ __forceinline__ void norm_row(const float* xrow, const float* gain, bf16_t* orow, int lane, f32x4 (&v)[4]) {
    float s = 0.f;
#pragma unroll
    for (int j = 0; j < 4; ++j) { v[j] = *(const f32x4*)(xrow + 4 * lane + 256 * j); s += (v[j][0] * v[j][0] + v[j][1] * v[j][1]) + (v[j][2] * v[j][2] + v[j][3] * v[j][3]); }
    const float rstd = __builtin_amdgcn_rsqf(wave_sum(s) * (1.0f / DM) + RMS_EPS);
#pragma unroll
    for (int j = 0; j < 4; ++j) { const f32x4 gg = *(const f32x4*)(gain + 4 * lane + 256 * j); v[j] = v[j] * rstd * gg;
        u32x2 o; o.x = pk2(v[j][0], v[j][1]); o.y = pk2(v[j][2], v[j][3]); *(u32x2*)(orow + 4 * lane + 256 * j) = o; }
}

__device__ __forceinline__ void norm_row_b(const bf16_t* xrow, const float* gain, bf16_t* orow, int lane, f32x4 (&v)[4]) {
    float s = 0.f;
#pragma unroll
    for (int j = 0; j < 4; ++j) { const u32x2 a = *(const u32x2*)(xrow + 4 * lane + 256 * j); v[j] = (f32x4){bflo(a.x), bfhi(a.x), bflo(a.y), bfhi(a.y)}; s += (v[j][0] * v[j][0] + v[j][1] * v[j][1]) + (v[j][2] * v[j][2] + v[j][3] * v[j][3]); }
    const float rstd = __builtin_amdgcn_rsqf(wave_sum(s) * (1.0f / DM) + RMS_EPS);
#pragma unroll
    for (int j = 0; j < 4; ++j) { const f32x4 gg = *(const f32x4*)(gain + 4 * lane + 256 * j); v[j] = v[j] * rstd * gg;
        *(unsigned*)((unsigned char*)orow + 4 * lane + 256 * j) = pk4_fp8(v[j][0] * FP8_ASCALE, v[j][1] * FP8_ASCALE, v[j][2] * FP8_ASCALE, v[j][3] * FP8_ASCALE); }
}
template <int RB> __device__ __forceinline__ void norm_rows(const float* X, const float* gain, bf16_t* U, int m0, int mstride, int lane) {
    f32x4 v[RB][4];
#pragma unroll
    for (int r = 0; r < RB; ++r)
#pragma unroll
        for (int j = 0; j < 4; ++j) v[r][j] = *(const f32x4*)(X + (size_t)(m0 + r * mstride) * DM + 4 * lane + 256 * j);
    f32x4 gg[4];
#pragma unroll
    for (int j = 0; j < 4; ++j) gg[j] = *(const f32x4*)(gain + 4 * lane + 256 * j);
#pragma unroll
    for (int r = 0; r < RB; ++r) {
        float s2 = 0.f;
#pragma unroll
        for (int j = 0; j < 4; ++j) s2 += (v[r][j][0] * v[r][j][0] + v[r][j][1] * v[r][j][1]) + (v[r][j][2] * v[r][j][2] + v[r][j][3] * v[r][j][3]);
        const float rstd = __builtin_amdgcn_rsqf(wave_sum(s2) * (1.0f / DM) + RMS_EPS);
        bf16_t* orow = U + (size_t)(m0 + r * mstride) * DM;
#pragma unroll
        for (int j = 0; j < 4; ++j) { const f32x4 x = v[r][j] * rstd * gg[j]; u32x2 o; o.x = pk2(x[0], x[1]); o.y = pk2(x[2], x[3]); *(u32x2*)(orow + 4 * lane + 256 * j) = o; }
    }
}

__device__ __forceinline__ void moe_combine(unsigned char* ws, float* out, int ncw, int cw0, bool want_tail) {
    const bf16_t* HB = (const bf16_t*)(ws + WS_HB);
    int tid_l_ = threadIdx.x; asm volatile("" : "+v"(tid_l_)); const int lane = tid_l_ & 63, wave = __builtin_amdgcn_readfirstlane(tid_l_ >> 6), cw = cw0 + wave;
    const int* tokpos = (const int*)(ws + RT_TOKPOS); const float* topG = (const float*)(ws + RT_TOPG); const bf16_t* Y = (const bf16_t*)(ws + WS_VSORT);
    for (int mb = cw; mb < MTOK; mb += 2 * ncw) {
        int pa[2], pb2[2]; float ga[2], gb[2]; bool act[2];
#pragma unroll
        for (int r = 0; r < 2; ++r) { const int m = mb + r * ncw; act[r] = (m < MTOK); const int mm = act[r] ? m : 0; pa[r] = tokpos[mm * 2]; pb2[r] = tokpos[mm * 2 + 1]; ga[r] = topG[mm * 2]; gb[r] = topG[mm * 2 + 1];
            act[r] = act[r] && (((pa[r] >= 65536) || (pb2[r] >= 65536)) == want_tail); }
        if (!(act[0] || act[1])) continue;
        u32x2 hv[2][4]; u32x2 ya[2][4], yb[2][4];
#pragma unroll
        for (int r = 0; r < 2; ++r) if (act[r]) { const int m = mb + r * ncw; const bf16_t* o = HB + (size_t)m * DM; const bf16_t* y0 = Y + (size_t)pa[r] * DM; const bf16_t* y1 = Y + (size_t)pb2[r] * DM;
#pragma unroll
            for (int j = 0; j < 4; ++j) { const int c = 4 * lane + 256 * j; hv[r][j] = *(const u32x2*)(o + c); ya[r][j] = *(const u32x2*)(y0 + c); yb[r][j] = *(const u32x2*)(y1 + c); } }
#pragma unroll
        for (int r = 0; r < 2; ++r) if (act[r]) { const int m = mb + r * ncw; float* o = out + (size_t)m * DM; const float g0 = ga[r], g1 = gb[r];
#pragma unroll
            for (int j = 0; j < 4; ++j) { const int c = 4 * lane + 256 * j; const u32x2 hb = hv[r][j]; f32x4 v = (f32x4){bflo(hb.x), bfhi(hb.x), bflo(hb.y), bfhi(hb.y)}; const u32x2 a = ya[r][j], b = yb[r][j];
                v[0] += g0 * bflo(a.x) + g1 * bflo(b.x); v[1] += g0 * bfhi(a.x) + g1 * bfhi(b.x); v[2] += g0 * bflo(a.y) + g1 * bflo(b.y); v[3] += g0 * bfhi(a.y) + g1 * bfhi(b.y);
                *(f32x4*)(o + c) = v; } }
    }
}

template <int RB, bool FP8OUT = false> __device__ __forceinline__ void norm_rows_b(const bf16_t* X, const float* gain, void* Uv, int m0, int mstride, int lane) {
    bf16_t* U = (bf16_t*)Uv;
    u32x4 x[RB][2];
#pragma unroll
    for (int r = 0; r < RB; ++r)
#pragma unroll
        for (int j = 0; j < 2; ++j) x[r][j] = *(const u32x4*)(X + (size_t)(m0 + r * mstride) * DM + 8 * lane + 512 * j);
    f32x4 gg[2][2];
#pragma unroll
    for (int j = 0; j < 2; ++j) { gg[j][0] = *(const f32x4*)(gain + 8 * lane + 512 * j); gg[j][1] = *(const f32x4*)(gain + 8 * lane + 512 * j + 4); }
#pragma unroll
    for (int r = 0; r < RB; ++r) {
        float v[2][8]; float s2 = 0.f;
#pragma unroll
        for (int j = 0; j < 2; ++j) { const u32x4 a = x[r][j]; v[j][0] = bflo(a.x); v[j][1] = bfhi(a.x); v[j][2] = bflo(a.y); v[j][3] = bfhi(a.y); v[j][4] = bflo(a.z); v[j][5] = bfhi(a.z); v[j][6] = bflo(a.w); v[j][7] = bfhi(a.w);
#pragma unroll
            for (int c = 0; c < 8; ++c) s2 += v[j][c] * v[j][c]; }
        const float rstd = __builtin_amdgcn_rsqf(wave_sum(s2) * (1.0f / DM) + RMS_EPS);
        if constexpr (FP8OUT) { unsigned char* orow = (unsigned char*)Uv + (size_t)(m0 + r * mstride) * DM; const float rs = rstd * FP8_ASCALE;
#pragma unroll
            for (int j = 0; j < 2; ++j) { u32x2 o; o.x = pk4_fp8(v[j][0] * rs * gg[j][0][0], v[j][1] * rs * gg[j][0][1], v[j][2] * rs * gg[j][0][2], v[j][3] * rs * gg[j][0][3]);
                o.y = pk4_fp8(v[j][4] * rs * gg[j][1][0], v[j][5] * rs * gg[j][1][1], v[j][6] * rs * gg[j][1][2], v[j][7] * rs * gg[j][1][3]); *(u32x2*)(orow + 8 * lane + 512 * j) = o; } }
        else { bf16_t* orow = U + (size_t)(m0 + r * mstride) * DM;
#pragma unroll
        for (int j = 0; j < 2; ++j) { u32x4 o; o.x = pk2(v[j][0] * rstd * gg[j][0][0], v[j][1] * rstd * gg[j][0][1]); o.y = pk2(v[j][2] * rstd * gg[j][0][2], v[j][3] * rstd * gg[j][0][3]);
            o.z = pk2(v[j][4] * rstd * gg[j][1][0], v[j][5] * rstd * gg[j][1][1]); o.w = pk2(v[j][6] * rstd * gg[j][1][2], v[j][7] * rstd * gg[j][1][3]); *(u32x4*)(orow + 8 * lane + 512 * j) = o; } }
    }
}

__global__ void __launch_bounds__(NTHR, 2) trunk_fwd(Args args) {
    extern __shared__ __attribute__((aligned(16))) unsigned char lds_raw[];
    Frame F;
    F.lds = (LAS unsigned char*)lds_raw;
    F.tid = threadIdx.x; F.lane = F.tid & 63; F.wave = __builtin_amdgcn_readfirstlane(F.tid >> 6);
    F.G = gridDim.x; F.wg = blockIdx.x; F.ws = args.ws; F.in = args.in; F.out = args.out;
    unsigned char* ws = args.ws;
    volatile LAS unsigned* MISC = (volatile LAS unsigned*)(F.lds + LDSCTL_OFF);
    for (int u = F.tid; u < (LDS_BYTES - LDSCTL_OFF) / 4; u += NTHR) ((LAS unsigned*)(F.lds + LDSCTL_OFF))[u] = 0u;
    __syncthreads();
    unsigned* ctl = (unsigned*)(ws + WS_CTL);
    XcdBarrier bar; bar.bar = ctl + CW_BAR + args.li * 4096; bar.x = 0; bar.st = nullptr;
    if (!MK_MULTI) bar = xcd_barrier_post(ctl + CW_BAR + args.li * 4096, MISC + 8);
    const int lo = args.ph_lo, hi_ = args.ph_hi;
#define IN(k) (lo <= (k) && (k) < hi_)
#define EN(g) (((PHMASK) >> (g)) & 1u)
#define NREP(g) ((((PROBE_DUP) >> (g)) & 1u) && L == 0 ? 2 : 1)
#define NREPX(g) ((((PROBE_DUP) >> (g)) & 1u) ? 2 : 1)
#define SEAM(k) do { if (IN(k) && IN((k) + 1)) { xcd_barrier(bar); if (PROBE_BAR) xcd_barrier(bar); } } while (0)
    const int NGW = F.G * NWAVES;
#define LAUNDER int tid_l_ = threadIdx.x; asm volatile("" : "+v"(tid_l_)); const int tid = tid_l_, lane = tid & 63, wave = __builtin_amdgcn_readfirstlane(tid >> 6), gw = F.wg * NWAVES + wave; (void)gw; (void)lane; (void)wave;

    if (EN(0) && IN(0)) { LAUNDER;
        LAS float* scr = (LAS float*)(F.lds + wave * 16384);
        for (int rep = 0; rep < NREPX(0); ++rep) for (int L = 0; L < 2; ++L) {
            conv_inproj(args.in[I_WIN] + (size_t)L * DM * IN_W, (bf16_t*)(ws + WS_WIN) + (size_t)L * INP * DM, scr, gw, NGW, lane);
            for (int kv = 0; kv < 2; ++kv) conv_plain(args.in[I_CW1] + (size_t)(L * 2 + kv) * 2048 * 256, 2048, 256, (bf16_t*)(ws + WS_WC1) + (size_t)(L * 2 + kv) * 256 * 2048, scr, gw, NGW, lane);
            conv_plain(args.in[I_WOUT] + (size_t)L * DM * DM, DM, DM, (bf16_t*)(ws + WS_WO) + (size_t)L * DM * DM, scr, gw, NGW, lane);
            for (int kv = 0; kv < 2; ++kv) conv_plain(args.in[I_CW2] + (size_t)(L * 2 + kv) * 256 * 64, 256, 64, (bf16_t*)(ws + WS_WC2) + (size_t)(L * 2 + kv) * 64 * 256, scr, gw, NGW, lane);
        }
        conv_gateup_f8(args.in[I_FG], args.in[I_FU], DM, DFF, ws + WS_WF1, scr, gw, NGW, lane);
        conv_plain<true>(args.in[I_FD], DFF, DM, ws + WS_WF2, scr, gw, NGW, lane);
        { int* rowtok = (int*)(ws + RT_ROWTOK); for (int k = F.wg * NTHR + tid; k < MOE_ROWS_MAX; k += F.G * NTHR) rowtok[k] = -1; }
        { LAS float* bsh = (LAS float*)(F.lds + 8 * 16384);
          if (wave == 0) { const float* rb = args.in[I_RELB]; float bm = 0.f;
              for (int k = lane; k < 512; k += 64) bm = fmaxf(bm, fabsf(rb[k]));
              for (int L = 0; L < 2; ++L) { float gq = fmaxf(fabsf(args.in[I_QN][L * 64 + lane]), fabsf(args.in[I_DQN][L * 64 + lane]));
                  float gk = fmaxf(fmaxf(fabsf(args.in[I_KN][L * 192 + lane]), fabsf(args.in[I_KN][L * 192 + 64 + lane])), fmaxf(fabsf(args.in[I_KN][L * 192 + 128 + lane]), fabsf(args.in[I_DKN][L * 64 + lane])));
                  float bb = bm;
#pragma unroll
                  for (int o = 1; o < 64; o <<= 1) { gq = fmaxf(gq, __shfl_xor(gq, o)); gk = fmaxf(gk, __shfl_xor(gk, o)); bb = fmaxf(bb, __shfl_xor(bb, o)); }
                  const float B = (8.0f * LOG2E * gq * gk + LOG2E * bb) * 1.002f + 0.05f;
                  if (lane == 0) { bsh[L] = B; if (F.wg == 0) ((float*)(ws + WS_BSH))[L] = B; } } }
          __syncthreads();
          float* LUT = (float*)(ws + WS_LUT); const float* rb = args.in[I_RELB];
          for (int k = F.wg * NTHR + tid; k < 2 * 16 * LUTN; k += F.G * NTHR) { const int L = k / (16 * LUTN), h = (k / LUTN) & 15, d = k % LUTN; int bk;
              if (d < 16) bk = d; else { bk = 16; bk += (d >= 22); bk += (d >= 30); bk += (d >= 40); bk += (d >= 54); bk += (d >= 73); bk += (d >= 99); bk += (d >= 134); bk += (d >= 182);
                  bk += (d >= 246); bk += (d >= 332); bk += (d >= 450); bk += (d >= 609); bk += (d >= 825); bk += (d >= 1117); bk += (d >= 1513); }
              LUT[k] = rb[bk * 16 + h] * LOG2E - bsh[L]; } }
        { float* B1P = (float*)(ws + WS_B1P);
          for (int it = gw; it < 2 * 2 * 16 * 4; it += NGW) { const int cg = it & 3, s = (it >> 2) & 15, lk = it >> 6;
              const float* pos = args.in[I_CPOS] + (size_t)lk * 2048 + s * 128; const float* w1 = args.in[I_CW1] + (size_t)lk * 2048 * 256 + (size_t)s * 128 * 256 + cg * 64 + lane;
              float a = 0.f;
              for (int p = 0; p < 128; ++p) a += pos[p] * w1[(size_t)p * 256];
              B1P[((size_t)lk * 16 + s) * 256 + cg * 64 + lane] = a; } }
    }

    for (int L = 0; L < 2; ++L) {
        const int pb = 1 + 10 * L;
        bf16_t* HB = (bf16_t*)(ws + WS_HB);
        if (EN(1) && IN(pb + 0)) { LAUNDER;
            bf16_t* U = (bf16_t*)(ws + WS_U); const float* gain = args.in[I_ANORM] + L * DM;
            if (L == 0) { for (int rep = 0; rep < NREP(1); ++rep) for (int m = gw; m < MTOK; m += 4 * NGW) norm_rows<4>(args.in[I_X], gain, U, m, NGW, lane); }
            else { for (int m = gw; m < MTOK; m += 4 * NGW) norm_rows_b<4>(HB, gain, U, m, NGW, lane); }
        }
        SEAM(pb + 0);
        if (EN(2) && IN(pb + 1)) {
            { LAUNDER;
            if (F.wg == 0) { const int kv = tid >> 8, j = tid & 255; const float* B1P = (const float*)(ws + WS_B1P) + (size_t)(L * 2 + kv) * 16 * 256;
                float a = args.in[I_CB1][(L * 2 + kv) * 256 + j];
                for (int s = 0; s < 16; ++s) a += B1P[s * 256 + j];
                ((float*)(ws + WS_B1E))[(L * 2 + kv) * 256 + j] = a; }
            }
            pg8::Dims g{DM, DM, DM}; pg8::StaticOrder S; S.init(MTOK, INP, F.G, F.wg, ws + WS_U, (bf16_t*)(ws + WS_WIN) + (size_t)L * INP * DM, DM, DM);
            EpiInProj E{ws, args.in[I_QN] + L * 64, args.in[I_KN] + L * 192, args.in[I_DQN] + L * 64, args.in[I_DKN] + L * 64};
            for (int rep = 0; rep < NREP(2); ++rep) pg8::gemm_phase<EpiInProj, pg8::StaticOrder>(F.lds, g, S, E);
        }
        SEAM(pb + 1);
        if (IN(pb + 2)) {
            if (F.wg < 32) {
                if (EN(3)) {
                    pg8::Dims g{2048, 1024, 2048}; SchedCmp S{F.wg, (const char*)(ws + WS_KC), (const char*)(ws + WS_VC), (const char*)((bf16_t*)(ws + WS_WC1) + (size_t)L * 2 * 256 * 2048)};
                    EpiCmp1 E{(bf16_t*)(ws + WS_HC), (const float*)(ws + WS_B1E) + L * 2 * 256};
                    pg8::gemm_phase<EpiCmp1, SchedCmp>(F.lds, g, S, E);
                }
                if (EN(4)) { LAUNDER;
                    asm volatile("s_waitcnt vmcnt(0)" ::: "memory"); __syncthreads();
                    __builtin_amdgcn_fence(__ATOMIC_ACQUIRE, "agent"); asm volatile("s_waitcnt vmcnt(0)" ::: "memory");
                    const bf16_t* HC = (const bf16_t*)(ws + WS_HC);
                    const int kv = F.wg >> 4, row0 = kv * 4096 + (F.wg & 15) * 256 + wave * 32, r32 = lane & 31, hi = lane >> 5;
                    const bf16_t* hrow = HC + (size_t)(row0 + r32) * 256 + hi * 8;
                    const bf16_t* wT = (const bf16_t*)(ws + WS_WC2) + (size_t)(L * 2 + kv) * 64 * 256 + (size_t)r32 * 256 + hi * 8;
                    f32x16 o0, o1;
#pragma unroll
                    for (int r = 0; r < 16; ++r) { o0[r] = 0.f; o1[r] = 0.f; }
#pragma unroll
                    for (int sk = 0; sk < 16; ++sk) { const bf16x8 bf = *(const bf16x8*)(hrow + 16 * sk), a0 = *(const bf16x8*)(wT + 16 * sk), a1 = *(const bf16x8*)(wT + 32 * 256 + 16 * sk);
                        o0 = mfma32(a0, bf, o0); o1 = mfma32(a1, bf, o1); }
                    if (kv == 0) { float ss = 0.f;
#pragma unroll
                        for (int r = 0; r < 16; ++r) ss += o0[r] * o0[r] + o1[r] * o1[r];
                        ss += __shfl_xor(ss, 32); const float rs = __builtin_amdgcn_rsqf(ss * (1.0f / 64.0f) + RMS_EPS); const float* gn = args.in[I_KN] + L * 192;
#pragma unroll
                        for (int r = 0; r < 16; ++r) { const int d = (r & 3) + 8 * (r >> 2) + 4 * hi; o0[r] *= rs * gn[d]; o1[r] *= rs * gn[d + 32]; } }
                    const int rr = (row0 + r32) & 4095; const float z = ((rr & 255) == 255) ? 0.f : 1.f;
                    bf16_t* dst = (bf16_t*)(ws + (kv ? WS_VCC : WS_KCC)) + (size_t)rr * 64 + 4 * hi;
#pragma unroll
                    for (int g4 = 0; g4 < 4; ++g4) { u32x2 v; v.x = pk2(o0[4 * g4] * z, o0[4 * g4 + 1] * z); v.y = pk2(o0[4 * g4 + 2] * z, o0[4 * g4 + 3] * z); *(u32x2*)(dst + 8 * g4) = v;
                        u32x2 w2; w2.x = pk2(o1[4 * g4] * z, o1[4 * g4 + 1] * z); w2.y = pk2(o1[4 * g4 + 2] * z, o1[4 * g4 + 3] * z); *(u32x2*)(dst + 32 + 8 * g4) = w2; }
                }
            } else if (EN(6)) {
                for (int k = 0; k < DIL_EARLY; ++k) dil_unit(F, L, (F.wg - 32) * DIL_EARLY + k);
                __syncthreads();
            }
        }
        SEAM(pb + 2);
        if (IN(pb + 4)) {
            if (EN(5) && F.wg < 512) nsa_prepare(F, L, F.wg & 1);
            if (EN(5)) for (int rep = 0; rep < NREP(5); ++rep) for (int p = F.wg; p < 512; p += F.G) { const int bg = (p & 7) + 8 * (p >> 8), s = (p >> 3) & 31; nsa_unit(F, L, bg >> 1, bg & 1, s); nsa_unit(F, L, bg >> 1, bg & 1, 63 - s); }
            if (EN(6)) for (int rep = 0; rep < NREP(6); ++rep) for (int u = (F.G - 32) * DIL_EARLY + F.wg; u < 3072; u += F.G) dil_unit(F, L, u);
            __syncthreads();
        }
        SEAM(pb + 4);
        if (EN(7) && IN(pb + 5)) { LAUNDER;
            bf16_t* ON = (bf16_t*)(ws + WS_U); const float* og = args.in[I_ONORM] + L * DM;
            const bf16_t* OA = (const bf16_t*)(ws + WS_OA); const bf16_t* OB = (const bf16_t*)(ws + WS_OB); const float* LSE = (const float*)(ws + WS_LSE);
            const f32x4 ga0 = *(const f32x4*)(og + 8 * lane), ga1 = *(const f32x4*)(og + 8 * lane + 4), gb0 = *(const f32x4*)(og + 512 + 8 * lane), gb1 = *(const f32x4*)(og + 512 + 8 * lane + 4);
            const int hd = lane >> 3;
            for (int rep = 0; rep < NREP(7); ++rep) for (int mb = gw; mb < MTOK; mb += 4 * NGW) {
                u32x4 xa[4], x0[4], x1[4], x2[4]; float q0[4], q1[4], q2[4];
#pragma unroll
                for (int r = 0; r < 4; ++r) { const size_t m = (size_t)(mb + r * NGW);
                    xa[r] = *(const u32x4*)(OA + m * 512 + 8 * lane);
                    x0[r] = *(const u32x4*)(OB + ((size_t)0 * MTOK + m) * 512 + 8 * lane); x1[r] = *(const u32x4*)(OB + ((size_t)1 * MTOK + m) * 512 + 8 * lane); x2[r] = *(const u32x4*)(OB + ((size_t)2 * MTOK + m) * 512 + 8 * lane);
                    q0[r] = LSE[((size_t)0 * MTOK + m) * 8 + hd]; q1[r] = LSE[((size_t)1 * MTOK + m) * 8 + hd]; q2[r] = LSE[((size_t)2 * MTOK + m) * 8 + hd]; }
#pragma unroll
                for (int r = 0; r < 4; ++r) { const size_t m = (size_t)(mb + r * NGW);
                    { const u32x4 a = xa[r];
                      float v[8] = {bflo(a.x), bfhi(a.x), bflo(a.y), bfhi(a.y), bflo(a.z), bfhi(a.z), bflo(a.w), bfhi(a.w)};
                      float s2 = 0.f;
#pragma unroll
                      for (int c = 0; c < 8; ++c) s2 += v[c] * v[c];
                      const float rstd = __builtin_amdgcn_rsqf(wave_sum(s2) * (1.0f / 512.0f) + RMS_EPS);
                      u32x4 o; o.x = pk2(v[0] * rstd * ga0[0], v[1] * rstd * ga0[1]); o.y = pk2(v[2] * rstd * ga0[2], v[3] * rstd * ga0[3]); o.z = pk2(v[4] * rstd * ga1[0], v[5] * rstd * ga1[1]); o.w = pk2(v[6] * rstd * ga1[2], v[7] * rstd * ga1[3]);
                      *(u32x4*)(ON + m * DM + 8 * lane) = o; }
                    { const float l0 = q0[r], l1 = q1[r], l2 = q2[r];
                      const float mx = fmaxf(l0, fmaxf(l1, l2)); const float e0 = __expf(l0 - mx), e1 = __expf(l1 - mx), e2 = __expf(l2 - mx); const float inv = __builtin_amdgcn_rcpf(e0 + e1 + e2);
                      const float w0 = e0 * inv, w1 = e1 * inv, w2 = e2 * inv;
                      const u32x4 a0 = x0[r], a1 = x1[r], a2 = x2[r];
                      float v[8];
                      v[0] = w0 * bflo(a0.x) + w1 * bflo(a1.x) + w2 * bflo(a2.x); v[1] = w0 * bfhi(a0.x) + w1 * bfhi(a1.x) + w2 * bfhi(a2.x);
                      v[2] = w0 * bflo(a0.y) + w1 * bflo(a1.y) + w2 * bflo(a2.y); v[3] = w0 * bfhi(a0.y) + w1 * bfhi(a1.y) + w2 * bfhi(a2.y);
                      v[4] = w0 * bflo(a0.z) + w1 * bflo(a1.z) + w2 * bflo(a2.z); v[5] = w0 * bfhi(a0.z) + w1 * bfhi(a1.z) + w2 * bfhi(a2.z);
                      v[6] = w0 * bflo(a0.w) + w1 * bflo(a1.w) + w2 * bflo(a2.w); v[7] = w0 * bfhi(a0.w) + w1 * bfhi(a1.w) + w2 * bfhi(a2.w);
                      float s2 = 0.f;
#pragma unroll
                      for (int c = 0; c < 8; ++c) s2 += v[c] * v[c];
                      const float rstd = __builtin_amdgcn_rsqf(wave_sum(s2) * (1.0f / 512.0f) + RMS_EPS);
                      u32x4 o; o.x = pk2(v[0] * rstd * gb0[0], v[1] * rstd * gb0[1]); o.y = pk2(v[2] * rstd * gb0[2], v[3] * rstd * gb0[3]); o.z = pk2(v[4] * rstd * gb1[0], v[5] * rstd * gb1[1]); o.w = pk2(v[6] * rstd * gb1[2], v[7] * rstd * gb1[3]);
                      *(u32x4*)(ON + m * DM + 512 + 8 * lane) = o; }
                }
            }
        }
        SEAM(pb + 5);
        if (EN(8) && IN(pb + 6)) {
            pg8::Dims g{DM, DM, DM}; pg8::StaticOrder S; S.init(MTOK, DM, F.G, F.wg, ws + WS_U, (bf16_t*)(ws + WS_WO) + (size_t)L * DM * DM, DM, DM);
            if (L == 0) { EpiRes<true> E{args.in[I_X], HB}; for (int rep = 0; rep < NREP(8); ++rep) pg8::gemm_phase<EpiRes<true>, pg8::StaticOrder>(F.lds, g, S, E); }
            else { EpiRes<false> E{HB, HB}; pg8::gemm_phase<EpiRes<false>, pg8::StaticOrder>(F.lds, g, S, E); }
        }
        SEAM(pb + 6);
        if (EN(9) && IN(pb + 7)) { LAUNDER;
            bf16_t* U = (bf16_t*)(ws + WS_U); const float* gain = args.in[I_FNORM] + L * DM;
            if (L == 0) {
                for (int m = gw; m < MTOK; m += 4 * NGW) norm_rows_b<4, true>(HB, gain, U, m, NGW, lane);
            } else {
                LAS int* lcnt = (LAS int*)(F.lds);
                if (tid < 8) lcnt[tid] = 0;
                __syncthreads();
                const float* rw = args.in[I_RW];
                int* topE = (int*)(ws + RT_TOPE); float* topG = (float*)(ws + RT_TOPG);
                const int per = MTOK / F.G, perw = per / NWAVES;
                for (int q = 0; q < perw; q += 2) { const int m0 = F.wg * per + wave * perw + q;
                    f32x4 v[2][4];
#pragma unroll
                    for (int t2 = 0; t2 < 2; ++t2) norm_row_b(HB + (size_t)(m0 + t2) * DM, gain, (bf16_t*)((unsigned char*)U + (size_t)(m0 + t2) * DM), lane, v[t2]);
                    float lg[2][8];
#pragma unroll
                    for (int t2 = 0; t2 < 2; ++t2)
#pragma unroll
                        for (int e = 0; e < 8; ++e) lg[t2][e] = 0.f;
#pragma unroll
                    for (int j = 0; j < 4; ++j)
#pragma unroll
                        for (int c = 0; c < 4; ++c) { const float* rr = rw + (size_t)(4 * lane + 256 * j + c) * 8; const f32x4 r0 = *(const f32x4*)rr, r1 = *(const f32x4*)(rr + 4);
#pragma unroll
                            for (int t2 = 0; t2 < 2; ++t2) { const float x = v[t2][j][c];
                                lg[t2][0] += x * r0[0]; lg[t2][1] += x * r0[1]; lg[t2][2] += x * r0[2]; lg[t2][3] += x * r0[3]; lg[t2][4] += x * r1[0]; lg[t2][5] += x * r1[1]; lg[t2][6] += x * r1[2]; lg[t2][7] += x * r1[3]; } }
#pragma unroll
                    for (int e = 0; e < 8; ++e) { lg[0][e] = wave_sum(lg[0][e]); lg[1][e] = wave_sum(lg[1][e]); }
#pragma unroll
                    for (int t2 = 0; t2 < 2; ++t2) { const int m = m0 + t2;
                        int e1 = 0; float l1 = lg[t2][0];
#pragma unroll
                        for (int e = 1; e < 8; ++e) if (lg[t2][e] > l1) { l1 = lg[t2][e]; e1 = e; }
                        int e2 = -1; float l2 = -3.0e38f;
#pragma unroll
                        for (int e = 0; e < 8; ++e) if (e != e1 && lg[t2][e] > l2) { l2 = lg[t2][e]; e2 = e; }
                        const float g2 = 1.0f / (1.0f + __expf(l1 - l2)), g1 = 1.0f - g2;
                        if (lane == 0) { topE[m * 2] = e1; topE[m * 2 + 1] = e2; topG[m * 2] = g1; topG[m * 2 + 1] = g2; __hip_atomic_fetch_add(&lcnt[e1], 1, __ATOMIC_RELAXED, __HIP_MEMORY_SCOPE_WORKGROUP); __hip_atomic_fetch_add(&lcnt[e2], 1, __ATOMIC_RELAXED, __HIP_MEMORY_SCOPE_WORKGROUP); } }
                }
                __syncthreads();
                if (tid < 8) ((int*)(ws + RT_CNT))[F.wg * 8 + tid] = lcnt[tid];
            }
        }
        SEAM(pb + 7);
        if (L == 0) {
            if (EN(10) && IN(pb + 8)) {
                pg8::Dims g{DM, DM, DM}; pg8::StaticOrder S; S.init(MTOK, 2 * DFF, F.G, F.wg, ws + WS_U, ws + WS_WF1, DM, DM, 1);
                EpiSwigluF8 E{ws + WS_ACT0, DFF, 0};
                for (int rep = 0; rep < NREP(10); ++rep) pg8::gemm_phase_f8d<EpiSwigluF8, pg8::StaticOrder>(F.lds, g, S, E);
            }
            SEAM(pb + 8);
            if (EN(11) && IN(pb + 9)) {
                pg8::Dims g{DFF, DFF, DFF}; pg8::StaticOrder S; S.init(MTOK, DM, F.G, F.wg, ws + WS_ACT0, ws + WS_WF2, DFF, DFF, 1);
                EpiResF8 E{HB};
                pg8::gemm_phase_f8d<EpiResF8, pg8::StaticOrder>(F.lds, g, S, E);
            }
            SEAM(pb + 9);
        }
    }
    if (EN(12) && IN(19)) { LAUNDER;
        LAS int* lc = (LAS int*)(F.lds);
        LAS int* mybase = lc + 2048;
        LAS int* wcnt = mybase + 8;
        LAS int* posl = wcnt + 32;
        const int* cnt = (const int*)(ws + RT_CNT);
        const int nwg = F.G;
        for (int k = tid; k < nwg * 8; k += NTHR) lc[k] = cnt[k];
        __syncthreads();
        if (tid < 8) { int tot = 0, before = 0; for (int w2 = 0; w2 < nwg; ++w2) { if (w2 == F.wg) before = tot; tot += lc[w2 * 8 + tid]; } wcnt[tid] = tot; mybase[tid] = before; }
        __syncthreads();
        if (tid == 0) { int ps = 0; int pst[9]; for (int e = 0; e < 8; ++e) { pst[e] = ps; ps += (wcnt[e] + 255) & ~255; } pst[8] = ps;
            for (int e = 0; e < 8; ++e) mybase[e] += pst[e];
            if (F.wg == 0) { int* P = (int*)(ws + RT_PSTART); for (int e = 0; e < 9; ++e) P[e] = pst[e]; P[9] = ps >> 8; } }
        __syncthreads();
        const int per = MTOK / F.G;
        const int* topE = (const int*)(ws + RT_TOPE); const float* topG = (const float*)(ws + RT_TOPG);
        int myE = -1, myTok = 0; float myG = 0.f; int rank = 0;
        if (tid < 2 * per) { myTok = F.wg * per + (tid >> 1); myE = topE[myTok * 2 + (tid & 1)]; myG = topG[myTok * 2 + (tid & 1)]; }
        if (wave < 4) {
#pragma unroll
            for (int e = 0; e < 8; ++e) { const unsigned long long bm = __ballot(myE == e); if (myE == e) rank = __popcll(bm & ((1ull << lane) - 1ull)); if (lane == 0) wcnt[wave * 8 + e] = __popcll(bm); }
        }
        __syncthreads();
        if (tid < 2 * per) { int pos = mybase[myE] + rank; for (int w2 = 0; w2 < wave; ++w2) pos += wcnt[w2 * 8 + myE];
            ((int*)(ws + RT_ROWTOK))[pos] = myTok; ((float*)(ws + RT_ROWGATE))[pos] = myG; posl[tid] = pos; ((int*)(ws + RT_TOKPOS))[myTok * 2 + (tid & 1)] = pos; }
        __syncthreads();
        const bf16_t* U = (const bf16_t*)(ws + WS_U); bf16_t* VS = (bf16_t*)(ws + WS_VSORT);
        for (int a = wave; a < 2 * per; a += NWAVES) { const int tok = F.wg * per + (a >> 1), pos = posl[a];
            const u32x4* src = (const u32x4*)((const unsigned char*)U + (size_t)tok * DM); u32x4* dst = (u32x4*)(VS + (size_t)pos * DM);
            dst[lane] = src[lane]; }
    }
    __syncthreads();
    if (EN(13) && IN(20)) { LAUNDER;
        LAS float* scr = (LAS float*)(F.lds + wave * 16384);
        for (int rep = 0; rep < NREPX(13); ++rep) for (int e = 0; e < NEXP; ++e) {
            conv_gateup_f8(args.in[I_EG] + (size_t)e * DM * DFE, args.in[I_EU] + (size_t)e * DM * DFE, DM, DFE, ws + WS_WE1 + (size_t)e * 7168 * DM, scr, gw, NGW, lane);
            conv_plain<true>(args.in[I_ED] + (size_t)e * DFE * DM, DFE, DM, ws + WS_WE2 + (size_t)e * DM * DFE, scr, gw, NGW, lane);
        }
    }
    SEAM(20);
    for (int gi = 0; gi < 4; ++gi) {
        const int* P = (const int*)(ws + RT_PSTART);
        if (EN(14) && IN(21 + 2 * gi)) {
            const int nchunks = __builtin_amdgcn_readfirstlane(P[9]);
            pg8::Dims g{DM, 2 * DM, DM}; SchedMoe1 S{F.wg, F.G, gi * MOE_GROUP, MOE_GROUP, nchunks, P, (const char*)(ws + WS_VSORT), (const char*)(ws + WS_WE1)};
            EpiSwigluF8 E{(unsigned char*)args.out, DFE, gi * MOE_GROUP};
            for (int rep = 0; rep < NREPX(14); ++rep) pg8::gemm_phase_f8d<EpiSwigluF8, SchedMoe1>(F.lds, g, S, E);
        }
        SEAM(21 + 2 * gi);
        if (EN(15) && IN(22 + 2 * gi)) {
            const int nchunks = __builtin_amdgcn_readfirstlane(P[9]);
            { pg8::Dims g{DFE, DFE, DFE}; SchedMoe2 S{F.wg, F.G, gi * MOE_GROUP, MOE_GROUP, nchunks, P, (const char*)args.out, (const char*)(ws + WS_WE2)};
              EpiMoe2F8 E{(bf16_t*)(ws + WS_VSORT), gi * MOE_GROUP};
              for (int rep = 0; rep < NREPX(15); ++rep) pg8::gemm_phase_f8d<EpiMoe2F8, SchedMoe2>(F.lds, g, S, E); }
            if (gi == 3) { pg8::Dims g{DM, 2 * DM, DM}; SchedMoe1 S{F.wg, F.G, 256, nchunks - 256, nchunks, P, (const char*)(ws + WS_VSORT), (const char*)(ws + WS_WE1)};
              EpiSwigluF8 E{ws + WS_U, DFE, 256};
              pg8::gemm_phase_f8d<EpiSwigluF8, SchedMoe1>(F.lds, g, S, E); }
        }
        SEAM(22 + 2 * gi);
    }
    if (EN(16) && IN(29)) {
        const int* P = (const int*)(ws + RT_PSTART); const int nchunks = __builtin_amdgcn_readfirstlane(P[9]), ntail = nchunks - 256, nmoe = 4 * ntail;
        if ((int)F.wg < nmoe) {
            pg8::Dims g{DFE, DFE, DFE}; SchedMoe2 S{F.wg, F.G, 256, ntail, nchunks, P, (const char*)(ws + WS_U), (const char*)(ws + WS_WE2)};
            EpiMoe2F8 E{(bf16_t*)(ws + WS_VSORT), 256};
            pg8::gemm_phase_f8d<EpiMoe2F8, SchedMoe2>(F.lds, g, S, E);
        } else moe_combine(ws, args.out, (F.G - nmoe) * NWAVES, (F.wg - nmoe) * NWAVES, false);
    }
    SEAM(29);
    if (EN(16) && IN(30)) moe_combine(ws, args.out, F.G * NWAVES, F.wg * NWAVES, true);
#undef IN
#undef SEAM
}

constexpr int N_PHASES = 31;

extern "C" void kernel_launch(void* const* d_in, const int* in_sizes, int n_in, void* d_out, int out_size, void* d_ws, size_t ws_size, hipStream_t stream) {
    static int grid = 0;
    if (grid == 0) {
        if (n_in != 22 || out_size != MTOK * DM || ws_size < WS_END) { fprintf(stderr, "kernel_launch: unexpected shapes (n_in %d out %d ws %zu need %zu)\n", n_in, out_size, ws_size, (size_t)WS_END); grid = -1; return; }
        int dev = 0, cus = 0, per_cu = 0;
        if (hipGetDevice(&dev) != hipSuccess || hipDeviceGetAttribute(&cus, hipDeviceAttributeMultiprocessorCount, dev) != hipSuccess) { grid = -1; return; }
        if (hipFuncSetAttribute((const void*)trunk_fwd, hipFuncAttributeMaxDynamicSharedMemorySize, LDS_BYTES) != hipSuccess) { fprintf(stderr, "kernel_launch: hipFuncSetAttribute failed\n"); grid = -1; return; }
        if (hipOccupancyMaxActiveBlocksPerMultiprocessor(&per_cu, (const void*)trunk_fwd, NTHR, LDS_BYTES) != hipSuccess || per_cu < 1) fprintf(stderr, "kernel_launch: occupancy query reports %d\n", per_cu);
        (void)hipGetLastError();
        grid = cus;
        if (grid > 256) grid = 256;
        if (MTOK % (grid * NWAVES) != 0) { fprintf(stderr, "kernel_launch: grid %d unsupported\n", grid); grid = -1; return; }
    }
    if (grid < 0) return;
    if (hipMemsetAsync((char*)d_ws + WS_CTL, 0, CTL_BYTES, stream) != hipSuccess) return;
    Args a{};
    for (int i = 0; i < 22; ++i) a.in[i] = (const float*)d_in[i];
    a.out = (float*)d_out; a.ws = (unsigned char*)d_ws; a.pad = 0;
#if MK_MULTI
    for (int p = 0; p < N_PHASES; ++p) { a.ph_lo = p; a.ph_hi = p + 1; a.li = 0; hipLaunchKernelGGL(trunk_fwd, dim3(grid), dim3(NTHR), LDS_BYTES, stream, a); }
#else
    a.ph_lo = 0; a.ph_hi = N_PHASES; a.li = 0;
    hipLaunchKernelGGL(trunk_fwd, dim3(grid), dim3(NTHR), LDS_BYTES, stream, a);
#endif
}
```

```cpp
#include <hip/hip_runtime.h>
#include <cstdio>
#include <cstdint>

#ifndef PHMASK
#define PHMASK 0xFFFFFFFFu
#endif
#ifndef PROBE_DUP
#define PROBE_DUP 0u
#endif
#ifndef PROBE_NSA
#define PROBE_NSA 0
#endif
#ifndef PROBE_BAR
#define PROBE_BAR 0
#endif
#ifndef PROBE_SLP
#define PROBE_SLP 0x0ull
#endif
#ifndef PROBE_TM
#define PROBE_TM 0x0ull
#endif
#ifndef MK_MULTI
#define MK_MULTI 0
#endif

#define LAS __attribute__((address_space(3)))
#define GAS __attribute__((address_space(1)))
typedef unsigned short bf16_t;
typedef short bf16x8 __attribute__((ext_vector_type(8)));
typedef short s16x4 __attribute__((ext_vector_type(4)));
typedef float f32x2 __attribute__((ext_vector_type(2)));
typedef float f32x4 __attribute__((ext_vector_type(4)));
typedef float f32x16 __attribute__((ext_vector_type(16)));
typedef unsigned u32x2 __attribute__((ext_vector_type(2)));
typedef unsigned u32x4 __attribute__((ext_vector_type(4)));
typedef __bf16 bf16x2_t __attribute__((ext_vector_type(2)));

constexpr int NB = 8, SEQ = 4096, DM = 1024, MTOK = NB * SEQ;
constexpr int HD = 64;
constexpr int IN_W = 2840, INP = 3072;
constexpr int DFF = 2816, DFE = 3584, NEXP = 8;
constexpr int CMPH = 256;
constexpr float RMS_EPS = 1e-6f;
constexpr float LOG2E = 1.4426950408889634f, LN2 = 0.6931471805599453f;
constexpr float QSCALE = 0.125f * LOG2E;
constexpr float NEGF = -1e30f;
constexpr int LUTN = 1664;
constexpr int NWAVES = 8, NTHR = 512;
constexpr int MOE_ROWS_MAX = (256 + 8) * 256;
constexpr int MOE_GROUP = 128;
constexpr int MOE_NG = 256 / MOE_GROUP;
constexpr int DIL_EARLY = 8;

constexpr size_t MiB = 1u << 20;
constexpr size_t WS_CTL = 0, CTL_BYTES = 1 * MiB;
constexpr size_t WS_LUT = 1 * MiB;
constexpr size_t WS_B1P = 1 * MiB + 224 * 1024;
constexpr size_t WS_B1E = WS_B1P + 2 * 2 * 16 * 256 * 4;
constexpr size_t WS_BSH = WS_B1E + 2 * 2 * 256 * 4;
constexpr size_t WS_WC2 = 1 * MiB + 512 * 1024;
static_assert(2 * 16 * LUTN * 4 <= 224 * 1024, "lut region");
constexpr size_t WS_ROUTE = 2 * MiB;
constexpr size_t RT_ROWTOK = WS_ROUTE;
constexpr size_t RT_ROWGATE = RT_ROWTOK + MOE_ROWS_MAX * 4;
constexpr size_t RT_TOPE = RT_ROWGATE + MOE_ROWS_MAX * 4;
constexpr size_t RT_TOPG = RT_TOPE + MTOK * 2 * 4;
constexpr size_t RT_CNT = RT_TOPG + MTOK * 2 * 4;
constexpr size_t RT_PSTART = RT_CNT + 256 * 8 * 4;
constexpr size_t RT_TOKPOS = RT_PSTART + 64;
static_assert(RT_TOKPOS + MTOK * 2 * 4 <= 4 * MiB, "route region");
constexpr size_t WS_WIN = 4 * MiB;
constexpr size_t WS_WC1 = 16 * MiB;
constexpr size_t WS_WO = 20 * MiB;
constexpr size_t WS_WF1 = 24 * MiB;
constexpr size_t WS_WF2 = 35 * MiB;
constexpr size_t SB = 44 * MiB;
constexpr size_t WS_QA = SB + 0 * MiB;
constexpr size_t WS_KC = SB + 32 * MiB, WS_VC = SB + 40 * MiB, WS_KS = SB + 48 * MiB, WS_VS = SB + 56 * MiB, WS_KW = SB + 64 * MiB, WS_VW = SB + 72 * MiB;
constexpr size_t WS_GATES = SB + 80 * MiB;
constexpr size_t WS_QB = SB + 84 * MiB, WS_KB = SB + 116 * MiB, WS_VB = SB + 148 * MiB;
constexpr size_t WS_KCC = SB + 180 * MiB, WS_VCC = SB + 181 * MiB;
constexpr size_t WS_HC = SB + 182 * MiB;
constexpr size_t WS_OA = SB + 186 * MiB;
constexpr size_t WS_OB = SB + 218 * MiB;
constexpr size_t WS_LSE = SB + 314 * MiB;
constexpr size_t WS_HB = SB + 352 * MiB;
constexpr size_t WS_U = SB + 420 * MiB;
constexpr size_t WS_ACT0 = SB + 0 * MiB;
constexpr size_t WS_WE1 = SB + 0 * MiB;
constexpr size_t WS_WE2 = SB + 112 * MiB;
constexpr size_t WS_VSORT = SB + 168 * MiB;
constexpr size_t WS_ACT1 = SB + 300 * MiB;
constexpr size_t WS_END = SB + 484 * MiB;
static_assert((size_t)MOE_GROUP * 256 * DFE <= (size_t)MTOK * DM * 4, "moe act in d_out");
static_assert(WS_LSE + 3 * (size_t)MTOK * 8 * 4 <= WS_U, "attn map");

constexpr int CW_BAR = 4096;
constexpr int CTL_WORDS = (int)(CTL_BYTES / 4);

constexpr int RING_BYTES = 131072;
constexpr int LDSCTL_OFF = RING_BYTES;
constexpr int LDS_BYTES = 147456;

#define RLX_AGENT __ATOMIC_RELAXED, __HIP_MEMORY_SCOPE_AGENT
__device__ __forceinline__ unsigned f2bf(float f) { unsigned u = __builtin_bit_cast(unsigned, f); return (u + 0x7fffu + ((u >> 16) & 1u)) >> 16; }
__device__ __forceinline__ unsigned pk2(float lo, float hi) { f32x2 v = {lo, hi}; bf16x2_t b = __builtin_convertvector(v, bf16x2_t); return __builtin_bit_cast(unsigned, b); }
constexpr float FP8_ASCALE = 8.0f, FP8_WSCALE = 64.0f;
constexpr float FP8_UNSCALE = 1.0f / (FP8_ASCALE * FP8_WSCALE);
__device__ __forceinline__ unsigned pk4_fp8(float a, float b, float c, float d) {
    a = __builtin_amdgcn_fmed3f(a, -448.f, 448.f); b = __builtin_amdgcn_fmed3f(b, -448.f, 448.f); c = __builtin_amdgcn_fmed3f(c, -448.f, 448.f); d = __builtin_amdgcn_fmed3f(d, -448.f, 448.f);
    int w = __builtin_amdgcn_cvt_pk_fp8_f32(a, b, 0, false); w = __builtin_amdgcn_cvt_pk_fp8_f32(c, d, w, true); return (unsigned)w; }
__device__ __forceinline__ float bflo(unsigned u) { return __builtin_bit_cast(float, u << 16); }
__device__ __forceinline__ float bfhi(unsigned u) { return __builtin_bit_cast(float, u & 0xffff0000u); }
__device__ __forceinline__ float wave_sum(float v) {
#pragma unroll
    for (int o = 1; o < 64; o <<= 1) v += __shfl_xor(v, o);
    return v;
}
__device__ __forceinline__ float fexp2(float x) { return __builtin_amdgcn_exp2f(x); }
__device__ __forceinline__ float sigmoidf_(float x) { return __builtin_amdgcn_rcpf(1.0f + __builtin_amdgcn_exp2f(-LOG2E * x)); }

#define XB_TMO      128
#define XB_XCNT(j)  (256  + 64 * (j))
#define XB_XSUB(j)  (1280 + 64 * (j))
#define XB_XGEN(j)  (2304 + 64 * (j))
#define XB_TOP      3328
#define XB_TOPGEN   3392
#define XCD_BAR_WORDS 3456
#define XB_SPIN_CAP (1u << 18)
__device__ __forceinline__ unsigned xb_ld(unsigned* p)              { return __hip_atomic_load(p, __ATOMIC_RELAXED, __HIP_MEMORY_SCOPE_AGENT); }
__device__ __forceinline__ unsigned xb_add(unsigned* p, unsigned v) { return __hip_atomic_fetch_add(p, v, __ATOMIC_RELAXED, __HIP_MEMORY_SCOPE_AGENT); }
__device__ __forceinline__ unsigned xb_xcc_id() { return (unsigned)__builtin_amdgcn_s_getreg((3 << 11) | 20) & 0xFu; }
#define XB_SPIN(cond, bar) do { unsigned _sp = 0; while (cond) { __builtin_amdgcn_s_sleep(1); \
    if ((++_sp & 255u) == 0u) { if (xb_ld(&(bar)[XB_TMO])) break; if (_sp > XB_SPIN_CAP) { atomicAdd(&(bar)[XB_TMO], 1u); break; } } } } while (0)
struct XcdBarrier { unsigned* bar; unsigned x; volatile LAS unsigned* st; };
__device__ __forceinline__ XcdBarrier xcd_barrier_post(unsigned* bar, volatile LAS unsigned* st) {
    XcdBarrier b; b.bar = bar; b.x = xb_xcc_id(); b.st = st;
    if (threadIdx.x == 0) (void)xb_add(&bar[XB_XCNT(b.x)], 1u);
    return b;
}
__device__ __forceinline__ void xcd_barrier_complete(unsigned* bar, unsigned x, unsigned& nloc, unsigned& nx) {
    const unsigned G = gridDim.x * gridDim.y * gridDim.z;
    unsigned sum, cnt, mine, sp = 0u;
    for (;;) {
        sum = 0u; cnt = 0u; mine = 0u;
#pragma unroll
        for (unsigned j = 0; j < 16; ++j) { const unsigned c = xb_ld(&bar[XB_XCNT(j)]); sum += c; cnt += (c > 0u) ? 1u : 0u; mine = (j == x) ? c : mine; }
        if (sum == G) break;
        __builtin_amdgcn_s_sleep(1);
        if ((++sp & 255u) == 0u) { if (xb_ld(&bar[XB_TMO])) break; if (sp > XB_SPIN_CAP) { atomicAdd(&bar[XB_TMO], 1u); break; } }
    }
    nloc = mine > 0u ? mine : 1u; nx = cnt > 0u ? cnt : 1u;
}
__device__ __forceinline__ void xcd_barrier(const XcdBarrier& b) {
    asm volatile("s_waitcnt vmcnt(0)" ::: "memory");
    __syncthreads();
    if (threadIdx.x == 0) {
        unsigned* bar = b.bar;
        __builtin_amdgcn_s_waitcnt(0);
        unsigned nloc = b.st[0], nx = b.st[1];
        if (nloc == 0u) { xcd_barrier_complete(bar, b.x, nloc, nx); b.st[0] = nloc; b.st[1] = nx; }
        const unsigned old = xb_add(&bar[XB_XSUB(b.x)], 1u);
        const unsigned gen = old / nloc;
        if (old + 1u == (gen + 1u) * nloc) {
            __builtin_amdgcn_fence(__ATOMIC_RELEASE, "agent");
            asm volatile("s_waitcnt vmcnt(0)" ::: "memory");
            const unsigned og = xb_add(&bar[XB_TOP], 1u);
            const unsigned tg = og / nx;
            if (og + 1u == (tg + 1u) * nx) xb_add(&bar[XB_TOPGEN], 1u);
            else XB_SPIN(xb_ld(&bar[XB_TOPGEN]) == tg, bar);
            __builtin_amdgcn_fence(__ATOMIC_ACQUIRE, "agent");
            xb_add(&bar[XB_XGEN(b.x)], 1u);
            asm volatile("s_waitcnt vmcnt(0)" ::: "memory");
        } else {
            XB_SPIN(xb_ld(&bar[XB_XGEN(b.x)]) == gen, bar);
            __builtin_amdgcn_fence(__ATOMIC_ACQUIRE, "agent");
            asm volatile("s_waitcnt vmcnt(0)" ::: "memory");
        }
    }
    __syncthreads();
}

namespace pg8 {
constexpr int BM = 256, BK = 64, HALF = 128, HTB = HALF * BK * 2, STAGE_BYTES = 8 * HTB, NXCD = 8, WGM = 8;
__host__ __device__ __forceinline__ int lds_byte(int r, int c) { const int st = (r >> 4) * 2 + (c >> 5), rr = r & 15, cc = c & 31, ob = rr * 64 + cc * 2; return st * 1024 + (ob ^ (((ob >> 9) & 1) << 5)); }
__host__ __device__ __forceinline__ void stage_rc(int b, int& R, int& C) { const int st = b / 1024, sb = b % 1024, swz = sb ^ (((sb >> 9) & 1) << 5); R = (st >> 1) * 16 + swz / 64; C = (st & 1) * 32 + (swz % 64) / 2; }
__host__ __device__ __forceinline__ int perm32(int rho) { const int n = rho >> 4, i = rho & 15; return 8 * (i >> 2) + 4 * n + (i & 3); }

struct Unit { int pm, pn; const char* A; const char* B; };
struct Dims { int K, lda, ldb; };

template <class Epi, class Sched, bool ALIGN_EPI = true>
__device__ __forceinline__ void gemm_phase(LAS unsigned char* lds, const Dims g, const Sched& S, const Epi& E) {
    int tid_l = threadIdx.x; asm volatile("" : "+v"(tid_l));
    const int tid = tid_l, wid = __builtin_amdgcn_readfirstlane(tid >> 6), lane = tid & 63, wr = wid >> 2, wc = wid & 3, fr = lane & 15, fq = lane >> 4;
    const int K = g.K, nt = K / BK;
    unsigned voffA[2], voffB[2];
#pragma unroll
    for (int i = 0; i < 2; ++i) { int R, C; stage_rc(tid * 16 + i * 8192, R, C); const int Rb = (R & ~31) + perm32(R & 31);
        voffA[i] = (unsigned)(R * g.lda + C) * 2u; voffB[i] = (unsigned)(Rb * g.ldb + C) * 2u; }
    const size_t kstep = (size_t)(BK * 2);
    const size_t hstepA = (size_t)HALF * g.lda * 2, hstepB = (size_t)HALF * g.ldb * 2;
    const unsigned ldsw = (unsigned)wid * 1024u;
    const int aoff = lds_byte(wr * 64 + fr, fq * 8), boff = lds_byte(wc * 32 + fr, fq * 8);
#define PG8_SA(b, h) (((b) * 2 + (h)) * HTB)
#define PG8_SB(b, h) ((4 + (b) * 2 + (h)) * HTB)
#define PG8_STAGE(bufoff, gbase, voff) do { _Pragma("unroll") for (int _i = 0; _i < 2; ++_i) \
        __builtin_amdgcn_global_load_lds((const unsigned*)((const char*)(gbase) + (voff)[_i]), (LAS unsigned*)(lds + (bufoff) + ldsw + _i * 8192), 16, 0, 0); } while (0)
#define PG8_LDA(dst, b, h) do { _Pragma("unroll") for (int m = 0; m < 4; ++m) _Pragma("unroll") for (int k = 0; k < 2; ++k) dst[m][k] = *(const LAS bf16x8*)(lds + PG8_SA(b, h) + aoff + m * 2048 + k * 1024); } while (0)
#define PG8_LDB(dst, b, h) do { _Pragma("unroll") for (int n = 0; n < 2; ++n) _Pragma("unroll") for (int k = 0; k < 2; ++k) dst[n][k] = *(const LAS bf16x8*)(lds + PG8_SB(b, h) + boff + n * 2048 + k * 1024); } while (0)
#define PG8_MMA(ai, bj, At, Bt) do { __builtin_amdgcn_s_setprio(1); _Pragma("unroll") for (int m = 0; m < 4; ++m) _Pragma("unroll") for (int n = 0; n < 2; ++n) _Pragma("unroll") for (int k = 0; k < 2; ++k) \
        acc[ai][bj][m][n] = __builtin_amdgcn_mfma_f32_16x16x32_bf16(Bt[n][k], At[m][k], acc[ai][bj][m][n], 0, 0, 0); __builtin_amdgcn_s_setprio(0); } while (0)
#define PG8_WAIT_V(n) asm volatile("s_waitcnt vmcnt(" #n ")" ::: "memory")
#define PG8_WAIT_L(n) asm volatile("s_waitcnt lgkmcnt(" #n ")" ::: "memory")
#define PG8_BAR __builtin_amdgcn_s_barrier()
#define PG8_SCHED __builtin_amdgcn_sched_barrier(0)
    Unit cur, nxt; int ui = 0;
    if (!S.next(0, cur)) return;
    f32x4 acc[2][2][4][2];
#pragma unroll
    for (int a = 0; a < 2; ++a)
#pragma unroll
        for (int b = 0; b < 2; ++b)
#pragma unroll
            for (int m = 0; m < 4; ++m)
#pragma unroll
                for (int n = 0; n < 2; ++n) acc[a][b][m][n] = (f32x4){0.f, 0.f, 0.f, 0.f};
    bf16x8 At[4][2], B0[2][2], B1[2][2];
    const char* cA = cur.A; const char* cB = cur.B;
    PG8_STAGE(PG8_SB(0, 0), cB, voffB); PG8_STAGE(PG8_SB(0, 1), cB + hstepB, voffB); PG8_STAGE(PG8_SA(0, 0), cA, voffA); PG8_STAGE(PG8_SA(0, 1), cA + hstepA, voffA);
    if (wr == 1) PG8_BAR;
    PG8_WAIT_V(2); PG8_BAR;
    PG8_STAGE(PG8_SB(1, 0), cB + kstep, voffB); PG8_STAGE(PG8_SA(1, 0), cA + kstep, voffA); PG8_STAGE(PG8_SB(1, 1), cB + hstepB + kstep, voffB);
    PG8_WAIT_V(6); PG8_BAR;
    for (;;) {
        const bool has_next = S.next(ui + 1, nxt);
        const char* nA = has_next ? nxt.A : cA; const char* nB = has_next ? nxt.B : cB;
        for (int t = 0; t < nt; t += 2) {
            const bool last = (t == nt - 2);
            const char* a1 = cA + (size_t)(t + 1) * kstep;
            const char* a2 = last ? nA : cA + (size_t)(t + 2) * kstep; const char* b2 = last ? nB : cB + (size_t)(t + 2) * kstep;
            const char* a3 = a2 + kstep; const char* b3 = b2 + kstep;
            PG8_LDB(B0, 0, 0); PG8_LDB(B1, 0, 1); PG8_SCHED; PG8_LDA(At, 0, 0); PG8_STAGE(PG8_SA(1, 1), a1 + hstepA, voffA);
            PG8_WAIT_V(8); PG8_WAIT_L(0); PG8_BAR; PG8_MMA(0, 0, At, B0); PG8_MMA(0, 1, At, B1); PG8_BAR; PG8_SCHED;
            PG8_LDA(At, 0, 1); PG8_STAGE(PG8_SB(0, 0), b2, voffB); PG8_STAGE(PG8_SB(0, 1), b2 + hstepB, voffB); PG8_STAGE(PG8_SA(0, 0), a2, voffA);
            PG8_WAIT_V(8); PG8_WAIT_L(0); PG8_BAR; PG8_MMA(1, 0, At, B0); PG8_MMA(1, 1, At, B1); PG8_BAR; PG8_SCHED;
            PG8_LDB(B0, 1, 0); PG8_LDB(B1, 1, 1); PG8_SCHED; PG8_LDA(At, 1, 0); PG8_STAGE(PG8_SA(0, 1), a2 + hstepA, voffA);
            PG8_WAIT_V(8); PG8_WAIT_L(0); PG8_BAR; PG8_MMA(0, 0, At, B0); PG8_MMA(0, 1, At, B1); PG8_BAR; PG8_SCHED;
            PG8_LDA(At, 1, 1); PG8_STAGE(PG8_SB(1, 0), b3, voffB); PG8_STAGE(PG8_SB(1, 1), b3 + hstepB, voffB); PG8_STAGE(PG8_SA(1, 0), a3, voffA);
            PG8_WAIT_V(8); PG8_WAIT_L(0); PG8_BAR; PG8_MMA(1, 0, At, B0); PG8_MMA(1, 1, At, B1); PG8_BAR; PG8_SCHED;
        }
        if (ALIGN_EPI) { if (wr == 0) PG8_BAR; }
        E(acc, cur, wr, wc, fr, fq);
        if (!has_next) break;
#pragma unroll
        for (int a = 0; a < 2; ++a)
#pragma unroll
            for (int b = 0; b < 2; ++b)
#pragma unroll
                for (int m = 0; m < 4; ++m)
#pragma unroll
                    for (int n = 0; n < 2; ++n) acc[a][b][m][n] = (f32x4){0.f, 0.f, 0.f, 0.f};
        cur = nxt; cA = nA; cB = nB; ++ui;
        if (ALIGN_EPI) { if (wr == 1) PG8_BAR; }
    }
    PG8_WAIT_V(0);
    if (!ALIGN_EPI) { if (wr == 0) PG8_BAR; }
    PG8_BAR;
#undef PG8_SA
#undef PG8_SB
#undef PG8_STAGE
#undef PG8_LDA
#undef PG8_LDB
#undef PG8_MMA
#undef PG8_WAIT_V
#undef PG8_WAIT_L
#undef PG8_BAR
#undef PG8_SCHED
}

typedef int v8i_t __attribute__((ext_vector_type(8)));
typedef int v4i_t __attribute__((ext_vector_type(4)));
template <class Epi, class Sched>
__device__ __forceinline__ void gemm_phase_f8(LAS unsigned char* lds, const Dims g, const Sched& S, const Epi& E) {
    int tid_l = threadIdx.x; asm volatile("" : "+v"(tid_l));
    const int tid = tid_l, wid = __builtin_amdgcn_readfirstlane(tid >> 6), lane = tid & 63, wr = wid >> 2, wc = wid & 3, fr = lane & 15, fq = lane >> 4;
    const int K = g.K, nt = K / 128;
    unsigned voffA[2], voffB[2];
#pragma unroll
    for (int i = 0; i < 2; ++i) { int R, C; stage_rc(tid * 16 + i * 8192, R, C); const int Rb = (R & ~31) + perm32(R & 31);
        voffA[i] = (unsigned)(R * g.lda) + (unsigned)C * 2u; voffB[i] = (unsigned)(Rb * g.ldb) + (unsigned)C * 2u; }
    const size_t kstep = 128, hstepA = (size_t)HALF * g.lda;
    const unsigned ldsw = (unsigned)wid * 1024u;
    const int aoff = lds_byte(wr * 64 + fr, fq * 8), boff = lds_byte(wc * 32 + fr, fq * 8);
#define F8_SA(b, h) (((b) * 2 + (h)) * HTB)
#define F8_SB(b) ((4 + (b) * 2) * HTB)
#define F8_STAGE(bufoff, gbase, voff) do { _Pragma("unroll") for (int _i = 0; _i < 2; ++_i) \
        __builtin_amdgcn_global_load_lds((const unsigned*)((const char*)(gbase) + (voff)[_i]), (LAS unsigned*)(lds + (bufoff) + ldsw + _i * 8192), 16, 0, 0); } while (0)
#define F8_CAT(x, y) __builtin_shufflevector(x, y, 0, 1, 2, 3, 4, 5, 6, 7)
#define F8_LDA(b, h) do { _Pragma("unroll") for (int m = 0; m < 4; ++m) A8[m] = F8_CAT(*(const LAS v4i_t*)(lds + F8_SA(b, h) + aoff + m * 2048), *(const LAS v4i_t*)(lds + F8_SA(b, h) + aoff + m * 2048 + 1024)); } while (0)
#define F8_LDB(b) do { _Pragma("unroll") for (int n = 0; n < 2; ++n) B8[n] = F8_CAT(*(const LAS v4i_t*)(lds + F8_SB(b) + boff + n * 2048), *(const LAS v4i_t*)(lds + F8_SB(b) + boff + n * 2048 + 1024)); } while (0)
#define F8_MMA(ai) do { __builtin_amdgcn_s_setprio(1); _Pragma("unroll") for (int m = 0; m < 4; ++m) _Pragma("unroll") for (int n = 0; n < 2; ++n) \
        acc[ai][m][n] = __builtin_amdgcn_mfma_scale_f32_16x16x128_f8f6f4(B8[n], A8[m], acc[ai][m][n], 0, 0, 0, 0, 0, 0); __builtin_amdgcn_s_setprio(0); } while (0)
#define F8_WAIT_V(n) asm volatile("s_waitcnt vmcnt(" #n ")" ::: "memory")
#define F8_WAIT_L(n) asm volatile("s_waitcnt lgkmcnt(" #n ")" ::: "memory")
#define F8_BAR __builtin_amdgcn_s_barrier()
#define F8_SCHED __builtin_amdgcn_sched_barrier(0)
    Unit cur, nxt; int ui = 0;
    if (!S.next(0, cur)) return;
    f32x4 acc[2][4][2];
#pragma unroll
    for (int a = 0; a < 2; ++a)
#pragma unroll
        for (int m = 0; m < 4; ++m)
#pragma unroll
            for (int n = 0; n < 2; ++n) acc[a][m][n] = (f32x4){0.f, 0.f, 0.f, 0.f};
    v8i_t A8[4], B8[2];
    const char* cA = cur.A; const char* cB = cur.B;
    F8_STAGE(F8_SB(0), cB, voffB); F8_STAGE(F8_SA(0, 0), cA, voffA); F8_STAGE(F8_SA(0, 1), cA + hstepA, voffA);
    if (wr == 1) F8_BAR;
    F8_WAIT_V(2); F8_BAR;
    F8_STAGE(F8_SB(1), cB + kstep, voffB); F8_STAGE(F8_SA(1, 0), cA + kstep, voffA);
    F8_WAIT_V(6); F8_BAR;
    for (;;) {
        const bool has_next = S.next(ui + 1, nxt);
        const char* nA = has_next ? nxt.A : cA; const char* nB = has_next ? nxt.B : cB;
        for (int t = 0; t < nt; t += 2) {
            const bool last = (t == nt - 2);
            const char* a1 = cA + (size_t)(t + 1) * kstep;
            const char* a2 = last ? nA : cA + (size_t)(t + 2) * kstep; const char* b2 = last ? nB : cB + (size_t)(t + 2) * kstep;
            const char* a3 = a2 + kstep; const char* b3 = b2 + kstep;
            F8_LDB(0); F8_SCHED; F8_LDA(0, 0); F8_STAGE(F8_SA(1, 1), a1 + hstepA, voffA);
            F8_WAIT_V(6); F8_WAIT_L(0); F8_BAR; F8_MMA(0); F8_BAR; F8_SCHED;
            F8_LDA(0, 1); F8_STAGE(F8_SB(0), b2, voffB); F8_STAGE(F8_SA(0, 0), a2, voffA);
            F8_WAIT_V(6); F8_WAIT_L(0); F8_BAR; F8_MMA(1); F8_BAR; F8_SCHED;
            F8_LDB(1); F8_SCHED; F8_LDA(1, 0); F8_STAGE(F8_SA(0, 1), a2 + hstepA, voffA);
            F8_WAIT_V(6); F8_WAIT_L(0); F8_BAR; F8_MMA(0); F8_BAR; F8_SCHED;
            F8_LDA(1, 1); F8_STAGE(F8_SB(1), b3, voffB); F8_STAGE(F8_SA(1, 0), a3, voffA);
            F8_WAIT_V(6); F8_WAIT_L(0); F8_BAR; F8_MMA(1); F8_BAR; F8_SCHED;
        }
        if (wr == 0) F8_BAR;
        E(acc, cur, wr, wc, fr, fq);
        if (!has_next) break;
#pragma unroll
        for (int a = 0; a < 2; ++a)
#pragma unroll
            for (int m = 0; m < 4; ++m)
#pragma unroll
                for (int n = 0; n < 2; ++n) acc[a][m][n] = (f32x4){0.f, 0.f, 0.f, 0.f};
        cur = nxt; cA = nA; cB = nB; ++ui;
        if (wr == 1) F8_BAR;
    }
    F8_WAIT_V(0);
    F8_BAR;
#undef F8_SA
#undef F8_SB
#undef F8_STAGE
#undef F8_CAT
#undef F8_LDA
#undef F8_LDB
#undef F8_MMA
#undef F8_WAIT_V
#undef F8_WAIT_L
#undef F8_BAR
#undef F8_SCHED
}

template <class Epi, class Sched>
__device__ __forceinline__ void gemm_phase_f8d(LAS unsigned char* lds, const Dims g, const Sched& S, const Epi& E) {
    int tid_l = threadIdx.x; asm volatile("" : "+v"(tid_l));
    const int tid = tid_l, wid = __builtin_amdgcn_readfirstlane(tid >> 6), lane = tid & 63, wr = wid >> 2, wq = wid >> 1, wh = wid & 1, fr = lane & 15, fq = lane >> 4;
    const int K = g.K, nt = K / 128;
    unsigned voffA[2], voffB[2];
#pragma unroll
    for (int i = 0; i < 2; ++i) { int R, C; stage_rc(tid * 16 + i * 8192, R, C); const int Rb = (R & ~31) + perm32(R & 31);
        voffA[i] = (unsigned)(R * g.lda) + (unsigned)C * 2u; voffB[i] = (unsigned)(Rb * g.ldb) + (unsigned)C * 2u; }
    const size_t hstepA = (size_t)HALF * g.lda, hstepB = (size_t)HALF * g.ldb;
    const unsigned ldsw = (unsigned)wid * 1024u;
    const int aoff = (wq >> 1) * HTB + lds_byte((wq & 1) * 64 + fr, fq * 8), boff = 2 * HTB + lds_byte(wh * 64 + fr, fq * 8);
    constexpr int STG = 4 * HTB;
#define FD_STAGE1(bufoff, gptr, voff) do { const char* gp_ = (const char*)(gptr); asm volatile("" : "+s"(gp_));     \
        _Pragma("unroll") for (int _i = 0; _i < 2; ++_i) \
        __builtin_amdgcn_global_load_lds((const unsigned*)(gp_ + (voff)[_i]), (LAS unsigned*)(lds + (bufoff) + ldsw + _i * 8192), 16, 0, 0); } while (0)
#define FD_STAGE_AB0(sb, pa, pb) do { FD_STAGE1((sb), pa, voffA); FD_STAGE1((sb) + HTB, (pa) + hstepA, voffA); FD_STAGE1((sb) + 2 * HTB, pb, voffB); } while (0)
#define FD_STAGE_B1(sb, pb) FD_STAGE1((sb) + 3 * HTB, (pb) + hstepB, voffB)
#define FD_CAT(x, y) __builtin_shufflevector(x, y, 0, 1, 2, 3, 4, 5, 6, 7)
#define FD_WAIT_V(n) asm volatile("s_waitcnt vmcnt(" #n ")" ::: "memory")
#define FD_WAIT_L(n) asm volatile("s_waitcnt lgkmcnt(" #n ")" ::: "memory")
#define FD_BAR __builtin_amdgcn_s_barrier()
#define FD_SCHED __builtin_amdgcn_sched_barrier(0)
#define FD_TILEP(base, nbase, tt) (((tt) < nt) ? (base) + (size_t)(tt) * 128 : (nbase) + (size_t)((tt) - nt) * 128)
    Unit cur, nxt; int ui = 0;
    if (!S.next(0, cur)) return;
    f32x4 acc[2][4][4];
#pragma unroll
    for (int p = 0; p < 2; ++p)
#pragma unroll
        for (int m = 0; m < 4; ++m)
#pragma unroll
            for (int n = 0; n < 4; ++n) acc[p][m][n] = (f32x4){0.f, 0.f, 0.f, 0.f};
    v8i_t A8[4], B8[4];
    const char* cA = cur.A; const char* cB = cur.B;
    int sb = 0;
    FD_STAGE_AB0(0, cA, cB); FD_STAGE_B1(0, cB); FD_STAGE_AB0(STG, cA + 128, cB + 128);
    if (wr == 1) FD_BAR;
    FD_WAIT_V(8); FD_BAR; FD_BAR;
    for (;;) {
        const bool has_next = S.next(ui + 1, nxt);
        const char* nA = has_next ? nxt.A : cA; const char* nB = has_next ? nxt.B : cB;
        _Pragma("unroll 1") for (int t = 0; t < nt; ++t) {
            const int so = STG - sb;
#pragma unroll
            for (int n = 0; n < 4; ++n) B8[n] = FD_CAT(*(const LAS v4i_t*)(lds + sb + boff + n * 2048), *(const LAS v4i_t*)(lds + sb + boff + n * 2048 + 1024));
#pragma unroll
            for (int m = 0; m < 4; ++m) A8[m] = FD_CAT(*(const LAS v4i_t*)(lds + sb + aoff + m * 2048), *(const LAS v4i_t*)(lds + sb + aoff + m * 2048 + 1024));
            { const char* pb = FD_TILEP(cB, nB, t + 1); FD_STAGE_B1(so, pb); }
            FD_WAIT_V(8); FD_WAIT_L(0); FD_BAR;
            __builtin_amdgcn_s_setprio(1);
#pragma unroll
            for (int m = 0; m < 4; ++m)
#pragma unroll
                for (int n = 0; n < 4; ++n) acc[0][m][n] = __builtin_amdgcn_mfma_scale_f32_16x16x128_f8f6f4(B8[n], A8[m], acc[0][m][n], 0, 0, 0, 0, 0, 0);
            __builtin_amdgcn_s_setprio(0);
            FD_BAR; FD_SCHED;
#pragma unroll
            for (int n = 0; n < 4; ++n) B8[n] = FD_CAT(*(const LAS v4i_t*)(lds + sb + HTB + boff + n * 2048), *(const LAS v4i_t*)(lds + sb + HTB + boff + n * 2048 + 1024));
            { const char* pa = FD_TILEP(cA, nA, t + 2); const char* pb = FD_TILEP(cB, nB, t + 2); FD_STAGE_AB0(sb, pa, pb); }
            FD_WAIT_V(8); FD_WAIT_L(0); FD_BAR;
            __builtin_amdgcn_s_setprio(1);
#pragma unroll
            for (int m = 0; m < 4; ++m)
#pragma unroll
                for (int n = 0; n < 4; ++n) acc[1][m][n] = __builtin_amdgcn_mfma_scale_f32_16x16x128_f8f6f4(B8[n], A8[m], acc[1][m][n], 0, 0, 0, 0, 0, 0);
            __builtin_amdgcn_s_setprio(0);
            FD_BAR; FD_SCHED;
            sb = so;
        }
        if (wr == 0) FD_BAR;
        E(acc, cur, wq, wh, fr, fq);
        if (!has_next) break;
#pragma unroll
        for (int p = 0; p < 2; ++p)
#pragma unroll
            for (int m = 0; m < 4; ++m)
#pragma unroll
                for (int n = 0; n < 4; ++n) acc[p][m][n] = (f32x4){0.f, 0.f, 0.f, 0.f};
        cur = nxt; cA = nA; cB = nB; ++ui;
        if (wr == 1) FD_BAR;
    }
    FD_WAIT_V(0);
    FD_BAR;
#undef FD_STAGE1
#undef FD_STAGE_AB0
#undef FD_STAGE_B1
#undef FD_CAT
#undef FD_WAIT_V
#undef FD_WAIT_L
#undef FD_BAR
#undef FD_SCHED
#undef FD_TILEP
}

struct StaticOrder {
    int nM, nN, nwg, G, c; const char* A; const char* B; size_t tsA, tsB;
    __device__ void init(int M, int N, int G_, int c_, const void* A_, const void* B_, int lda, int ldb, int es = 2, int bn = BM) { nM = M / BM; nN = N / bn; nwg = nM * nN; G = G_; c = c_; A = (const char*)A_; B = (const char*)B_; tsA = (size_t)BM * lda * es; tsB = (size_t)bn * ldb * es; }
    __device__ bool next(int i, Unit& u) const {
        const long L = (long)i * G + c; if (L >= nwg) return false;
        int wgid = (int)L; { const int q = nwg / NXCD, r = nwg % NXCD, xcd = wgid % NXCD, off = wgid / NXCD; wgid = (xcd < r ? xcd * (q + 1) : r * (q + 1) + (xcd - r) * q) + off; }
        const int nig = WGM * nN, gid = wgid / nig, fm = gid * WGM, gsz = (nM - fm) < WGM ? (nM - fm) : WGM;
        u.pm = fm + ((wgid % nig) % gsz); u.pn = (wgid % nig) / gsz; u.A = A + (size_t)u.pm * tsA; u.B = B + (size_t)u.pn * tsB; return true;
    }
};
}

struct Args {
    const float* in[22]; float* out; unsigned char* ws; int ph_lo, ph_hi, li, pad;
};
enum { I_X = 0, I_RELB, I_ANORM, I_WIN, I_QN, I_KN, I_CPOS, I_CW1, I_CB1, I_CW2, I_DQN, I_DKN, I_ONORM, I_WOUT, I_FNORM, I_FG, I_FU, I_FD, I_RW, I_EG, I_EU, I_ED };

struct Frame {
    LAS unsigned char* lds;
    int tid, lane, wave, G, wg;
    unsigned char* ws; const float* const* in; float* out;
};

struct EpiInProj {
    unsigned char* ws; const float* qn; const float* kn; const float* dqn; const float* dkn;
    __device__ __forceinline__ void operator()(const f32x4 (&acc)[2][2][4][2], const pg8::Unit& u, int wr, int wc, int fr, int fq) const {
        const int rowb = u.pm * 256 + wr * 64 + fr;
        if (u.pn == 11) {
            if (wc != 0 || fq >= 3) return;
            float* G = (float*)(ws + WS_GATES);
#pragma unroll
            for (int ai = 0; ai < 2; ++ai)
#pragma unroll
                for (int m = 0; m < 4; ++m) { const int row = rowb + ai * 128 + m * 16;
#pragma unroll
                    for (int n = 0; n < 2; ++n) { f32x4 v = acc[ai][0][m][n]; f32x4 o; o[0] = sigmoidf_(v[0]); o[1] = sigmoidf_(v[1]); o[2] = sigmoidf_(v[2]); o[3] = sigmoidf_(v[3]);
                        *(f32x4*)(G + (size_t)row * 24 + 8 * fq + 4 * n) = o; } }
            return;
        }
        const int vh = 4 * u.pn + wc;
        size_t base; int nh, hidx; const float* gain = nullptr; float scale = 1.f;
        if (vh < 8)       { base = WS_QA; nh = 8; hidx = vh; gain = qn; scale = QSCALE; }
        else if (vh < 20) { const int k = (vh - 8) >> 1; nh = 2; hidx = (vh - 8) & 1;
                            base = (k == 0) ? WS_KC : (k == 1) ? WS_VC : (k == 2) ? WS_KS : (k == 3) ? WS_VS : (k == 4) ? WS_KW : WS_VW;
                            if (k == 2) gain = kn + 64; else if (k == 4) gain = kn + 128; }
        else if (vh < 28) { base = WS_QB; nh = 8; hidx = vh - 20; gain = dqn; scale = QSCALE; }
        else if (vh < 36) { base = WS_KB; nh = 8; hidx = vh - 28; gain = dkn; }
        else              { base = WS_VB; nh = 8; hidx = vh - 36; }
        bf16_t* O = (bf16_t*)(ws + base);
        f32x4 gv[2][2];
#pragma unroll
        for (int bj = 0; bj < 2; ++bj)
#pragma unroll
            for (int n = 0; n < 2; ++n) gv[bj][n] = gain ? *(const f32x4*)(gain + 32 * bj + 8 * fq + 4 * n) : (f32x4){1.f, 1.f, 1.f, 1.f};
#pragma unroll
        for (int ai = 0; ai < 2; ++ai)
#pragma unroll
            for (int m = 0; m < 4; ++m) {
                const int row = rowb + ai * 128 + m * 16, b = row >> 12, t = row & 4095;
                float rs = scale;
                if (gain) {
                    float ss = 0.f;
#pragma unroll
                    for (int bj = 0; bj < 2; ++bj)
#pragma unroll
                        for (int n = 0; n < 2; ++n) { const f32x4 v = acc[ai][bj][m][n]; ss += (v[0] * v[0] + v[1] * v[1]) + (v[2] * v[2] + v[3] * v[3]); }
                    ss += __shfl_xor(ss, 16); ss += __shfl_xor(ss, 32);
                    rs = scale * __builtin_amdgcn_rsqf(ss * (1.0f / 64.0f) + RMS_EPS);
                }
                bf16_t* dst = O + ((size_t)(b * nh + hidx) * SEQ + t) * 64 + 8 * fq;
#pragma unroll
                for (int bj = 0; bj < 2; ++bj) { const f32x4 v0 = acc[ai][bj][m][0] * gv[bj][0] * rs, v1 = acc[ai][bj][m][1] * gv[bj][1] * rs;
                    u32x4 w; w.x = pk2(v0[0], v0[1]); w.y = pk2(v0[2], v0[3]); w.z = pk2(v1[0], v1[1]); w.w = pk2(v1[2], v1[3]);
                    *(u32x4*)(dst + 32 * bj) = w; }
            }
    }
};
__device__ __forceinline__ float gelu_tanh(float x) { const float y = 0.7978845608028654f * (x + 0.044715f * x * x * x); const float e = __builtin_amdgcn_exp2f((2.f * LOG2E) * y); return x - x * __builtin_amdgcn_rcpf(e + 1.f); }
struct EpiCmp1 {
    bf16_t* HC; const float* b1e;
    __device__ __forceinline__ void operator()(const f32x4 (&acc)[2][2][4][2], const pg8::Unit& u, int wr, int wc, int fr, int fq) const {
        const int kv = u.pm >> 4, bg = u.pm & 15;
        bf16_t* O = HC + ((size_t)kv * 4096 + bg * 256) * 256; const float* bias = b1e + kv * 256;
        const int col0 = wc * 32 + 8 * fq;
#pragma unroll
        for (int ai = 0; ai < 2; ++ai)
#pragma unroll
            for (int m = 0; m < 4; ++m) { const int r = ai * 128 + wr * 64 + m * 16 + fr;
#pragma unroll
                for (int bj = 0; bj < 2; ++bj) { const f32x4 b0 = *(const f32x4*)(bias + col0 + bj * 128), b1 = *(const f32x4*)(bias + col0 + bj * 128 + 4);
                    const f32x4 v0 = acc[ai][bj][m][0] + b0, v1 = acc[ai][bj][m][1] + b1;
                    u32x4 w; w.x = pk2(gelu_tanh(v0[0]), gelu_tanh(v0[1])); w.y = pk2(gelu_tanh(v0[2]), gelu_tanh(v0[3])); w.z = pk2(gelu_tanh(v1[0]), gelu_tanh(v1[1])); w.w = pk2(gelu_tanh(v1[2]), gelu_tanh(v1[3]));
                    *(u32x4*)(O + (size_t)r * 256 + col0 + bj * 128) = w; } }
    }
};
template <bool RESF32> struct EpiRes {
    const void* res; bf16_t* out;
    __device__ __forceinline__ void operator()(const f32x4 (&acc)[2][2][4][2], const pg8::Unit& u, int wr, int wc, int fr, int fq) const {
        const int row0 = u.pm * 256 + wr * 64 + fr, col0 = u.pn * 256 + wc * 32 + 8 * fq;
#pragma unroll
        for (int ai = 0; ai < 2; ++ai)
#pragma unroll
            for (int m = 0; m < 4; ++m) { const size_t ro = (size_t)(row0 + ai * 128 + m * 16) * DM + col0;
#pragma unroll
                for (int bj = 0; bj < 2; ++bj) {
                    f32x4 r0, r1;
                    if (RESF32) { r0 = *(const f32x4*)((const float*)res + ro + bj * 128); r1 = *(const f32x4*)((const float*)res + ro + bj * 128 + 4); }
                    else { const u32x4 rb = *(const u32x4*)((const bf16_t*)res + ro + bj * 128); r0 = (f32x4){bflo(rb.x), bfhi(rb.x), bflo(rb.y), bfhi(rb.y)}; r1 = (f32x4){bflo(rb.z), bfhi(rb.z), bflo(rb.w), bfhi(rb.w)}; }
                    const f32x4 v0 = r0 + acc[ai][bj][m][0], v1 = r1 + acc[ai][bj][m][1];
                    u32x4 w; w.x = pk2(v0[0], v0[1]); w.y = pk2(v0[2], v0[3]); w.z = pk2(v1[0], v1[1]); w.w = pk2(v1[2], v1[3]);
                    *(u32x4*)(out + ro + bj * 128) = w; } }
    }
};
__device__ __forceinline__ float silu_mul(float g, float u) { return g * u * __builtin_amdgcn_rcpf(1.0f + __builtin_amdgcn_exp2f(-LOG2E * g)); }
template <bool FP8OUT> struct EpiSwiglu {
    void* Ov; int ldc; int pm0;
    __device__ __forceinline__ void operator()(const f32x4 (&acc)[2][2][4][2], const pg8::Unit& u, int wr, int wc, int fr, int fq) const {
        const int row0 = (u.pm - pm0) * 256 + wr * 64 + fr, col0 = u.pn * 128 + wc * 32 + 8 * fq;
#pragma unroll
        for (int ai = 0; ai < 2; ++ai)
#pragma unroll
            for (int m = 0; m < 4; ++m) { const f32x4 g0 = acc[ai][0][m][0], g1 = acc[ai][0][m][1], u0 = acc[ai][1][m][0], u1 = acc[ai][1][m][1];
                if constexpr (FP8OUT) { const f32x4 s0 = u0 * FP8_ASCALE, s1 = u1 * FP8_ASCALE;
                    u32x2 w; w.x = pk4_fp8(silu_mul(g0[0], s0[0]), silu_mul(g0[1], s0[1]), silu_mul(g0[2], s0[2]), silu_mul(g0[3], s0[3]));
                    w.y = pk4_fp8(silu_mul(g1[0], s1[0]), silu_mul(g1[1], s1[1]), silu_mul(g1[2], s1[2]), silu_mul(g1[3], s1[3]));
                    *(u32x2*)((unsigned char*)Ov + (size_t)(row0 + ai * 128 + m * 16) * ldc + col0) = w; }
                else { u32x4 w; w.x = pk2(silu_mul(g0[0], u0[0]), silu_mul(g0[1], u0[1])); w.y = pk2(silu_mul(g0[2], u0[2]), silu_mul(g0[3], u0[3]));
                    w.z = pk2(silu_mul(g1[0], u1[0]), silu_mul(g1[1], u1[1])); w.w = pk2(silu_mul(g1[2], u1[2]), silu_mul(g1[3], u1[3]));
                    *(u32x4*)((bf16_t*)Ov + (size_t)(row0 + ai * 128 + m * 16) * ldc + col0) = w; } }
    }
};
struct EpiResF8 {
    bf16_t* h;
    __device__ __forceinline__ void operator()(const f32x4 (&acc)[2][4][4], const pg8::Unit& u, int wq, int wh, int fr, int fq) const {
        const int row0 = u.pm * 256 + wq * 64 + fr, col0 = u.pn * 256 + wh * 64 + 8 * fq;
#pragma unroll
        for (int p = 0; p < 2; ++p)
#pragma unroll
        for (int m = 0; m < 4; ++m)
#pragma unroll
            for (int G = 0; G < 2; ++G) { bf16_t* q = h + (size_t)(row0 + m * 16) * DM + col0 + 128 * p + 32 * G; const u32x4 rb = *(const u32x4*)q;
                const f32x4 v0 = (f32x4){bflo(rb.x), bfhi(rb.x), bflo(rb.y), bfhi(rb.y)} + acc[p][m][2 * G] * FP8_UNSCALE, v1 = (f32x4){bflo(rb.z), bfhi(rb.z), bflo(rb.w), bfhi(rb.w)} + acc[p][m][2 * G + 1] * FP8_UNSCALE;
                u32x4 w; w.x = pk2(v0[0], v0[1]); w.y = pk2(v0[2], v0[3]); w.z = pk2(v1[0], v1[1]); w.w = pk2(v1[2], v1[3]);
                *(u32x4*)q = w; }
    }
    __device__ __forceinline__ void operator()(const f32x4 (&acc)[2][4][2], const pg8::Unit& u, int wr, int wc, int fr, int fq) const {
        const int row0 = u.pm * 256 + wr * 64 + fr, col0 = u.pn * 128 + wc * 32 + 8 * fq;
#pragma unroll
        for (int ai = 0; ai < 2; ++ai)
#pragma unroll
            for (int m = 0; m < 4; ++m) { bf16_t* p = h + (size_t)(row0 + ai * 128 + m * 16) * DM + col0; const u32x4 rb = *(const u32x4*)p;
                const f32x4 v0 = (f32x4){bflo(rb.x), bfhi(rb.x), bflo(rb.y), bfhi(rb.y)} + acc[ai][m][0] * FP8_UNSCALE, v1 = (f32x4){bflo(rb.z), bfhi(rb.z), bflo(rb.w), bfhi(rb.w)} + acc[ai][m][1] * FP8_UNSCALE;
                u32x4 w; w.x = pk2(v0[0], v0[1]); w.y = pk2(v0[2], v0[3]); w.z = pk2(v1[0], v1[1]); w.w = pk2(v1[2], v1[3]);
                *(u32x4*)p = w; }
    }
};
struct EpiSwigluF8 {
    unsigned char* O; int ldc; int pm0;
    __device__ __forceinline__ void operator()(const f32x4 (&acc)[2][4][4], const pg8::Unit& u, int wq, int wh, int fr, int fq) const {
        const int row0 = (u.pm - pm0) * 256 + wq * 64 + fr, col0 = u.pn * 128 + wh * 32 + 4 * fq;
        constexpr float KE = -LOG2E * FP8_UNSCALE, KP = FP8_UNSCALE * FP8_UNSCALE * FP8_ASCALE;
#pragma unroll
        for (int p = 0; p < 2; ++p)
#pragma unroll
        for (int m = 0; m < 4; ++m)
#pragma unroll
            for (int G = 0; G < 2; ++G) { const f32x4 ga = acc[p][m][2 * G], ua = acc[p][m][2 * G + 1]; float r[4];
#pragma unroll
                for (int c = 0; c < 4; ++c) r[c] = (ga[c] * ua[c]) * KP * __builtin_amdgcn_rcpf(1.0f + __builtin_amdgcn_exp2f(KE * ga[c]));
                *(unsigned*)(O + (size_t)(row0 + m * 16) * ldc + col0 + 64 * p + 16 * G) = pk4_fp8(r[0], r[1], r[2], r[3]); }
    }
    __device__ __forceinline__ void operator()(const f32x4 (&acc)[2][4][2], const pg8::Unit& u, int wr, int wc, int fr, int fq) const {
        const int row0 = (u.pm - pm0) * 256 + wr * 64 + fr, col0 = u.pn * 64 + wc * 16 + 4 * fq;
#pragma unroll
        for (int ai = 0; ai < 2; ++ai)
#pragma unroll
            for (int m = 0; m < 4; ++m) { const f32x4 ga = acc[ai][m][0], ua = acc[ai][m][1];
                constexpr float KE = -LOG2E * FP8_UNSCALE, KP = FP8_UNSCALE * FP8_UNSCALE * FP8_ASCALE;
                float r[4];
#pragma unroll
                for (int c = 0; c < 4; ++c) r[c] = (ga[c] * ua[c]) * KP * __builtin_amdgcn_rcpf(1.0f + __builtin_amdgcn_exp2f(KE * ga[c]));
                *(unsigned*)(O + (size_t)(row0 + ai * 128 + m * 16) * ldc + col0) = pk4_fp8(r[0], r[1], r[2], r[3]); }
    }
};
struct EpiMoe2F8 {
    bf16_t* Y; int pm0;
    __device__ __forceinline__ void operator()(const f32x4 (&acc)[2][4][4], const pg8::Unit& u, int wq, int wh, int fr, int fq) const {
        const int row0 = (pm0 + u.pm) * 256 + wq * 64 + fr, col0 = u.pn * 256 + wh * 64 + 8 * fq;
#pragma unroll
        for (int p = 0; p < 2; ++p)
#pragma unroll
        for (int m = 0; m < 4; ++m)
#pragma unroll
            for (int G = 0; G < 2; ++G) { const f32x4 v0 = acc[p][m][2 * G] * FP8_UNSCALE, v1 = acc[p][m][2 * G + 1] * FP8_UNSCALE;
                u32x4 w; w.x = pk2(v0[0], v0[1]); w.y = pk2(v0[2], v0[3]); w.z = pk2(v1[0], v1[1]); w.w = pk2(v1[2], v1[3]);
                *(u32x4*)(Y + (size_t)(row0 + m * 16) * DM + col0 + 128 * p + 32 * G) = w; }
    }
    __device__ __forceinline__ void operator()(const f32x4 (&acc)[2][4][2], const pg8::Unit& u, int wr, int wc, int fr, int fq) const {
        const int row0 = (pm0 + u.pm) * 256 + wr * 64 + fr, col0 = u.pn * 128 + wc * 32 + 8 * fq;
#pragma unroll
        for (int ai = 0; ai < 2; ++ai)
#pragma unroll
            for (int m = 0; m < 4; ++m) { const f32x4 v0 = acc[ai][m][0] * FP8_UNSCALE, v1 = acc[ai][m][1] * FP8_UNSCALE;
                u32x4 w; w.x = pk2(v0[0], v0[1]); w.y = pk2(v0[2], v0[3]); w.z = pk2(v1[0], v1[1]); w.w = pk2(v1[2], v1[3]);
                *(u32x4*)(Y + (size_t)(row0 + ai * 128 + m * 16) * DM + col0) = w; }
    }
};
struct EpiMoe2 {
    bf16_t* Y; int pm0;
    __device__ __forceinline__ void operator()(const f32x4 (&acc)[2][2][4][2], const pg8::Unit& u, int wr, int wc, int fr, int fq) const {
        const int row0 = (pm0 + u.pm) * 256 + wr * 64 + fr, col0 = u.pn * 256 + wc * 32 + 8 * fq;
#pragma unroll
        for (int ai = 0; ai < 2; ++ai)
#pragma unroll
            for (int m = 0; m < 4; ++m) { bf16_t* o = Y + (size_t)(row0 + ai * 128 + m * 16) * DM + col0;
#pragma unroll
                for (int bj = 0; bj < 2; ++bj) { const f32x4 v0 = acc[ai][bj][m][0], v1 = acc[ai][bj][m][1];
                    u32x4 w; w.x = pk2(v0[0], v0[1]); w.y = pk2(v0[2], v0[3]); w.z = pk2(v1[0], v1[1]); w.w = pk2(v1[2], v1[3]);
                    *(u32x4*)(o + bj * 128) = w; } }
    }
};

struct SchedCmp {
    int wg; const char* KC; const char* VC; const char* W;
    __device__ bool next(int i, pg8::Unit& u) const { if (i > 0 || wg >= 32) return false; const int kv = wg >> 4, bg = wg & 15; u.pm = wg; u.pn = 0;
        u.A = (kv ? VC : KC) + (size_t)bg * SEQ * 64 * 2; u.B = W + (size_t)kv * 256 * 2048 * 2; return true; }
};
struct SchedMoe1 {
    int wg, G, c0, ncg, nchunks; const int* pstart; const char* A; const char* W;
    __device__ bool next(int i, pg8::Unit& u) const {
        if (ncg <= 0) return false;
        const int L = i * G + wg; const int cl = __builtin_amdgcn_readfirstlane(L % ncg), pn = __builtin_amdgcn_readfirstlane(L / ncg); if (pn >= 28) return false; const int c = c0 + cl; if (c >= nchunks) return false;
        int e = 0;
#pragma unroll
        for (int k = 1; k < 8; ++k) e += (c * 256 >= __builtin_amdgcn_readfirstlane(pstart[k])) ? 1 : 0;
        u.pm = c; u.pn = pn; u.A = A + (size_t)c * 256 * DM * 2; u.B = W + ((size_t)e * 7168 + (size_t)pn * 256) * DM; return true; }
};
struct SchedMoe2 {
    int wg, G, c0, ncg, nchunks; const int* pstart; const char* A; const char* W;
    __device__ bool next(int i, pg8::Unit& u) const {
        if (ncg <= 0) return false;
        const int L = i * G + wg; const int cl = __builtin_amdgcn_readfirstlane(L % ncg), pn = __builtin_amdgcn_readfirstlane(L / ncg); if (pn >= 4) return false; const int c = c0 + cl; if (c >= nchunks) return false;
        int e = 0;
#pragma unroll
        for (int k = 1; k < 8; ++k) e += (c * 256 >= __builtin_amdgcn_readfirstlane(pstart[k])) ? 1 : 0;
        u.pm = cl; u.pn = pn; u.A = A + (size_t)cl * 256 * DFE; u.B = W + ((size_t)e * 1024 + (size_t)pn * 256) * DFE; return true; }
};

__device__ __forceinline__ void transpose_block(const float* src, int ldw, bf16_t* dst, int ldt, int nvalid, LAS float* scr, int lane) {
    if (nvalid == 32) {
#pragma unroll
        for (int i = 0; i < 8; ++i) { const int kk = 8 * i + (lane >> 3), n = (lane & 7) * 4; const f32x4 v = *(const f32x4*)(src + (size_t)kk * ldw + n);
            LAS float* d = scr + kk * 33 + n; d[0] = v[0]; d[1] = v[1]; d[2] = v[2]; d[3] = v[3]; }
    } else {
#pragma unroll 8
        for (int i = 0; i < 32; ++i) { const int kk = 2 * i + (lane >> 5), n = lane & 31; scr[kk * 33 + n] = (n < nvalid) ? src[(size_t)kk * ldw + n] : 0.f; }
    }
    asm volatile("s_waitcnt lgkmcnt(0)" ::: "memory");
    const int c = lane & 7;
#pragma unroll
    for (int j = 0; j < 4; ++j) { const int n = (lane >> 3) + 8 * j; const LAS float* s = scr + (8 * c) * 33 + n;
        u32x4 o; o.x = pk2(s[0 * 33], s[1 * 33]); o.y = pk2(s[2 * 33], s[3 * 33]); o.z = pk2(s[4 * 33], s[5 * 33]); o.w = pk2(s[6 * 33], s[7 * 33]);
        *(u32x4*)(dst + (size_t)n * ldt + 8 * c) = o; }
    asm volatile("s_waitcnt lgkmcnt(0)" ::: "memory");
}
__device__ __forceinline__ void tb_load(f32x4 (&r)[8], const float* src, int ldw, int lane) {
#pragma unroll
    for (int i = 0; i < 8; ++i) r[i] = *(const f32x4*)(src + (size_t)(8 * i + (lane >> 3)) * ldw + (lane & 7) * 4);
}
template <bool FP8> __device__ __forceinline__ void tb_emit(const f32x4 (&r)[8], void* dstv, int ldt, LAS float* scr, int lane) {
#pragma unroll
    for (int i = 0; i < 8; ++i) { LAS float* d = scr + (8 * i + (lane >> 3)) * 33 + (lane & 7) * 4; d[0] = r[i][0]; d[1] = r[i][1]; d[2] = r[i][2]; d[3] = r[i][3]; }
    asm volatile("s_waitcnt lgkmcnt(0)" ::: "memory");
    const int c = lane & 7;
#pragma unroll
    for (int j = 0; j < 4; ++j) { const int n = (lane >> 3) + 8 * j; const LAS float* s = scr + (8 * c) * 33 + n;
        if constexpr (FP8) { u32x2 o; o.x = pk4_fp8(s[0 * 33] * FP8_WSCALE, s[1 * 33] * FP8_WSCALE, s[2 * 33] * FP8_WSCALE, s[3 * 33] * FP8_WSCALE); o.y = pk4_fp8(s[4 * 33] * FP8_WSCALE, s[5 * 33] * FP8_WSCALE, s[6 * 33] * FP8_WSCALE, s[7 * 33] * FP8_WSCALE);
            *(u32x2*)((unsigned char*)dstv + (size_t)n * ldt + 8 * c) = o; }
        else { u32x4 o; o.x = pk2(s[0 * 33], s[1 * 33]); o.y = pk2(s[2 * 33], s[3 * 33]); o.z = pk2(s[4 * 33], s[5 * 33]); o.w = pk2(s[6 * 33], s[7 * 33]);
            *(u32x4*)((bf16_t*)dstv + (size_t)n * ldt + 8 * c) = o; } }
    asm volatile("s_waitcnt lgkmcnt(0)" ::: "memory");
}
template <bool FP8 = false> __device__ __forceinline__ void conv_plain(const float* W, int K, int N, void* WTv, LAS float* scr, int gw, int ngw, int lane) {
    unsigned char* WT = (unsigned char*)WTv; constexpr int ES = FP8 ? 1 : 2;
    const int nkb = K / 64, nnb = N / 32, nit = nkb * nnb;
    f32x4 cur[8], nxt[8];
    int it = gw;
    if (it < nit) { const int kb = it / nnb, nb = it % nnb; tb_load(cur, W + (size_t)kb * 64 * N + nb * 32, N, lane); }
    for (; it < nit; it += ngw) {
        const int kb = it / nnb, nb = it % nnb;
        if (it + ngw < nit) { const int kb2 = (it + ngw) / nnb, nb2 = (it + ngw) % nnb; tb_load(nxt, W + (size_t)kb2 * 64 * N + nb2 * 32, N, lane); }
        tb_emit<FP8>(cur, WT + ((size_t)nb * 32 * K + kb * 64) * ES, K, scr, lane);
#pragma unroll
        for (int i = 0; i < 8; ++i) cur[i] = nxt[i];
    }
}
__device__ __forceinline__ void conv_gateup(const float* Wg, const float* Wu, int K, int N, bf16_t* WT, LAS float* scr, int gw, int ngw, int lane) {
    const int nkb = K / 64, nvb = 2 * N / 32, nit = nkb * nvb;
    f32x4 cur[8], nxt[8];
    int it = gw;
#define GU_SRC(itx) ((((((itx) % nvb) * 32) >> 7) & 1 ? Wu : Wg) + (size_t)((itx) / nvb) * 64 * N + (((((itx) % nvb) * 32) >> 8) * 128) + ((((itx) % nvb) * 32) & 127))
    if (it < nit) tb_load(cur, GU_SRC(it), N, lane);
    for (; it < nit; it += ngw) {
        const int kb = it / nvb, vb = it % nvb;
        if (it + ngw < nit) tb_load(nxt, GU_SRC(it + ngw), N, lane);
        tb_emit<false>(cur, WT + (size_t)vb * 32 * K + kb * 64, K, scr, lane);
#pragma unroll
        for (int i = 0; i < 8; ++i) cur[i] = nxt[i];
    }
#undef GU_SRC
}
__device__ __forceinline__ void conv_gateup_f8(const float* Wg, const float* Wu, int K, int N, unsigned char* WT, LAS float* scr, int gw, int ngw, int lane) {
    const int nkb = K / 64, nvb = 2 * N / 32, nit = nkb * nvb;
    f32x4 cur[8], nxt[8];
    int it = gw;
#define GU8_LOAD(r, itx) do { const int kb_ = (itx) / nvb, vb_ = (itx) % nvb, q8_ = lane & 7; const float* W_ = (q8_ & 1) ? Wu : Wg; \
        const float* src_ = W_ + (size_t)kb_ * 64 * N + (vb_ >> 2) * 64 + (vb_ & 3) * 16 + (q8_ >> 1) * 4; \
        _Pragma("unroll") for (int i = 0; i < 8; ++i) r[i] = *(const f32x4*)(src_ + (size_t)(8 * i + (lane >> 3)) * N); } while (0)
    if (it < nit) GU8_LOAD(cur, it);
    for (; it < nit; it += ngw) {
        const int kb = it / nvb, vb = it % nvb;
        if (it + ngw < nit) GU8_LOAD(nxt, it + ngw);
        tb_emit<true>(cur, WT + (size_t)vb * 32 * K + kb * 64, K, scr, lane);
#pragma unroll
        for (int i = 0; i < 8; ++i) cur[i] = nxt[i];
    }
#undef GU8_LOAD
}
__device__ __forceinline__ void conv_inproj(const float* W, bf16_t* WT, LAS float* scr, int gw, int ngw, int lane) {
    const int nkb = DM / 64, nvb = INP / 32;
    for (int it = gw; it < nkb * nvb; it += ngw) { const int kb = it / nvb, vb = it % nvb; const int v0 = vb * 32, pn = v0 >> 8, bj = (v0 >> 7) & 1, wc = (v0 >> 5) & 3;
        int col, nvalid = 32;
        if (pn < 11) { const int vh = 4 * pn + wc; col = (vh < 20 ? 64 * vh : 1304 + 64 * (vh - 20)) + 32 * bj; }
        else { col = 1280; nvalid = (bj == 0 && wc == 0) ? 24 : 0; }
        transpose_block(W + (size_t)kb * 64 * IN_W + col, IN_W, WT + (size_t)v0 * DM + kb * 64, DM, nvalid, scr, lane); }
}

__device__ __forceinline__ f32x16 mfma32(bf16x8 a, bf16x8 b, f32x16 c) { return __builtin_amdgcn_mfma_f32_32x32x16_bf16(a, b, c, 0, 0, 0); }
typedef short v4i16_t __attribute__((ext_vector_type(4)));
__device__ __forceinline__ s16x4 vtr(const LAS char* p) { return __builtin_bit_cast(s16x4, __builtin_amdgcn_ds_read_tr16_b64_v4i16((LAS v4i16_t*)p)); }

__device__ __forceinline__ void init_scores(f32x16& p0, f32x16& p1, int dbase, int dstep, int dmaxv, bool lanevalid, const LAS float* lut) {
#pragma unroll
    for (int r = 0; r < 16; ++r) {
        const int kk = (r & 3) + 8 * (r >> 2);
        const int d0 = dbase - dstep * kk, d1 = dbase - dstep * (kk + 32);
        const bool v0 = lanevalid && ((unsigned)d0 <= (unsigned)dmaxv), v1 = lanevalid && ((unsigned)d1 <= (unsigned)dmaxv);
        const int i0 = min(max(d0, 0), LUTN - 1), i1 = min(max(d1, 0), LUTN - 1);
        const float b0 = lut[(LUTN - 1) - i0], b1 = lut[(LUTN - 1) - i1];
        p0[r] = v0 ? b0 : NEGF; p1[r] = v1 ? b1 : NEGF;
    }
}
__device__ __forceinline__ void qk_tile(f32x16& p0, f32x16& p1, const LAS char* Ks, const bf16x8 (&qr)[4], int r32, int hi) {
    const LAS char* kb = Ks + hi * 1024 + r32 * 16;
#pragma unroll
    for (int d0 = 0; d0 < 4; ++d0) {
        const bf16x8 b0 = *(const LAS bf16x8*)(kb + d0 * 2048), b1 = *(const LAS bf16x8*)(kb + d0 * 2048 + 512);
        p0 = mfma32(b0, qr[d0], p0); p1 = mfma32(b1, qr[d0], p1);
    }
}
__device__ __forceinline__ void k_load(bf16x8 (&kf)[8], const LAS char* kb) {
#pragma unroll
    for (int d0 = 0; d0 < 4; ++d0) { kf[2 * d0] = *(const LAS bf16x8*)(kb + d0 * 2048); kf[2 * d0 + 1] = *(const LAS bf16x8*)(kb + d0 * 2048 + 512); }
}
__device__ __forceinline__ void qk_mma(f32x16& p0, f32x16& p1, const bf16x8 (&kf)[8], const bf16x8 (&qr)[4]) {
#pragma unroll
    for (int d0 = 0; d0 < 4; ++d0) { p0 = mfma32(kf[2 * d0], qr[d0], p0); p1 = mfma32(kf[2 * d0 + 1], qr[d0], p1); }
}
__device__ __forceinline__ bf16x8 pack8(const f32x16& p, int s) {
    u32x4 w; w.x = pk2(p[8 * s], p[8 * s + 1]); w.y = pk2(p[8 * s + 2], p[8 * s + 3]); w.z = pk2(p[8 * s + 4], p[8 * s + 5]); w.w = pk2(p[8 * s + 6], p[8 * s + 7]);
    return __builtin_bit_cast(bf16x8, w);
}
__device__ __forceinline__ void pv_tile(f32x16 (&o)[2], const LAS char* vb, const f32x16& p0, const f32x16& p1) {
    bf16x8 pf[4]; pf[0] = pack8(p0, 0); pf[1] = pack8(p0, 1); pf[2] = pack8(p1, 0); pf[3] = pack8(p1, 1);
#pragma unroll
    for (int db = 0; db < 2; ++db)
#pragma unroll
        for (int ks = 0; ks < 4; ++ks) {
            const s16x4 lo = vtr(vb + db * 4096 + ks * 1024), hh = vtr(vb + db * 4096 + ks * 1024 + 512);
            const bf16x8 vf = (bf16x8){lo[0], lo[1], lo[2], lo[3], hh[0], hh[1], hh[2], hh[3]};
            o[db] = mfma32(vf, pf[ks], o[db]);
        }
}
__device__ __forceinline__ void v_load(bf16x8 (&vf)[8], const LAS char* vb) {
#pragma unroll
    for (int db = 0; db < 2; ++db)
#pragma unroll
        for (int ks = 0; ks < 4; ++ks) {
            const s16x4 lo = vtr(vb + db * 4096 + ks * 1024), hh = vtr(vb + db * 4096 + ks * 1024 + 512);
            vf[db * 4 + ks] = (bf16x8){lo[0], lo[1], lo[2], lo[3], hh[0], hh[1], hh[2], hh[3]};
        }
}
__device__ __forceinline__ void pv_mma(f32x16 (&o)[2], const bf16x8 (&vf)[8], const f32x16& p0, const f32x16& p1) {
    bf16x8 pf[4]; pf[0] = pack8(p0, 0); pf[1] = pack8(p0, 1); pf[2] = pack8(p1, 0); pf[3] = pack8(p1, 1);
#pragma unroll
    for (int ks = 0; ks < 4; ++ks) { o[0] = mfma32(vf[ks], pf[ks], o[0]); o[1] = mfma32(vf[4 + ks], pf[ks], o[1]); }
}
#define SCHED_FENCE() __builtin_amdgcn_sched_barrier(0)
__device__ __forceinline__ float max16x2(const f32x16& a, const f32x16& b) {
    float m = fmaxf(a[0], b[0]);
#pragma unroll
    for (int r = 1; r < 16; ++r) m = fmaxf(m, fmaxf(a[r], b[r]));
    return m;
}
__device__ __forceinline__ void init_direct(f32x16& p0, f32x16& p1, const LAS float* base) {
#pragma unroll
    for (int r = 0; r < 16; ++r) { const int kk = (r & 3) + 8 * (r >> 2); p0[r] = base[kk]; p1[r] = base[kk + 32]; }
}
__device__ __forceinline__ float exp_tile(f32x16& p0, f32x16& p1) {
    float rs = 0.f;
#pragma unroll
    for (int r = 0; r < 16; ++r) { p0[r] = fexp2(p0[r]); p1[r] = fexp2(p1[r]); rs += p0[r] + p1[r]; }
    return rs;
}

constexpr int AL_KV = 0;
constexpr int LUTS_N = 64 + LUTN, LUTW_N = 64 + 512 + 128;
constexpr int AL_LUTS = 65536;
constexpr int AL_LUTW = AL_LUTS + 4 * LUTS_N * 4, AL_NEGP = AL_LUTW + 4 * LUTW_N * 4;
constexpr int AL_IMP = AL_NEGP + 512;
constexpr int AL_SEL = LDSCTL_OFF + 1024;
constexpr int AL_DLUT = 65536;
constexpr int AL_STA = AL_IMP, AL_STB = AL_SEL + 2048;
static_assert(AL_STB + 2 * 4096 <= LDS_BYTES && AL_STA + 6 * 4096 <= RING_BYTES && AL_IMP + 64 * 65 * 4 <= RING_BYTES, "attention LDS map");

__device__ __forceinline__ void glds16(const void* gsrc, unsigned lds_dst) { unsigned keep;
    asm volatile("s_mov_b32 %0, m0\n\ts_mov_b32 m0, %2\n\ts_nop 0\n\tglobal_load_lds_dwordx4 %1, off\n\ts_mov_b32 m0, %0" : "=&s"(keep) : "v"(gsrc), "s"(lds_dst) : "memory"); }
__device__ __forceinline__ void kv_dma(const bf16_t* Kt, const bf16_t* Vt, LAS char* slot, int w, int lane) {
    const unsigned base = (unsigned)__builtin_amdgcn_readfirstlane((int)(unsigned)(size_t)slot + w * 1024);
    glds16(Kt + lane * 64 + w * 8, base);
    glds16(Vt + ((w & 3) * 16 + (lane >> 2)) * 64 + (w >> 2) * 32 + (lane & 3) * 8, base + 8192u);
}
#define WAITBAR(N) asm volatile("s_waitcnt vmcnt(" #N ") lgkmcnt(0)\n\ts_barrier" ::: "memory")

__device__ __forceinline__ void stash_store(LAS char* st, const f32x16 (&o)[2]) {
#pragma unroll
    for (int k = 0; k < 4; ++k) { const f32x16& v = o[k >> 1]; const int b = 8 * (k & 1);
        u32x4 wv; wv.x = pk2(v[b], v[b + 1]); wv.y = pk2(v[b + 2], v[b + 3]); wv.z = pk2(v[b + 4], v[b + 5]); wv.w = pk2(v[b + 6], v[b + 7]); *(LAS u32x4*)(st + k * 1024) = wv; }
}
__device__ __forceinline__ void stash_load(const LAS char* st, f32x16 (&o)[2]) {
#pragma unroll
    for (int k = 0; k < 4; ++k) { const u32x4 wv = *(const LAS u32x4*)(st + k * 1024); f32x16& v = o[k >> 1]; const int b = 8 * (k & 1);
        v[b] = bflo(wv.x); v[b + 1] = bfhi(wv.x); v[b + 2] = bflo(wv.y); v[b + 3] = bfhi(wv.y); v[b + 4] = bflo(wv.z); v[b + 5] = bfhi(wv.z); v[b + 6] = bflo(wv.w); v[b + 7] = bfhi(wv.w); }
}
__device__ __forceinline__ void nsa_prepare(const Frame& F, int L, int g) {
    LAS char* lds = (LAS char*)F.lds; int tid_l = F.tid; asm volatile("" : "+v"(tid_l)); const int tid = tid_l;
    const float* LUTG = (const float*)(F.ws + WS_LUT) + (size_t)(L * 16 + g * 4) * LUTN;
    LAS float* ls = (LAS float*)(lds + AL_LUTS); LAS float* lw = (LAS float*)(lds + AL_LUTW); LAS float* np = (LAS float*)(lds + AL_NEGP);
    __syncthreads();
    for (int h = 0; h < 4; ++h) {
        for (int x = tid; x < LUTS_N; x += NTHR) ls[h * LUTS_N + x] = (x >= LUTN) ? NEGF : LUTG[h * LUTN + (LUTN - 1 - x)];
        for (int x = tid; x < LUTW_N; x += NTHR) { const int d = 639 - x; lw[h * LUTW_N + x] = (d < 0 || d > 511) ? NEGF : LUTG[h * LUTN + d]; }
    }
    if (tid < 128) np[tid] = NEGF;
    __syncthreads();
}

__device__ __forceinline__ void nsa_unit(const Frame& F, int L, int b, int g, int i) {
    LAS char* lds = (LAS char*)F.lds;
    int tid_l = F.tid; asm volatile("" : "+v"(tid_l));
    const int tid = tid_l, lane = tid & 63, w = __builtin_amdgcn_readfirstlane(tid >> 6), r32 = lane & 31, hi = lane >> 5;
    const int hh = w >> 1, qh = w & 1, head = g * 4 + hh;
    const int t0 = i * 64, tq = t0 + 32 * qh + r32;
    unsigned char* ws = F.ws;
    const bf16_t* QA = (const bf16_t*)(ws + WS_QA);
    const size_t bgoff = (size_t)(b * 2 + g) * SEQ * 64;
    const bf16_t *KS = (const bf16_t*)(ws + WS_KS) + bgoff, *VS = (const bf16_t*)(ws + WS_VS) + bgoff, *KW = (const bf16_t*)(ws + WS_KW) + bgoff, *VW = (const bf16_t*)(ws + WS_VW) + bgoff;
    const bf16_t *KCC = (const bf16_t*)(ws + WS_KCC) + (size_t)(b * 2 + g) * 256 * 64, *VCC = (const bf16_t*)(ws + WS_VCC) + (size_t)(b * 2 + g) * 256 * 64;
    LAS char* ring = lds + AL_KV;
    const LAS float* luts = (const LAS float*)(lds + AL_LUTS) + hh * LUTS_N;
    const LAS float* lutw = (const LAS float*)(lds + AL_LUTW) + hh * LUTW_N;
    const LAS float* negp = (const LAS float*)(lds + AL_NEGP);
    WAITBAR(0);
    const int ntc = (4 * i + 3 + 63) >> 6;
#pragma unroll
    for (int p = 0; p < 4; ++p) if (p < ntc) kv_dma(KCC + (size_t)p * 4096, VCC + (size_t)p * 4096, ring + p * 16384, w, lane);
    bf16x8 qr[4];
    { const bf16_t* Qp = QA + ((size_t)(b * 8 + head) * SEQ + tq) * 64;
#pragma unroll
      for (int d0 = 0; d0 < 4; ++d0) qr[d0] = *(const bf16x8*)(Qp + d0 * 16 + hi * 8); }
    const int vlane = ((lane >> 4) & 1) * 32 + (lane & 3) * 8 + (4 * hi + ((lane & 15) >> 2)) * 64 + 8192;
    const float* GT = (const float*)(ws + WS_GATES) + (size_t)(b * SEQ + tq) * 24 + head * 3;
    const float g_c = GT[0], g_s = GT[1], g_w = GT[2];
    const float cfar = luts[0];
    LAS char* stash = lds + ((w < 6) ? AL_STA + w * 4096 : AL_STB + (w - 6) * 4096) + lane * 16;
    const int j0 = (i >= 8) ? i - 8 : 0, nw = i - j0 + 1;
    f32x16 oc[2];
    {
#pragma unroll
        for (int r = 0; r < 16; ++r) { oc[0][r] = 0.f; oc[1][r] = 0.f; }
        float lc = 0.f, carry = 0.f;
        { LAS int* iz = (LAS int*)(lds + AL_IMP); for (int k = tid; k < 64 * 65; k += NTHR) iz[k] = 0; }
        WAITBAR(0);
        for (int t = 0; t < ntc; ++t) {
            f32x16 p0, p1;
            init_scores(p0, p1, (tq - 31) - 16 * (64 * t + 4 * hi), 16, 1 << 20, true, luts);
            qk_tile(p0, p1, ring + t * 16384, qr, r32, hi);
            lc += exp_tile(p0, p1);
        }
        lc += __shfl_xor(lc, 32);
        const float lcinv = (tq >= 31) ? 1.0f / lc : 0.f;
        LAS int* impq = (LAS int*)(lds + AL_IMP) + (32 * qh + r32);
        for (int t = 0; t < ntc; ++t) {
            const LAS char* buf = ring + t * 16384;
            f32x16 p0, p1; bf16x8 vf[8];
            init_scores(p0, p1, (tq - 31) - 16 * (64 * t + 4 * hi), 16, 1 << 20, true, luts);
            qk_tile(p0, p1, buf, qr, r32, hi);
            v_load(vf, buf + vlane); SCHED_FENCE();
#pragma unroll
            for (int r = 0; r < 16; ++r) { p0[r] = fexp2(p0[r]) * lcinv; p1[r] = fexp2(p1[r]) * lcinv; }
#pragma unroll
            for (int blk = 0; blk < 2; ++blk)
#pragma unroll
                for (int g4 = 0; g4 < 4; ++g4) {
                    const f32x16& p = blk ? p1 : p0;
                    const float a = p[4 * g4] + p[4 * g4 + 1] + p[4 * g4 + 2] + 0.5f * p[4 * g4 + 3], bn = 0.5f * p[4 * g4 + 3];
                    const float pb = __shfl_xor(bn, 32);
                    const float v = hi ? (a + pb) : (a + carry); carry = pb;
                    const int j = 16 * t + 8 * blk + 2 * g4 + hi;
                    (void)__hip_atomic_fetch_add(impq + j * 65, (int)(v * 67108864.0f + 0.5f), __ATOMIC_RELAXED, __HIP_MEMORY_SCOPE_WORKGROUP);
                }
            pv_mma(oc, vf, p0, p1);
        }
#pragma unroll
        for (int r = 0; r < 16; ++r) { oc[0][r] *= g_c; oc[1][r] *= g_c; }
        WAITBAR(0);
#pragma unroll
        for (int p = 0; p < 3; ++p) if (p < nw) kv_dma(KW + (size_t)(j0 + p) * 4096, VW + (size_t)(j0 + p) * 4096, ring + p * 16384, w, lane);
    }
    {
        const LAS int* imp = (const LAS int*)(lds + AL_IMP);
        LAS unsigned* selm = (LAS unsigned*)(lds + AL_SEL);
        unsigned um0 = 0u, um1 = 0u;
        for (int qq = 0; qq < 8; ++qq) {
            const int q = w * 8 + qq;
            int v = imp[lane * 65 + q];
            if (lane == 0 || lane == i || lane == i - 1) v = 0x7fffffff; else if (lane > i) v = -1;
            int thr = 0;
#pragma unroll
            for (int bit = 30; bit >= 0; --bit) { const int cand = thr | (1 << bit); if (__popcll(__ballot(v >= cand)) >= 16) thr = cand; }
            const unsigned long long gtm = __ballot(v > thr), eqm = __ballot(v == thr);
            const int need = 16 - __popcll(gtm);
            const bool sel = ((v > thr) || (v == thr && __popcll(eqm & ((1ull << lane) - 1ull)) < need)) && (lane <= i);
            const unsigned long long mk = __ballot(sel);
            if (lane == 0) { selm[q * 2] = (unsigned)mk; selm[q * 2 + 1] = (unsigned)(mk >> 32); }
            um0 |= (unsigned)mk; um1 |= (unsigned)(mk >> 32);
        }
        if (lane == 0) { selm[128 + w * 2] = um0; selm[128 + w * 2 + 1] = um1; }
        asm volatile("s_waitcnt lgkmcnt(0)\n\ts_barrier" ::: "memory");
        stash_store(stash, oc);
        if (w == 0) {
            unsigned a0 = 0u, a1 = 0u;
#pragma unroll
            for (int k = 0; k < 8; ++k) { a0 |= selm[128 + 2 * k]; a1 |= selm[128 + 2 * k + 1]; }
            const unsigned long long um = ((unsigned long long)a1 << 32) | a0;
            LAS int* ul = (LAS int*)(lds + AL_SEL + 1024);
            if ((um >> lane) & 1ull) ul[__popcll(um & ((1ull << lane) - 1ull))] = lane;
            if (lane == 0) ul[64] = __popcll(um);
        }
    }
    const int koff = hi * 1024 + r32 * 16;
#define BAR_V(N) asm volatile("s_waitcnt vmcnt(" #N ")\n\ts_barrier" ::: "memory")
#define NSA_STEP(T, C0, C1, N0, N1) do { const int t_ = (T); \
        if (t_ > 0) asm volatile("s_barrier" ::: "memory");                \
        if (t_ + 3 < n_) { NSA_DMA(t_ + 3); } \
        const int tn_ = min(t_ + 1, n_ - 1); \
        NSA_INIT(tn_, N0, N1); \
        bf16x8 kf_[8], vf_[8]; \
        k_load(kf_, ring + (tn_ & 3) * 16384 + koff); \
        v_load(vf_, ring + (t_ & 3) * 16384 + vlane); \
        if (t_ + 3 < n_) WAITBAR(2); else WAITBAR(0);                           \
        SCHED_FENCE(); \
        lsum_ += exp_tile(C0, C1); \
        qk_mma(N0, N1, kf_, qr); \
        pv_mma(o_, vf_, C0, C1); \
    } while (0)
#define NSA_STREAM() do { \
        WAITBAR(0); \
        f32x16 a0, a1, b0, b1; \
        NSA_INIT(0, a0, a1); \
        qk_tile(a0, a1, ring, qr, r32, hi); \
        if (w >= 4) asm volatile("s_barrier" ::: "memory"); \
        _Pragma("unroll 1") for (int t = 0; t < n_; t += 2) { NSA_STEP(t, a0, a1, b0, b1); if (t + 1 < n_) NSA_STEP(t + 1, b0, b1, a0, a1); } \
        if (w < 4) asm volatile("s_barrier" ::: "memory"); \
    } while (0)
    {
        f32x16 o_[2];
#pragma unroll
        for (int r = 0; r < 16; ++r) { o_[0][r] = 0.f; o_[1][r] = 0.f; }
        float lsum_ = 0.f;
        const int n_ = nw;
#define NSA_DMA(tt) kv_dma(KW + (size_t)(j0 + (tt)) * 4096, VW + (size_t)(j0 + (tt)) * 4096, ring + ((tt) & 3) * 16384, w, lane)
#define NSA_INIT(tt, S0, S1) init_direct(S0, S1, lutw + (639 - (tq - 64 * (j0 + (tt)) - 4 * hi)))
        NSA_STREAM();
#undef NSA_DMA
#undef NSA_INIT
        lsum_ += __shfl_xor(lsum_, 32); const float sc = g_w / lsum_;
        f32x16 ot[2]; stash_load(stash, ot);
#pragma unroll
        for (int r = 0; r < 16; ++r) { ot[0][r] += sc * o_[0][r]; ot[1][r] += sc * o_[1][r]; }
        stash_store(stash, ot);
    }
    WAITBAR(0);
    f32x16 ot[2];
    {
        const LAS unsigned* selm = (const LAS unsigned*)(lds + AL_SEL);
        const LAS int* ul = (const LAS int*)(lds + AL_SEL + 1024);
        const int n_ = __builtin_amdgcn_readfirstlane(ul[64]);
        const int ulv = ul[lane];
        const unsigned sm0 = selm[(32 * qh + r32) * 2], sm1 = selm[(32 * qh + r32) * 2 + 1];
        f32x16 o_[2];
#pragma unroll
        for (int r = 0; r < 16; ++r) { o_[0][r] = 0.f; o_[1][r] = 0.f; }
        float lsum_ = 0.f;
#define NSA_DMA(tt) do { const int jn_ = __builtin_amdgcn_readlane(ulv, (tt)); kv_dma(KS + (size_t)jn_ * 4096, VS + (size_t)jn_ * 4096, ring + ((tt) & 3) * 16384, w, lane); } while (0)
#define NSA_INIT(tt, S0, S1) do { const int jA_ = __builtin_amdgcn_readlane(ulv, (tt)); \
            const bool selbit_ = (jA_ < 32) ? ((sm0 >> jA_) & 1u) : ((sm1 >> (jA_ - 32)) & 1u); \
            if (t0 + 32 * qh - (64 * jA_ + 63) >= 1513) { const float c_ = selbit_ ? cfar : NEGF; \
                _Pragma("unroll") for (int r = 0; r < 16; ++r) { S0[r] = c_; S1[r] = c_; } } \
            else init_direct(S0, S1, selbit_ ? (luts + ((LUTN - 1) - (tq - 64 * jA_ - 4 * hi))) : negp); } while (0)
        for (int p = 0; p < 3; ++p) if (p < n_) NSA_DMA(p);
        NSA_STREAM();
#undef NSA_DMA
#undef NSA_INIT
        lsum_ += __shfl_xor(lsum_, 32); const float sc = g_s / lsum_;
        stash_load(stash, ot);
#pragma unroll
        for (int r = 0; r < 16; ++r) { ot[0][r] += sc * o_[0][r]; ot[1][r] += sc * o_[1][r]; }
    }
#undef NSA_STEP
#undef NSA_STREAM
    { bf16_t* O = (bf16_t*)(ws + WS_OA) + (size_t)(b * SEQ + tq) * 512 + head * 64 + 4 * hi;
#pragma unroll
      for (int db = 0; db < 2; ++db)
#pragma unroll
          for (int g4 = 0; g4 < 4; ++g4) { u32x2 v; v.x = pk2(ot[db][4 * g4], ot[db][4 * g4 + 1]); v.y = pk2(ot[db][4 * g4 + 2], ot[db][4 * g4 + 3]); *(u32x2*)(O + 32 * db + 8 * g4) = v; } }
}

__device__ __forceinline__ void dil_unit(const Frame& F, int L, int u) {
    LAS char* lds = (LAS char*)F.lds;
    int tid_l = F.tid; asm volatile("" : "+v"(tid_l));
    const int tid = tid_l, lane = tid & 63, w = __builtin_amdgcn_readfirstlane(tid >> 6), r32 = lane & 31, hi = lane >> 5;
    const int half = w >> 2, wh = w & 3, th = tid & 255;
    const int pair = u & 15, br = (u >> 4) % 3, head = (u / 48) & 7, b = u / 384;
    const int dil = (br == 0) ? 1 : (br == 1) ? 4 : 16, nb = 32 / dil;
    const int beta = 2 * pair + half, res = beta / nb, n = beta % nb;
    unsigned char* ws = F.ws;
    const size_t hoff = (size_t)(b * 8 + head) * SEQ * 64;
    const bf16_t *Q = (const bf16_t*)(ws + WS_QB) + hoff, *K = (const bf16_t*)(ws + WS_KB) + hoff, *V = (const bf16_t*)(ws + WS_VB) + hoff;
    const float* LUTG = (const float*)(ws + WS_LUT) + (size_t)(L * 16 + 8 + head) * LUTN;
    LAS float* lutd = (LAS float*)(lds + AL_DLUT);
    __syncthreads();
    if (tid < 321) { const int nd = 224 - tid; lutd[tid] = (nd < 0 || nd > 128) ? NEGF : LUTG[min(nd * dil, LUTN - 1)]; }
    const int P = 128 * n + 32 * wh + r32, tq = P * dil + res;
    bf16x8 qr[4];
    { const bf16_t* Qp = Q + (size_t)tq * 64;
#pragma unroll
      for (int d0 = 0; d0 < 4; ++d0) qr[d0] = *(const bf16x8*)(Qp + d0 * 16 + hi * 8); }
    LAS char* kvb = lds + AL_KV + half * 32768;
    const LAS char* vboff = (const LAS char*)(kvb + 8192 + ((lane >> 4) & 1) * 32 + (lane & 3) * 8 + (4 * hi + ((lane & 15) >> 2)) * 64);
    f32x16 o[2];
#pragma unroll
    for (int r = 0; r < 16; ++r) { o[0][r] = 0.f; o[1][r] = 0.f; }
    float lsum = 0.f;
    const int tt0 = (n == 0) ? 2 : 0;
    u32x4 rk[2], rv[2];
#define DIL_LOAD(tt) do { const int Pk0 = 128 * (n - 1) + 64 * (tt); if (Pk0 >= 0) { _Pragma("unroll") for (int k = 0; k < 2; ++k) { const int c = th + 256 * k; \
        rk[k] = *(const u32x4*)(K + (size_t)((Pk0 + (c & 63)) * dil + res) * 64 + (c >> 6) * 8); \
        rv[k] = *(const u32x4*)(V + (size_t)((Pk0 + ((c >> 2) & 63)) * dil + res) * 64 + (c >> 8) * 32 + (c & 3) * 8); } } } while (0)
#define DIL_STORE(bufi) do { _Pragma("unroll") for (int k = 0; k < 2; ++k) { const int c = th + 256 * k; *(LAS u32x4*)(kvb + (bufi) * 16384 + c * 16) = rk[k]; *(LAS u32x4*)(kvb + (bufi) * 16384 + 8192 + c * 16) = rv[k]; } } while (0)
    DIL_LOAD(0); DIL_STORE(0); __syncthreads();
#pragma unroll 1
    for (int tt = 0; tt < 4; ++tt) {
        if (tt + 1 < 4) DIL_LOAD(tt + 1);
        const int ndmax = 128 + 32 * wh + 31 - 64 * tt, ndmin = 128 + 32 * wh - 64 * tt - 63;
        if (tt >= tt0 && ndmax >= 0 && ndmin <= 128) {
            const LAS char* buf = kvb + (tt & 1) * 16384;
            f32x16 p0, p1;
            init_direct(p0, p1, lutd + (224 - (128 + 32 * wh + r32 - 64 * tt - 4 * hi)));
            bf16x8 vf[8];
            qk_tile(p0, p1, buf, qr, r32, hi);
            v_load(vf, vboff + (tt & 1) * 16384); SCHED_FENCE();
            lsum += exp_tile(p0, p1);
            pv_mma(o, vf, p0, p1);
        }
        if (tt + 1 < 4) DIL_STORE((tt + 1) & 1);
        __syncthreads();
    }
#undef DIL_LOAD
#undef DIL_STORE
    const float lt = lsum + __shfl_xor(lsum, 32), linv = 1.0f / lt;
    const size_t tok = (size_t)b * SEQ + tq;
    if (hi == 0) ((float*)(ws + WS_LSE))[((size_t)br * MTOK + tok) * 8 + head] = (((const float*)(ws + WS_BSH))[L] + __log2f(lt)) * LN2;
    bf16_t* O = (bf16_t*)(ws + WS_OB) + ((size_t)br * MTOK + tok) * 512 + head * 64 + 4 * hi;
#pragma unroll
    for (int db = 0; db < 2; ++db)
#pragma unroll
        for (int g4 = 0; g4 < 4; ++g4) { u32x2 v; v.x = pk2(o[db][4 * g4] * linv, o[db][4 * g4 + 1] * linv); v.y = pk2(o[db][4 * g4 + 2] * linv, o[db][4 * g4 + 3] * linv); *(u32x2*)(O + 32 * db + 8 * g4) = v; }
}

__device__ __forceinline__ void norm_row(const float* xrow, const float* gain, bf16_t* orow, int lane, f32x4 (&v)[4]) {
    float s = 0.f;
#pragma unroll
    for (int j = 0; j < 4; ++j) { v[j] = *(const f32x4*)(xrow + 4 * lane + 256 * j); s += (v[j][0] * v[j][0] + v[j][1] * v[j][1]) + (v[j][2] * v[j][2] + v[j][3] * v[j][3]); }
    const float rstd = __builtin_amdgcn_rsqf(wave_sum(s) * (1.0f / DM) + RMS_EPS);
#pragma unroll
    for (int j = 0; j < 4; ++j) { const f32x4 gg = *(const f32x4*)(gain + 4 * lane + 256 * j); v[j] = v[j] * rstd * gg;
        u32x2 o; o.x = pk2(v[j][0], v[j][1]); o.y = pk2(v[j][2], v[j][3]); *(u32x2*)(orow + 4 * lane + 256 * j) = o; }
}

__device__ __forceinline__ void norm_row_b(const bf16_t* xrow, const float* gain, bf16_t* orow, int lane, f32x4 (&v)[4]) {
    float s = 0.f;
#pragma unroll
    for (int j = 0; j < 4; ++j) { const u32x2 a = *(const u32x2*)(xrow + 4 * lane + 256 * j); v[j] = (f32x4){bflo(a.x), bfhi(a.x), bflo(a.y), bfhi(a.y)}; s += (v[j][0] * v[j][0] + v[j][1] * v[j][1]) + (v[j][2] * v[j][2] + v[j][3] * v[j][3]); }
    const float rstd = __builtin_amdgcn_rsqf(wave_sum(s) * (1.0f / DM) + RMS_EPS);
#pragma unroll
    for (int j = 0; j < 4; ++j) { const f32x4 gg = *(const f32x4*)(gain + 4 * lane + 256 * j); v[j] = v[j] * rstd * gg;
        *(unsigned*)((unsigned char*)orow + 4 * lane + 256 * j) = pk4_fp8(v[j][0] * FP8_ASCALE, v[j][1] * FP8_ASCALE, v[j][2] * FP8_ASCALE, v[j][3] * FP8_ASCALE); }
}
template <int RB> __device__ __forceinline__ void norm_rows(const float* X, const float* gain, bf16_t* U, int m0, int mstride, int lane) {
    f32x4 v[RB][4];
#pragma unroll
    for (int r = 0; r < RB; ++r)
#pragma unroll
        for (int j = 0; j < 4; ++j) v[r][j] = *(const f32x4*)(X + (size_t)(m0 + r * mstride) * DM + 4 * lane + 256 * j);
    f32x4 gg[4];
#pragma unroll
    for (int j = 0; j < 4; ++j) gg[j] = *(const f32x4*)(gain + 4 * lane + 256 * j);
#pragma unroll
    for (int r = 0; r < RB; ++r) {
        float s2 = 0.f;
#pragma unroll
        for (int j = 0; j < 4; ++j) s2 += (v[r][j][0] * v[r][j][0] + v[r][j][1] * v[r][j][1]) + (v[r][j][2] * v[r][j][2] + v[r][j][3] * v[r][j][3]);
        const float rstd = __builtin_amdgcn_rsqf(wave_sum(s2) * (1.0f / DM) + RMS_EPS);
        bf16_t* orow = U + (size_t)(m0 + r * mstride) * DM;
#pragma unroll
        for (int j = 0; j < 4; ++j) { const f32x4 x = v[r][j] * rstd * gg[j]; u32x2 o; o.x = pk2(x[0], x[1]); o.y = pk2(x[2], x[3]); *(u32x2*)(orow + 4 * lane + 256 * j) = o; }
    }
}

__device__ __forceinline__ void moe_combine(unsigned char* ws, float* out, int ncw, int cw0, bool want_tail) {
    const bf16_t* HB = (const bf16_t*)(ws + WS_HB);
    int tid_l_ = threadIdx.x; asm volatile("" : "+v"(tid_l_)); const int lane = tid_l_ & 63, wave = __builtin_amdgcn_readfirstlane(tid_l_ >> 6), cw = cw0 + wave;
    const int* tokpos = (const int*)(ws + RT_TOKPOS); const float* topG = (const float*)(ws + RT_TOPG); const bf16_t* Y = (const bf16_t*)(ws + WS_VSORT);
    for (int mb = cw; mb < MTOK; mb += 2 * ncw) {
        int pa[2], pb2[2]; float ga[2], gb[2]; bool act[2];
#pragma unroll
        for (int r = 0; r < 2; ++r) { const int m = mb + r * ncw; act[r] = (m < MTOK); const int mm = act[r] ? m : 0; pa[r] = tokpos[mm * 2]; pb2[r] = tokpos[mm * 2 + 1]; ga[r] = topG[mm * 2]; gb[r] = topG[mm * 2 + 1];
            act[r] = act[r] && (((pa[r] >= 65536) || (pb2[r] >= 65536)) == want_tail); }
        if (!(act[0] || act[1])) continue;
        u32x2 hv[2][4]; u32x2 ya[2][4], yb[2][4];
#pragma unroll
        for (int r = 0; r < 2; ++r) if (act[r]) { const int m = mb + r * ncw; const bf16_t* o = HB + (size_t)m * DM; const bf16_t* y0 = Y + (size_t)pa[r] * DM; const bf16_t* y1 = Y + (size_t)pb2[r] * DM;
#pragma unroll
            for (int j = 0; j < 4; ++j) { const int c = 4 * lane + 256 * j; hv[r][j] = *(const u32x2*)(o + c); ya[r][j] = *(const u32x2*)(y0 + c); yb[r][j] = *(const u32x2*)(y1 + c); } }
#pragma unroll
        for (int r = 0; r < 2; ++r) if (act[r]) { const int m = mb + r * ncw; float* o = out + (size_t)m * DM; const float g0 = ga[r], g1 = gb[r];
#pragma unroll
            for (int j = 0; j < 4; ++j) { const int c = 4 * lane + 256 * j; const u32x2 hb = hv[r][j]; f32x4 v = (f32x4){bflo(hb.x), bfhi(hb.x), bflo(hb.y), bfhi(hb.y)}; const u32x2 a = ya[r][j], b = yb[r][j];
                v[0] += g0 * bflo(a.x) + g1 * bflo(b.x); v[1] += g0 * bfhi(a.x) + g1 * bfhi(b.x); v[2] += g0 * bflo(a.y) + g1 * bflo(b.y); v[3] += g0 * bfhi(a.y) + g1 * bfhi(b.y);
                *(f32x4*)(o + c) = v; } }
    }
}

template <int RB, bool FP8OUT = false> __device__ __forceinline__ void norm_rows_b(const bf16_t* X, const float* gain, void* Uv, int m0, int mstride, int lane) {
    bf16_t* U = (bf16_t*)Uv;
    u32x4 x[RB][2];
#pragma unroll
    for (int r = 0; r < RB; ++r)
#pragma unroll
        for (int j = 0; j < 2; ++j) x[r][j] = *(const u32x4*)(X + (size_t)(m0 + r * mstride) * DM + 8 * lane + 512 * j);
    f32x4 gg[2][2];
#pragma unroll
    for (int j = 0; j < 2; ++j) { gg[j][0] = *(const f32x4*)(gain + 8 * lane + 512 * j); gg[j][1] = *(const f32x4*)(gain + 8 * lane + 512 * j + 4); }
#pragma unroll
    for (int r = 0; r < RB; ++r) {
        float v[2][8]; float s2 = 0.f;
#pragma unroll
        for (int j = 0; j < 2; ++j) { const u32x4 a = x[r][j]; v[j][0] = bflo(a.x); v[j][1] = bfhi(a.x); v[j][2] = bflo(a.y); v[j][3] = bfhi(a.y); v[j][4] = bflo(a.z); v[j][5] = bfhi(a.z); v[j][6] = bflo(a.w); v[j][7] = bfhi(a.w);
#pragma unroll
            for (int c = 0; c < 8; ++c) s2 += v[j][c] * v[j][c]; }
        const float rstd = __builtin_amdgcn_rsqf(wave_sum(s2) * (1.0f / DM) + RMS_EPS);
        if constexpr (FP8OUT) { unsigned char* orow = (unsigned char*)Uv + (size_t)(m0 + r * mstride) * DM; const float rs = rstd * FP8_ASCALE;
#pragma unroll
            for (int j = 0; j < 2; ++j) { u32x2 o; o.x = pk4_fp8(v[j][0] * rs * gg[j][0][0], v[j][1] * rs * gg[j][0][1], v[j][2] * rs * gg[j][0][2], v[j][3] * rs * gg[j][0][3]);
                o.y = pk4_fp8(v[j][4] * rs * gg[j][1][0], v[j][5] * rs * gg[j][1][1], v[j][6] * rs * gg[j][1][2], v[j][7] * rs * gg[j][1][3]); *(u32x2*)(orow + 8 * lane + 512 * j) = o; } }
        else { bf16_t* orow = U + (size_t)(m0 + r * mstride) * DM;
#pragma unroll
        for (int j = 0; j < 2; ++j) { u32x4 o; o.x = pk2(v[j][0] * rstd * gg[j][0][0], v[j][1] * rstd * gg[j][0][1]); o.y = pk2(v[j][2] * rstd * gg[j][0][2], v[j][3] * rstd * gg[j][0][3]);
            o.z = pk2(v[j][4] * rstd * gg[j][1][0], v[j][5] * rstd * gg[j][1][1]); o.w = pk2(v[j][6] * rstd * gg[j][1][2], v[j][7] * rstd * gg[j][1][3]); *(u32x4*)(orow + 8 * lane + 512 * j) = o; } }
    }
}

__global__ void __launch_bounds__(NTHR, 2) trunk_fwd(Args args) {
    extern __shared__ __attribute__((aligned(16))) unsigned char lds_raw[];
    Frame F;
    F.lds = (LAS unsigned char*)lds_raw;
    F.tid = threadIdx.x; F.lane = F.tid & 63; F.wave = __builtin_amdgcn_readfirstlane(F.tid >> 6);
    F.G = gridDim.x; F.wg = blockIdx.x; F.ws = args.ws; F.in = args.in; F.out = args.out;
    unsigned char* ws = args.ws;
    volatile LAS unsigned* MISC = (volatile LAS unsigned*)(F.lds + LDSCTL_OFF);
    for (int u = F.tid; u < (LDS_BYTES - LDSCTL_OFF) / 4; u += NTHR) ((LAS unsigned*)(F.lds + LDSCTL_OFF))[u] = 0u;
    __syncthreads();
    unsigned* ctl = (unsigned*)(ws + WS_CTL);
    XcdBarrier bar; bar.bar = ctl + CW_BAR + args.li * 4096; bar.x = 0; bar.st = nullptr;
    if (!MK_MULTI) bar = xcd_barrier_post(ctl + CW_BAR + args.li * 4096, MISC + 8);
    const int lo = args.ph_lo, hi_ = args.ph_hi;
#define IN(k) (lo <= (k) && (k) < hi_)
#define EN(g) (((PHMASK) >> (g)) & 1u)
#define NREP(g) ((((PROBE_DUP) >> (g)) & 1u) && L == 0 ? 2 : 1)
#define NREPX(g) ((((PROBE_DUP) >> (g)) & 1u) ? 2 : 1)
#define SEAM(k) do { if (IN(k) && IN((k) + 1)) { if ((PROBE_TM >> (k)) & 1ull) { const unsigned long long t1_ = __builtin_amdgcn_s_memrealtime(); while (__builtin_amdgcn_s_memrealtime() - t1_ < t1_ - tprev_) __builtin_amdgcn_s_sleep(8); } \
        xcd_barrier(bar); if (PROBE_BAR) xcd_barrier(bar); if ((PROBE_SLP >> (k)) & 1ull) { const unsigned long long t2_ = __builtin_amdgcn_s_memrealtime(); while (__builtin_amdgcn_s_memrealtime() - t2_ < 10000ull) __builtin_amdgcn_s_sleep(8); } if (PROBE_TM != 0ull) tprev_ = __builtin_amdgcn_s_memrealtime(); } } while (0)
    unsigned long long tprev_ = (PROBE_TM != 0ull) ? __builtin_amdgcn_s_memrealtime() : 0ull;
    const int NGW = F.G * NWAVES;
#define LAUNDER int tid_l_ = threadIdx.x; asm volatile("" : "+v"(tid_l_)); const int tid = tid_l_, lane = tid & 63, wave = __builtin_amdgcn_readfirstlane(tid >> 6), gw = F.wg * NWAVES + wave; (void)gw; (void)lane; (void)wave;

    if (EN(0) && IN(0)) { LAUNDER;
        LAS float* scr = (LAS float*)(F.lds + wave * 16384);
        for (int rep = 0; rep < NREPX(0); ++rep) for (int L = 0; L < 2; ++L) {
            conv_inproj(args.in[I_WIN] + (size_t)L * DM * IN_W, (bf16_t*)(ws + WS_WIN) + (size_t)L * INP * DM, scr, gw, NGW, lane);
            for (int kv = 0; kv < 2; ++kv) conv_plain(args.in[I_CW1] + (size_t)(L * 2 + kv) * 2048 * 256, 2048, 256, (bf16_t*)(ws + WS_WC1) + (size_t)(L * 2 + kv) * 256 * 2048, scr, gw, NGW, lane);
            conv_plain(args.in[I_WOUT] + (size_t)L * DM * DM, DM, DM, (bf16_t*)(ws + WS_WO) + (size_t)L * DM * DM, scr, gw, NGW, lane);
            for (int kv = 0; kv < 2; ++kv) conv_plain(args.in[I_CW2] + (size_t)(L * 2 + kv) * 256 * 64, 256, 64, (bf16_t*)(ws + WS_WC2) + (size_t)(L * 2 + kv) * 64 * 256, scr, gw, NGW, lane);
        }
        conv_gateup_f8(args.in[I_FG], args.in[I_FU], DM, DFF, ws + WS_WF1, scr, gw, NGW, lane);
        conv_plain<true>(args.in[I_FD], DFF, DM, ws + WS_WF2, scr, gw, NGW, lane);
        { int* rowtok = (int*)(ws + RT_ROWTOK); for (int k = F.wg * NTHR + tid; k < MOE_ROWS_MAX; k += F.G * NTHR) rowtok[k] = -1; }
        { LAS float* bsh = (LAS float*)(F.lds + 8 * 16384);
          if (wave == 0) { const float* rb = args.in[I_RELB]; float bm = 0.f;
              for (int k = lane; k < 512; k += 64) bm = fmaxf(bm, fabsf(rb[k]));
              for (int L = 0; L < 2; ++L) { float gq = fmaxf(fabsf(args.in[I_QN][L * 64 + lane]), fabsf(args.in[I_DQN][L * 64 + lane]));
                  float gk = fmaxf(fmaxf(fabsf(args.in[I_KN][L * 192 + lane]), fabsf(args.in[I_KN][L * 192 + 64 + lane])), fmaxf(fabsf(args.in[I_KN][L * 192 + 128 + lane]), fabsf(args.in[I_DKN][L * 64 + lane])));
                  float bb = bm;
#pragma unroll
                  for (int o = 1; o < 64; o <<= 1) { gq = fmaxf(gq, __shfl_xor(gq, o)); gk = fmaxf(gk, __shfl_xor(gk, o)); bb = fmaxf(bb, __shfl_xor(bb, o)); }
                  const float B = (8.0f * LOG2E * gq * gk + LOG2E * bb) * 1.002f + 0.05f;
                  if (lane == 0) { bsh[L] = B; if (F.wg == 0) ((float*)(ws + WS_BSH))[L] = B; } } }
          __syncthreads();
          float* LUT = (float*)(ws + WS_LUT); const float* rb = args.in[I_RELB];
          for (int k = F.wg * NTHR + tid; k < 2 * 16 * LUTN; k += F.G * NTHR) { const int L = k / (16 * LUTN), h = (k / LUTN) & 15, d = k % LUTN; int bk;
              if (d < 16) bk = d; else { bk = 16; bk += (d >= 22); bk += (d >= 30); bk += (d >= 40); bk += (d >= 54); bk += (d >= 73); bk += (d >= 99); bk += (d >= 134); bk += (d >= 182);
                  bk += (d >= 246); bk += (d >= 332); bk += (d >= 450); bk += (d >= 609); bk += (d >= 825); bk += (d >= 1117); bk += (d >= 1513); }
              LUT[k] = rb[bk * 16 + h] * LOG2E - bsh[L]; } }
        { float* B1P = (float*)(ws + WS_B1P);
          for (int it = gw; it < 2 * 2 * 16 * 4; it += NGW) { const int cg = it & 3, s = (it >> 2) & 15, lk = it >> 6;
              const float* pos = args.in[I_CPOS] + (size_t)lk * 2048 + s * 128; const float* w1 = args.in[I_CW1] + (size_t)lk * 2048 * 256 + (size_t)s * 128 * 256 + cg * 64 + lane;
              float a = 0.f;
              for (int p = 0; p < 128; ++p) a += pos[p] * w1[(size_t)p * 256];
              B1P[((size_t)lk * 16 + s) * 256 + cg * 64 + lane] = a; } }
    }

    for (int L = 0; L < 2; ++L) {
        const int pb = 1 + 10 * L;
        bf16_t* HB = (bf16_t*)(ws + WS_HB);
        if (EN(1) && IN(pb + 0)) { LAUNDER;
            bf16_t* U = (bf16_t*)(ws + WS_U); const float* gain = args.in[I_ANORM] + L * DM;
            if (L == 0) { for (int rep = 0; rep < NREP(1); ++rep) for (int m = gw; m < MTOK; m += 4 * NGW) norm_rows<4>(args.in[I_X], gain, U, m, NGW, lane); }
            else { for (int m = gw; m < MTOK; m += 4 * NGW) norm_rows_b<4>(HB, gain, U, m, NGW, lane); }
        }
        SEAM(pb + 0);
        if (EN(2) && IN(pb + 1)) {
            { LAUNDER;
            if (F.wg == 0) { const int kv = tid >> 8, j = tid & 255; const float* B1P = (const float*)(ws + WS_B1P) + (size_t)(L * 2 + kv) * 16 * 256;
                float a = args.in[I_CB1][(L * 2 + kv) * 256 + j];
                for (int s = 0; s < 16; ++s) a += B1P[s * 256 + j];
                ((float*)(ws + WS_B1E))[(L * 2 + kv) * 256 + j] = a; }
            }
            pg8::Dims g{DM, DM, DM}; pg8::StaticOrder S; S.init(MTOK, INP, F.G, F.wg, ws + WS_U, (bf16_t*)(ws + WS_WIN) + (size_t)L * INP * DM, DM, DM);
            EpiInProj E{ws, args.in[I_QN] + L * 64, args.in[I_KN] + L * 192, args.in[I_DQN] + L * 64, args.in[I_DKN] + L * 64};
            for (int rep = 0; rep < NREP(2); ++rep) pg8::gemm_phase<EpiInProj, pg8::StaticOrder>(F.lds, g, S, E);
        }
        SEAM(pb + 1);
        if (IN(pb + 2)) {
            if (F.wg < 32) {
                if (EN(3)) {
                    pg8::Dims g{2048, 1024, 2048}; SchedCmp S{F.wg, (const char*)(ws + WS_KC), (const char*)(ws + WS_VC), (const char*)((bf16_t*)(ws + WS_WC1) + (size_t)L * 2 * 256 * 2048)};
                    EpiCmp1 E{(bf16_t*)(ws + WS_HC), (const float*)(ws + WS_B1E) + L * 2 * 256};
                    pg8::gemm_phase<EpiCmp1, SchedCmp>(F.lds, g, S, E);
                }
                if (EN(4)) { LAUNDER;
                    asm volatile("s_waitcnt vmcnt(0)" ::: "memory"); __syncthreads();
                    __builtin_amdgcn_fence(__ATOMIC_ACQUIRE, "agent"); asm volatile("s_waitcnt vmcnt(0)" ::: "memory");
                    const bf16_t* HC = (const bf16_t*)(ws + WS_HC);
                    const int kv = F.wg >> 4, row0 = kv * 4096 + (F.wg & 15) * 256 + wave * 32, r32 = lane & 31, hi = lane >> 5;
                    const bf16_t* hrow = HC + (size_t)(row0 + r32) * 256 + hi * 8;
                    const bf16_t* wT = (const bf16_t*)(ws + WS_WC2) + (size_t)(L * 2 + kv) * 64 * 256 + (size_t)r32 * 256 + hi * 8;
                    f32x16 o0, o1;
#pragma unroll
                    for (int r = 0; r < 16; ++r) { o0[r] = 0.f; o1[r] = 0.f; }
#pragma unroll
                    for (int sk = 0; sk < 16; ++sk) { const bf16x8 bf = *(const bf16x8*)(hrow + 16 * sk), a0 = *(const bf16x8*)(wT + 16 * sk), a1 = *(const bf16x8*)(wT + 32 * 256 + 16 * sk);
                        o0 = mfma32(a0, bf, o0); o1 = mfma32(a1, bf, o1); }
                    if (kv == 0) { float ss = 0.f;
#pragma unroll
                        for (int r = 0; r < 16; ++r) ss += o0[r] * o0[r] + o1[r] * o1[r];
                        ss += __shfl_xor(ss, 32); const float rs = __builtin_amdgcn_rsqf(ss * (1.0f / 64.0f) + RMS_EPS); const float* gn = args.in[I_KN] + L * 192;
#pragma unroll
                        for (int r = 0; r < 16; ++r) { const int d = (r & 3) + 8 * (r >> 2) + 4 * hi; o0[r] *= rs * gn[d]; o1[r] *= rs * gn[d + 32]; } }
                    const int rr = (row0 + r32) & 4095; const float z = ((rr & 255) == 255) ? 0.f : 1.f;
                    bf16_t* dst = (bf16_t*)(ws + (kv ? WS_VCC : WS_KCC)) + (size_t)rr * 64 + 4 * hi;
#pragma unroll
                    for (int g4 = 0; g4 < 4; ++g4) { u32x2 v; v.x = pk2(o0[4 * g4] * z, o0[4 * g4 + 1] * z); v.y = pk2(o0[4 * g4 + 2] * z, o0[4 * g4 + 3] * z); *(u32x2*)(dst + 8 * g4) = v;
                        u32x2 w2; w2.x = pk2(o1[4 * g4] * z, o1[4 * g4 + 1] * z); w2.y = pk2(o1[4 * g4 + 2] * z, o1[4 * g4 + 3] * z); *(u32x2*)(dst + 32 + 8 * g4) = w2; }
                }
            } else if (EN(6)) {
                for (int k = 0; k < DIL_EARLY; ++k) dil_unit(F, L, (F.wg - 32) * DIL_EARLY + k);
                __syncthreads();
            }
        }
        SEAM(pb + 2);
        if (IN(pb + 4)) {
            if (EN(5) && F.wg < 512) nsa_prepare(F, L, F.wg & 1);
            if (EN(5)) for (int rep = 0; rep < NREP(5); ++rep) for (int p = F.wg; p < 512; p += F.G) { const int bg = (p & 7) + 8 * (p >> 8), s = (p >> 3) & 31; nsa_unit(F, L, bg >> 1, bg & 1, s); nsa_unit(F, L, bg >> 1, bg & 1, 63 - s); }
            if (EN(6)) for (int rep = 0; rep < NREP(6); ++rep) for (int u = (F.G - 32) * DIL_EARLY + F.wg; u < 3072; u += F.G) dil_unit(F, L, u);
            __syncthreads();
        }
        SEAM(pb + 4);
        if (EN(7) && IN(pb + 5)) { LAUNDER;
            bf16_t* ON = (bf16_t*)(ws + WS_U); const float* og = args.in[I_ONORM] + L * DM;
            const bf16_t* OA = (const bf16_t*)(ws + WS_OA); const bf16_t* OB = (const bf16_t*)(ws + WS_OB); const float* LSE = (const float*)(ws + WS_LSE);
            const f32x4 ga0 = *(const f32x4*)(og + 8 * lane), ga1 = *(const f32x4*)(og + 8 * lane + 4), gb0 = *(const f32x4*)(og + 512 + 8 * lane), gb1 = *(const f32x4*)(og + 512 + 8 * lane + 4);
            const int hd = lane >> 3;
            for (int rep = 0; rep < NREP(7); ++rep) for (int mb = gw; mb < MTOK; mb += 4 * NGW) {
                u32x4 xa[4], x0[4], x1[4], x2[4]; float q0[4], q1[4], q2[4];
#pragma unroll
                for (int r = 0; r < 4; ++r) { const size_t m = (size_t)(mb + r * NGW);
                    xa[r] = *(const u32x4*)(OA + m * 512 + 8 * lane);
                    x0[r] = *(const u32x4*)(OB + ((size_t)0 * MTOK + m) * 512 + 8 * lane); x1[r] = *(const u32x4*)(OB + ((size_t)1 * MTOK + m) * 512 + 8 * lane); x2[r] = *(const u32x4*)(OB + ((size_t)2 * MTOK + m) * 512 + 8 * lane);
                    q0[r] = LSE[((size_t)0 * MTOK + m) * 8 + hd]; q1[r] = LSE[((size_t)1 * MTOK + m) * 8 + hd]; q2[r] = LSE[((size_t)2 * MTOK + m) * 8 + hd]; }
#pragma unroll
                for (int r = 0; r < 4; ++r) { const size_t m = (size_t)(mb + r * NGW);
                    { const u32x4 a = xa[r];
                      float v[8] = {bflo(a.x), bfhi(a.x), bflo(a.y), bfhi(a.y), bflo(a.z), bfhi(a.z), bflo(a.w), bfhi(a.w)};
                      float s2 = 0.f;
#pragma unroll
                      for (int c = 0; c < 8; ++c) s2 += v[c] * v[c];
                      const float rstd = __builtin_amdgcn_rsqf(wave_sum(s2) * (1.0f / 512.0f) + RMS_EPS);
                      u32x4 o; o.x = pk2(v[0] * rstd * ga0[0], v[1] * rstd * ga0[1]); o.y = pk2(v[2] * rstd * ga0[2], v[3] * rstd * ga0[3]); o.z = pk2(v[4] * rstd * ga1[0], v[5] * rstd * ga1[1]); o.w = pk2(v[6] * rstd * ga1[2], v[7] * rstd * ga1[3]);
                      *(u32x4*)(ON + m * DM + 8 * lane) = o; }
                    { const float l0 = q0[r], l1 = q1[r], l2 = q2[r];
                      const float mx = fmaxf(l0, fmaxf(l1, l2)); const float e0 = __expf(l0 - mx), e1 = __expf(l1 - mx), e2 = __expf(l2 - mx); const float inv = __builtin_amdgcn_rcpf(e0 + e1 + e2);
                      const float w0 = e0 * inv, w1 = e1 * inv, w2 = e2 * inv;
                      const u32x4 a0 = x0[r], a1 = x1[r], a2 = x2[r];
                      float v[8];
                      v[0] = w0 * bflo(a0.x) + w1 * bflo(a1.x) + w2 * bflo(a2.x); v[1] = w0 * bfhi(a0.x) + w1 * bfhi(a1.x) + w2 * bfhi(a2.x);
                      v[2] = w0 * bflo(a0.y) + w1 * bflo(a1.y) + w2 * bflo(a2.y); v[3] = w0 * bfhi(a0.y) + w1 * bfhi(a1.y) + w2 * bfhi(a2.y);
                      v[4] = w0 * bflo(a0.z) + w1 * bflo(a1.z) + w2 * bflo(a2.z); v[5] = w0 * bfhi(a0.z) + w1 * bfhi(a1.z) + w2 * bfhi(a2.z);
                      v[6] = w0 * bflo(a0.w) + w1 * bflo(a1.w) + w2 * bflo(a2.w); v[7] = w0 * bfhi(a0.w) + w1 * bfhi(a1.w) + w2 * bfhi(a2.w);
                      float s2 = 0.f;
#pragma unroll
                      for (int c = 0; c < 8; ++c) s2 += v[c] * v[c];
                      const float rstd = __builtin_amdgcn_rsqf(wave_sum(s2) * (1.0f / 512.0f) + RMS_EPS);
                      u32x4 o; o.x = pk2(v[0] * rstd * gb0[0], v[1] * rstd * gb0[1]); o.y = pk2(v[2] * rstd * gb0[2], v[3] * rstd * gb0[3]); o.z = pk2(v[4] * rstd * gb1[0], v[5] * rstd * gb1[1]); o.w = pk2(v[6] * rstd * gb1[2], v[7] * rstd * gb1[3]);
                      *(u32x4*)(ON + m * DM + 512 + 8 * lane) = o; }
                }
            }
        }
        SEAM(pb + 5);
        if (EN(8) && IN(pb + 6)) {
            pg8::Dims g{DM, DM, DM}; pg8::StaticOrder S; S.init(MTOK, DM, F.G, F.wg, ws + WS_U, (bf16_t*)(ws + WS_WO) + (size_t)L * DM * DM, DM, DM);
            if (L == 0) { EpiRes<true> E{args.in[I_X], HB}; for (int rep = 0; rep < NREP(8); ++rep) pg8::gemm_phase<EpiRes<true>, pg8::StaticOrder>(F.lds, g, S, E); }
            else { EpiRes<false> E{HB, HB}; pg8::gemm_phase<EpiRes<false>, pg8::StaticOrder>(F.lds, g, S, E); }
        }
        SEAM(pb + 6);
        if (EN(9) && IN(pb + 7)) { LAUNDER;
            bf16_t* U = (bf16_t*)(ws + WS_U); const float* gain = args.in[I_FNORM] + L * DM;
            if (L == 0) {
                for (int m = gw; m < MTOK; m += 4 * NGW) norm_rows_b<4, true>(HB, gain, U, m, NGW, lane);
            } else {
                LAS int* lcnt = (LAS int*)(F.lds);
                if (tid < 8) lcnt[tid] = 0;
                __syncthreads();
                const float* rw = args.in[I_RW];
                int* topE = (int*)(ws + RT_TOPE); float* topG = (float*)(ws + RT_TOPG);
                const int per = MTOK / F.G, perw = per / NWAVES;
                for (int q = 0; q < perw; q += 2) { const int m0 = F.wg * per + wave * perw + q;
                    f32x4 v[2][4];
#pragma unroll
                    for (int t2 = 0; t2 < 2; ++t2) norm_row_b(HB + (size_t)(m0 + t2) * DM, gain, (bf16_t*)((unsigned char*)U + (size_t)(m0 + t2) * DM), lane, v[t2]);
                    float lg[2][8];
#pragma unroll
                    for (int t2 = 0; t2 < 2; ++t2)
#pragma unroll
                        for (int e = 0; e < 8; ++e) lg[t2][e] = 0.f;
#pragma unroll
                    for (int j = 0; j < 4; ++j)
#pragma unroll
                        for (int c = 0; c < 4; ++c) { const float* rr = rw + (size_t)(4 * lane + 256 * j + c) * 8; const f32x4 r0 = *(const f32x4*)rr, r1 = *(const f32x4*)(rr + 4);
#pragma unroll
                            for (int t2 = 0; t2 < 2; ++t2) { const float x = v[t2][j][c];
                                lg[t2][0] += x * r0[0]; lg[t2][1] += x * r0[1]; lg[t2][2] += x * r0[2]; lg[t2][3] += x * r0[3]; lg[t2][4] += x * r1[0]; lg[t2][5] += x * r1[1]; lg[t2][6] += x * r1[2]; lg[t2][7] += x * r1[3]; } }
#pragma unroll
                    for (int e = 0; e < 8; ++e) { lg[0][e] = wave_sum(lg[0][e]); lg[1][e] = wave_sum(lg[1][e]); }
#pragma unroll
                    for (int t2 = 0; t2 < 2; ++t2) { const int m = m0 + t2;
                        int e1 = 0; float l1 = lg[t2][0];
#pragma unroll
                        for (int e = 1; e < 8; ++e) if (lg[t2][e] > l1) { l1 = lg[t2][e]; e1 = e; }
                        int e2 = -1; float l2 = -3.0e38f;
#pragma unroll
                        for (int e = 0; e < 8; ++e) if (e != e1 && lg[t2][e] > l2) { l2 = lg[t2][e]; e2 = e; }
                        const float g2 = 1.0f / (1.0f + __expf(l1 - l2)), g1 = 1.0f - g2;
                        if (lane == 0) { topE[m * 2] = e1; topE[m * 2 + 1] = e2; topG[m * 2] = g1; topG[m * 2 + 1] = g2; __hip_atomic_fetch_add(&lcnt[e1], 1, __ATOMIC_RELAXED, __HIP_MEMORY_SCOPE_WORKGROUP); __hip_atomic_fetch_add(&lcnt[e2], 1, __ATOMIC_RELAXED, __HIP_MEMORY_SCOPE_WORKGROUP); } }
                }
                __syncthreads();
                if (tid < 8) ((int*)(ws + RT_CNT))[F.wg * 8 + tid] = lcnt[tid];
            }
        }
        SEAM(pb + 7);
        if (L == 0) {
            if (EN(10) && IN(pb + 8)) {
                pg8::Dims g{DM, DM, DM}; pg8::StaticOrder S; S.init(MTOK, 2 * DFF, F.G, F.wg, ws + WS_U, ws + WS_WF1, DM, DM, 1);
                EpiSwigluF8 E{ws + WS_ACT0, DFF, 0};
                for (int rep = 0; rep < NREP(10); ++rep) pg8::gemm_phase_f8d<EpiSwigluF8, pg8::StaticOrder>(F.lds, g, S, E);
            }
            SEAM(pb + 8);
            if (EN(11) && IN(pb + 9)) {
                pg8::Dims g{DFF, DFF, DFF}; pg8::StaticOrder S; S.init(MTOK, DM, F.G, F.wg, ws + WS_ACT0, ws + WS_WF2, DFF, DFF, 1);
                EpiResF8 E{HB};
                pg8::gemm_phase_f8d<EpiResF8, pg8::StaticOrder>(F.lds, g, S, E);
            }
            SEAM(pb + 9);
        }
    }
    if (EN(12) && IN(19)) { LAUNDER;
        LAS int* lc = (LAS int*)(F.lds);
        LAS int* mybase = lc + 2048;
        LAS int* wcnt = mybase + 8;
        LAS int* posl = wcnt + 32;
        const int* cnt = (const int*)(ws + RT_CNT);
        const int nwg = F.G;
        for (int k = tid; k < nwg * 8; k += NTHR) lc[k] = cnt[k];
        __syncthreads();
        if (tid < 8) { int tot = 0, before = 0; for (int w2 = 0; w2 < nwg; ++w2) { if (w2 == F.wg) before = tot; tot += lc[w2 * 8 + tid]; } wcnt[tid] = tot; mybase[tid] = before; }
        __syncthreads();
        if (tid == 0) { int ps = 0; int pst[9]; for (int e = 0; e < 8; ++e) { pst[e] = ps; ps += (wcnt[e] + 255) & ~255; } pst[8] = ps;
            for (int e = 0; e < 8; ++e) mybase[e] += pst[e];
            if (F.wg == 0) { int* P = (int*)(ws + RT_PSTART); for (int e = 0; e < 9; ++e) P[e] = pst[e]; P[9] = ps >> 8; } }
        __syncthreads();
        const int per = MTOK / F.G;
        const int* topE = (const int*)(ws + RT_TOPE); const float* topG = (const float*)(ws + RT_TOPG);
        int myE = -1, myTok = 0; float myG = 0.f; int rank = 0;
        if (tid < 2 * per) { myTok = F.wg * per + (tid >> 1); myE = topE[myTok * 2 + (tid & 1)]; myG = topG[myTok * 2 + (tid & 1)]; }
        if (wave < 4) {
#pragma unroll
            for (int e = 0; e < 8; ++e) { const unsigned long long bm = __ballot(myE == e); if (myE == e) rank = __popcll(bm & ((1ull << lane) - 1ull)); if (lane == 0) wcnt[wave * 8 + e] = __popcll(bm); }
        }
        __syncthreads();
        if (tid < 2 * per) { int pos = mybase[myE] + rank; for (int w2 = 0; w2 < wave; ++w2) pos += wcnt[w2 * 8 + myE];
            ((int*)(ws + RT_ROWTOK))[pos] = myTok; ((float*)(ws + RT_ROWGATE))[pos] = myG; posl[tid] = pos; ((int*)(ws + RT_TOKPOS))[myTok * 2 + (tid & 1)] = pos; }
        __syncthreads();
        const bf16_t* U = (const bf16_t*)(ws + WS_U); bf16_t* VS = (bf16_t*)(ws + WS_VSORT);
        for (int a = wave; a < 2 * per; a += NWAVES) { const int tok = F.wg * per + (a >> 1), pos = posl[a];
            const u32x4* src = (const u32x4*)((const unsigned char*)U + (size_t)tok * DM); u32x4* dst = (u32x4*)(VS + (size_t)pos * DM);
            dst[lane] = src[lane]; }
    }
    __syncthreads();
    if (EN(13) && IN(20)) { LAUNDER;
        LAS float* scr = (LAS float*)(F.lds + wave * 16384);
        for (int rep = 0; rep < NREPX(13); ++rep) for (int e = 0; e < NEXP; ++e) {
            conv_gateup_f8(args.in[I_EG] + (size_t)e * DM * DFE, args.in[I_EU] + (size_t)e * DM * DFE, DM, DFE, ws + WS_WE1 + (size_t)e * 7168 * DM, scr, gw, NGW, lane);
            conv_plain<true>(args.in[I_ED] + (size_t)e * DFE * DM, DFE, DM, ws + WS_WE2 + (size_t)e * DM * DFE, scr, gw, NGW, lane);
        }
    }
    SEAM(20);
    for (int gi = 0; gi < MOE_NG; ++gi) {
        const int* P = (const int*)(ws + RT_PSTART);
        if (EN(14) && IN(21 + 2 * gi)) {
            const int nchunks = __builtin_amdgcn_readfirstlane(P[9]);
            pg8::Dims g{DM, 2 * DM, DM}; SchedMoe1 S{F.wg, F.G, gi * MOE_GROUP, MOE_GROUP, nchunks, P, (const char*)(ws + WS_VSORT), (const char*)(ws + WS_WE1)};
            EpiSwigluF8 E{(unsigned char*)args.out, DFE, gi * MOE_GROUP};
            for (int rep = 0; rep < NREPX(14); ++rep) pg8::gemm_phase_f8d<EpiSwigluF8, SchedMoe1>(F.lds, g, S, E);
        }
        SEAM(21 + 2 * gi);
        if (EN(15) && IN(22 + 2 * gi)) {
            const int nchunks = __builtin_amdgcn_readfirstlane(P[9]);
            { pg8::Dims g{DFE, DFE, DFE}; SchedMoe2 S{F.wg, F.G, gi * MOE_GROUP, MOE_GROUP, nchunks, P, (const char*)args.out, (const char*)(ws + WS_WE2)};
              EpiMoe2F8 E{(bf16_t*)(ws + WS_VSORT), gi * MOE_GROUP};
              for (int rep = 0; rep < NREPX(15); ++rep) pg8::gemm_phase_f8d<EpiMoe2F8, SchedMoe2>(F.lds, g, S, E); }
            if (gi == MOE_NG - 1) { pg8::Dims g{DM, 2 * DM, DM}; SchedMoe1 S{F.wg, F.G, 256, nchunks - 256, nchunks, P, (const char*)(ws + WS_VSORT), (const char*)(ws + WS_WE1)};
              EpiSwigluF8 E{ws + WS_U, DFE, 256};
              pg8::gemm_phase_f8d<EpiSwigluF8, SchedMoe1>(F.lds, g, S, E); }
        }
        SEAM(22 + 2 * gi);
    }
    if (EN(16) && IN(21 + 2 * MOE_NG)) {
        const int* P = (const int*)(ws + RT_PSTART); const int nchunks = __builtin_amdgcn_readfirstlane(P[9]), ntail = nchunks - 256, nmoe = 4 * ntail;
        if ((int)F.wg < nmoe) {
            pg8::Dims g{DFE, DFE, DFE}; SchedMoe2 S{F.wg, F.G, 256, ntail, nchunks, P, (const char*)(ws + WS_U), (const char*)(ws + WS_WE2)};
            EpiMoe2F8 E{(bf16_t*)(ws + WS_VSORT), 256};
            pg8::gemm_phase_f8d<EpiMoe2F8, SchedMoe2>(F.lds, g, S, E);
        } else moe_combine(ws, args.out, (F.G - nmoe) * NWAVES, (F.wg - nmoe) * NWAVES, false);
    }
    SEAM(21 + 2 * MOE_NG);
    if (EN(16) && IN(22 + 2 * MOE_NG)) moe_combine(ws, args.out, F.G * NWAVES, F.wg * NWAVES, true);
#undef IN
#undef SEAM
}

constexpr int N_PHASES = 23 + 2 * MOE_NG;

extern "C" void kernel_launch(void* const* d_in, const int* in_sizes, int n_in, void* d_out, int out_size, void* d_ws, size_t ws_size, hipStream_t stream) {
    static int grid = 0;
    if (grid == 0) {
        if (n_in != 22 || out_size != MTOK * DM || ws_size < WS_END) { fprintf(stderr, "kernel_launch: unexpected shapes (n_in %d out %d ws %zu need %zu)\n", n_in, out_size, ws_size, (size_t)WS_END); grid = -1; return; }
        int dev = 0, cus = 0, per_cu = 0;
        if (hipGetDevice(&dev) != hipSuccess || hipDeviceGetAttribute(&cus, hipDeviceAttributeMultiprocessorCount, dev) != hipSuccess) { grid = -1; return; }
        if (hipFuncSetAttribute((const void*)trunk_fwd, hipFuncAttributeMaxDynamicSharedMemorySize, LDS_BYTES) != hipSuccess) { fprintf(stderr, "kernel_launch: hipFuncSetAttribute failed\n"); grid = -1; return; }
        if (hipOccupancyMaxActiveBlocksPerMultiprocessor(&per_cu, (const void*)trunk_fwd, NTHR, LDS_BYTES) != hipSuccess || per_cu < 1) fprintf(stderr, "kernel_launch: occupancy query reports %d\n", per_cu);
        (void)hipGetLastError();
        grid = cus;
        if (grid > 256) grid = 256;
        if (MTOK % (grid * NWAVES) != 0) { fprintf(stderr, "kernel_launch: grid %d unsupported\n", grid); grid = -1; return; }
    }
    if (grid < 0) return;
    if (hipMemsetAsync((char*)d_ws + WS_CTL, 0, CTL_BYTES, stream) != hipSuccess) return;
    Args a{};
    for (int i = 0; i < 22; ++i) a.in[i] = (const float*)d_in[i];
    a.out = (float*)d_out; a.ws = (unsigned char*)d_ws; a.pad = 0;
#if MK_MULTI
    for (int p = 0; p < N_PHASES; ++p) { a.ph_lo = p; a.ph_hi = p + 1; a.li = 0; hipLaunchKernelGGL(trunk_fwd, dim3(grid), dim3(NTHR), LDS_BYTES, stream, a); }
#else
    a.ph_lo = 0; a.ph_hi = N_PHASES; a.li = 0;
    hipLaunchKernelGGL(trunk_fwd, dim3(grid), dim3(NTHR), LDS_BYTES, stream, a);
#endif
}
```

```cpp
#include <hip/hip_runtime.h>
#include <cstdio>
#include <cstdint>

#ifndef PHMASK
#define PHMASK 0xFFFFFFFFu
#endif
#ifndef PROBE_DUP
#define PROBE_DUP 0u
#endif
#ifndef PROBE_NSA
#define PROBE_NSA 0
#endif
#ifndef PROBE_BAR
#define PROBE_BAR 0
#endif
#ifndef PROBE_SLP
#define PROBE_SLP 0x0ull
#endif
#ifndef PROBE_MEAN
#define PROBE_MEAN 0x0ull
#endif
#ifndef PROBE_TM
#define PROBE_TM 0x0ull
#endif
#ifndef MK_MULTI
#define MK_MULTI 0
#endif

#define LAS __attribute__((address_space(3)))
#define GAS __attribute__((address_space(1)))
typedef unsigned short bf16_t;
typedef short bf16x8 __attribute__((ext_vector_type(8)));
typedef short s16x4 __attribute__((ext_vector_type(4)));
typedef float f32x2 __attribute__((ext_vector_type(2)));
typedef float f32x4 __attribute__((ext_vector_type(4)));
typedef float f32x16 __attribute__((ext_vector_type(16)));
typedef unsigned u32x2 __attribute__((ext_vector_type(2)));
typedef unsigned u32x4 __attribute__((ext_vector_type(4)));
typedef __bf16 bf16x2_t __attribute__((ext_vector_type(2)));

constexpr int NB = 8, SEQ = 4096, DM = 1024, MTOK = NB * SEQ;
constexpr int HD = 64;
constexpr int IN_W = 2840, INP = 3072;
constexpr int DFF = 2816, DFE = 3584, NEXP = 8;
constexpr int CMPH = 256;
constexpr float RMS_EPS = 1e-6f;
constexpr float LOG2E = 1.4426950408889634f, LN2 = 0.6931471805599453f;
constexpr float QSCALE = 0.125f * LOG2E;
constexpr float NEGF = -1e30f;
constexpr int LUTN = 1664;
constexpr int NWAVES = 8, NTHR = 512;
constexpr int MOE_ROWS_MAX = (256 + 8) * 256;
constexpr int MOE_GROUP = 128;
constexpr int MOE_NG = 256 / MOE_GROUP;
constexpr int DIL_EARLY = 8;

constexpr size_t MiB = 1u << 20;
constexpr size_t WS_CTL = 0, CTL_BYTES = 1 * MiB;
constexpr size_t WS_LUT = 1 * MiB;
constexpr size_t WS_B1P = 1 * MiB + 224 * 1024;
constexpr size_t WS_B1E = WS_B1P + 2 * 2 * 16 * 256 * 4;
constexpr size_t WS_BSH = WS_B1E + 2 * 2 * 256 * 4;
constexpr size_t WS_WC2 = 1 * MiB + 512 * 1024;
static_assert(2 * 16 * LUTN * 4 <= 224 * 1024, "lut region");
constexpr size_t WS_ROUTE = 2 * MiB;
constexpr size_t RT_ROWTOK = WS_ROUTE;
constexpr size_t RT_ROWGATE = RT_ROWTOK + MOE_ROWS_MAX * 4;
constexpr size_t RT_TOPE = RT_ROWGATE + MOE_ROWS_MAX * 4;
constexpr size_t RT_TOPG = RT_TOPE + MTOK * 2 * 4;
constexpr size_t RT_CNT = RT_TOPG + MTOK * 2 * 4;
constexpr size_t RT_PSTART = RT_CNT + 256 * 8 * 4;
constexpr size_t RT_TOKPOS = RT_PSTART + 64;
static_assert(RT_TOKPOS + MTOK * 2 * 4 <= 4 * MiB, "route region");
constexpr size_t WS_WIN = 4 * MiB;
constexpr size_t WS_WC1 = 16 * MiB;
constexpr size_t WS_WO = 20 * MiB;
constexpr size_t WS_WF1 = 24 * MiB;
constexpr size_t WS_WF2 = 35 * MiB;
constexpr size_t SB = 44 * MiB;
constexpr size_t WS_QA = SB + 0 * MiB;
constexpr size_t WS_KC = SB + 32 * MiB, WS_VC = SB + 40 * MiB, WS_KS = SB + 48 * MiB, WS_VS = SB + 56 * MiB, WS_KW = SB + 64 * MiB, WS_VW = SB + 72 * MiB;
constexpr size_t WS_GATES = SB + 80 * MiB;
constexpr size_t WS_QB = SB + 84 * MiB, WS_KB = SB + 116 * MiB, WS_VB = SB + 148 * MiB;
constexpr size_t WS_KCC = SB + 180 * MiB, WS_VCC = SB + 181 * MiB;
constexpr size_t WS_HC = SB + 182 * MiB;
constexpr size_t WS_OA = SB + 186 * MiB;
constexpr size_t WS_OB = SB + 218 * MiB;
constexpr size_t WS_LSE = SB + 314 * MiB;
constexpr size_t WS_HB = SB + 352 * MiB;
constexpr size_t WS_U = SB + 420 * MiB;
constexpr size_t WS_ACT0 = SB + 0 * MiB;
constexpr size_t WS_WE1 = SB + 0 * MiB;
constexpr size_t WS_WE2 = SB + 112 * MiB;
constexpr size_t WS_VSORT = SB + 168 * MiB;
constexpr size_t WS_ACT1 = SB + 300 * MiB;
constexpr size_t WS_END = SB + 484 * MiB;
static_assert((size_t)MOE_GROUP * 256 * DFE <= (size_t)MTOK * DM * 4, "moe act in d_out");
static_assert(WS_LSE + 3 * (size_t)MTOK * 8 * 4 <= WS_U, "attn map");

constexpr int CW_BAR = 4096;
constexpr int CTL_WORDS = (int)(CTL_BYTES / 4);

constexpr int RING_BYTES = 131072;
constexpr int LDSCTL_OFF = RING_BYTES;
constexpr int LDS_BYTES = 147456;

#define RLX_AGENT __ATOMIC_RELAXED, __HIP_MEMORY_SCOPE_AGENT
__device__ __forceinline__ unsigned f2bf(float f) { unsigned u = __builtin_bit_cast(unsigned, f); return (u + 0x7fffu + ((u >> 16) & 1u)) >> 16; }
__device__ __forceinline__ unsigned pk2(float lo, float hi) { f32x2 v = {lo, hi}; bf16x2_t b = __builtin_convertvector(v, bf16x2_t); return __builtin_bit_cast(unsigned, b); }
constexpr float FP8_ASCALE = 8.0f, FP8_WSCALE = 64.0f;
constexpr float FP8_UNSCALE = 1.0f / (FP8_ASCALE * FP8_WSCALE);
__device__ __forceinline__ unsigned pk4_fp8(float a, float b, float c, float d) {
    a = __builtin_amdgcn_fmed3f(a, -448.f, 448.f); b = __builtin_amdgcn_fmed3f(b, -448.f, 448.f); c = __builtin_amdgcn_fmed3f(c, -448.f, 448.f); d = __builtin_amdgcn_fmed3f(d, -448.f, 448.f);
    int w = __builtin_amdgcn_cvt_pk_fp8_f32(a, b, 0, false); w = __builtin_amdgcn_cvt_pk_fp8_f32(c, d, w, true); return (unsigned)w; }
__device__ __forceinline__ float bflo(unsigned u) { return __builtin_bit_cast(float, u << 16); }
__device__ __forceinline__ float bfhi(unsigned u) { return __builtin_bit_cast(float, u & 0xffff0000u); }
__device__ __forceinline__ float wave_sum(float v) {
#pragma unroll
    for (int o = 1; o < 64; o <<= 1) v += __shfl_xor(v, o);
    return v;
}
__device__ __forceinline__ float fexp2(float x) { return __builtin_amdgcn_exp2f(x); }
__device__ __forceinline__ float sigmoidf_(float x) { return __builtin_amdgcn_rcpf(1.0f + __builtin_amdgcn_exp2f(-LOG2E * x)); }

#define XB_TMO      128
#define XB_XCNT(j)  (256  + 64 * (j))
#define XB_XSUB(j)  (1280 + 64 * (j))
#define XB_XGEN(j)  (2304 + 64 * (j))
#define XB_TOP      3328
#define XB_TOPGEN   3392
#define XCD_BAR_WORDS 3456
#define XB_SPIN_CAP (1u << 18)
__device__ __forceinline__ unsigned xb_ld(unsigned* p)              { return __hip_atomic_load(p, __ATOMIC_RELAXED, __HIP_MEMORY_SCOPE_AGENT); }
__device__ __forceinline__ unsigned xb_add(unsigned* p, unsigned v) { return __hip_atomic_fetch_add(p, v, __ATOMIC_RELAXED, __HIP_MEMORY_SCOPE_AGENT); }
__device__ __forceinline__ unsigned xb_xcc_id() { return (unsigned)__builtin_amdgcn_s_getreg((3 << 11) | 20) & 0xFu; }
#define XB_SPIN(cond, bar) do { unsigned _sp = 0; while (cond) { __builtin_amdgcn_s_sleep(1); \
    if ((++_sp & 255u) == 0u) { if (xb_ld(&(bar)[XB_TMO])) break; if (_sp > XB_SPIN_CAP) { atomicAdd(&(bar)[XB_TMO], 1u); break; } } } } while (0)
struct XcdBarrier { unsigned* bar; unsigned x; volatile LAS unsigned* st; };
__device__ __forceinline__ XcdBarrier xcd_barrier_post(unsigned* bar, volatile LAS unsigned* st) {
    XcdBarrier b; b.bar = bar; b.x = xb_xcc_id(); b.st = st;
    if (threadIdx.x == 0) (void)xb_add(&bar[XB_XCNT(b.x)], 1u);
    return b;
}
__device__ __forceinline__ void xcd_barrier_complete(unsigned* bar, unsigned x, unsigned& nloc, unsigned& nx) {
    const unsigned G = gridDim.x * gridDim.y * gridDim.z;
    unsigned sum, cnt, mine, sp = 0u;
    for (;;) {
        sum = 0u; cnt = 0u; mine = 0u;
#pragma unroll
        for (unsigned j = 0; j < 16; ++j) { const unsigned c = xb_ld(&bar[XB_XCNT(j)]); sum += c; cnt += (c > 0u) ? 1u : 0u; mine = (j == x) ? c : mine; }
        if (sum == G) break;
        __builtin_amdgcn_s_sleep(1);
        if ((++sp & 255u) == 0u) { if (xb_ld(&bar[XB_TMO])) break; if (sp > XB_SPIN_CAP) { atomicAdd(&bar[XB_TMO], 1u); break; } }
    }
    nloc = mine > 0u ? mine : 1u; nx = cnt > 0u ? cnt : 1u;
}
__device__ __forceinline__ void xcd_barrier(const XcdBarrier& b) {
    asm volatile("s_waitcnt vmcnt(0)" ::: "memory");
    __syncthreads();
    if (threadIdx.x == 0) {
        unsigned* bar = b.bar;
        __builtin_amdgcn_s_waitcnt(0);
        unsigned nloc = b.st[0], nx = b.st[1];
        if (nloc == 0u) { xcd_barrier_complete(bar, b.x, nloc, nx); b.st[0] = nloc; b.st[1] = nx; }
        const unsigned old = xb_add(&bar[XB_XSUB(b.x)], 1u);
        const unsigned gen = old / nloc;
        if (old + 1u == (gen + 1u) * nloc) {
            __builtin_amdgcn_fence(__ATOMIC_RELEASE, "agent");
            asm volatile("s_waitcnt vmcnt(0)" ::: "memory");
            const unsigned og = xb_add(&bar[XB_TOP], 1u);
            const unsigned tg = og / nx;
            if (og + 1u == (tg + 1u) * nx) xb_add(&bar[XB_TOPGEN], 1u);
            else XB_SPIN(xb_ld(&bar[XB_TOPGEN]) == tg, bar);
            __builtin_amdgcn_fence(__ATOMIC_ACQUIRE, "agent");
            xb_add(&bar[XB_XGEN(b.x)], 1u);
            asm volatile("s_waitcnt vmcnt(0)" ::: "memory");
        } else {
            XB_SPIN(xb_ld(&bar[XB_XGEN(b.x)]) == gen, bar);
            __builtin_amdgcn_fence(__ATOMIC_ACQUIRE, "agent");
            asm volatile("s_waitcnt vmcnt(0)" ::: "memory");
        }
    }
    __syncthreads();
}

namespace pg8 {
constexpr int BM = 256, BK = 64, HALF = 128, HTB = HALF * BK * 2, STAGE_BYTES = 8 * HTB, NXCD = 8, WGM = 8;
__host__ __device__ __forceinline__ int lds_byte(int r, int c) { const int st = (r >> 4) * 2 + (c >> 5), rr = r & 15, cc = c & 31, ob = rr * 64 + cc * 2; return st * 1024 + (ob ^ (((ob >> 9) & 1) << 5)); }
__host__ __device__ __forceinline__ void stage_rc(int b, int& R, int& C) { const int st = b / 1024, sb = b % 1024, swz = sb ^ (((sb >> 9) & 1) << 5); R = (st >> 1) * 16 + swz / 64; C = (st & 1) * 32 + (swz % 64) / 2; }
__host__ __device__ __forceinline__ int perm32(int rho) { const int n = rho >> 4, i = rho & 15; return 8 * (i >> 2) + 4 * n + (i & 3); }

struct Unit { int pm, pn; const char* A; const char* B; };
struct Dims { int K, lda, ldb; };

template <class Epi, class Sched, bool ALIGN_EPI = true>
__device__ __forceinline__ void gemm_phase(LAS unsigned char* lds, const Dims g, const Sched& S, const Epi& E) {
    int tid_l = threadIdx.x; asm volatile("" : "+v"(tid_l));
    const int tid = tid_l, wid = __builtin_amdgcn_readfirstlane(tid >> 6), lane = tid & 63, wr = wid >> 2, wc = wid & 3, fr = lane & 15, fq = lane >> 4;
    const int K = g.K, nt = K / BK;
    unsigned voffA[2], voffB[2];
#pragma unroll
    for (int i = 0; i < 2; ++i) { int R, C; stage_rc(tid * 16 + i * 8192, R, C); const int Rb = (R & ~31) + perm32(R & 31);
        voffA[i] = (unsigned)(R * g.lda + C) * 2u; voffB[i] = (unsigned)(Rb * g.ldb + C) * 2u; }
    const size_t kstep = (size_t)(BK * 2);
    const size_t hstepA = (size_t)HALF * g.lda * 2, hstepB = (size_t)HALF * g.ldb * 2;
    const unsigned ldsw = (unsigned)wid * 1024u;
    const int aoff = lds_byte(wr * 64 + fr, fq * 8), boff = lds_byte(wc * 32 + fr, fq * 8);
#define PG8_SA(b, h) (((b) * 2 + (h)) * HTB)
#define PG8_SB(b, h) ((4 + (b) * 2 + (h)) * HTB)
#define PG8_STAGE(bufoff, gbase, voff) do { _Pragma("unroll") for (int _i = 0; _i < 2; ++_i) \
        __builtin_amdgcn_global_load_lds((const unsigned*)((const char*)(gbase) + (voff)[_i]), (LAS unsigned*)(lds + (bufoff) + ldsw + _i * 8192), 16, 0, 0); } while (0)
#define PG8_LDA(dst, b, h) do { _Pragma("unroll") for (int m = 0; m < 4; ++m) _Pragma("unroll") for (int k = 0; k < 2; ++k) dst[m][k] = *(const LAS bf16x8*)(lds + PG8_SA(b, h) + aoff + m * 2048 + k * 1024); } while (0)
#define PG8_LDB(dst, b, h) do { _Pragma("unroll") for (int n = 0; n < 2; ++n) _Pragma("unroll") for (int k = 0; k < 2; ++k) dst[n][k] = *(const LAS bf16x8*)(lds + PG8_SB(b, h) + boff + n * 2048 + k * 1024); } while (0)
#define PG8_MMA(ai, bj, At, Bt) do { __builtin_amdgcn_s_setprio(1); _Pragma("unroll") for (int m = 0; m < 4; ++m) _Pragma("unroll") for (int n = 0; n < 2; ++n) _Pragma("unroll") for (int k = 0; k < 2; ++k) \
        acc[ai][bj][m][n] = __builtin_amdgcn_mfma_f32_16x16x32_bf16(Bt[n][k], At[m][k], acc[ai][bj][m][n], 0, 0, 0); __builtin_amdgcn_s_setprio(0); } while (0)
#define PG8_WAIT_V(n) asm volatile("s_waitcnt vmcnt(" #n ")" ::: "memory")
#define PG8_WAIT_L(n) asm volatile("s_waitcnt lgkmcnt(" #n ")" ::: "memory")
#define PG8_BAR __builtin_amdgcn_s_barrier()
#define PG8_SCHED __builtin_amdgcn_sched_barrier(0)
    Unit cur, nxt; int ui = 0;
    if (!S.next(0, cur)) return;
    f32x4 acc[2][2][4][2];
#pragma unroll
    for (int a = 0; a < 2; ++a)
#pragma unroll
        for (int b = 0; b < 2; ++b)
#pragma unroll
            for (int m = 0; m < 4; ++m)
#pragma unroll
                for (int n = 0; n < 2; ++n) acc[a][b][m][n] = (f32x4){0.f, 0.f, 0.f, 0.f};
    bf16x8 At[4][2], B0[2][2], B1[2][2];
    const char* cA = cur.A; const char* cB = cur.B;
    PG8_STAGE(PG8_SB(0, 0), cB, voffB); PG8_STAGE(PG8_SB(0, 1), cB + hstepB, voffB); PG8_STAGE(PG8_SA(0, 0), cA, voffA); PG8_STAGE(PG8_SA(0, 1), cA + hstepA, voffA);
    if (wr == 1) PG8_BAR;
    PG8_WAIT_V(2); PG8_BAR;
    PG8_STAGE(PG8_SB(1, 0), cB + kstep, voffB); PG8_STAGE(PG8_SA(1, 0), cA + kstep, voffA); PG8_STAGE(PG8_SB(1, 1), cB + hstepB + kstep, voffB);
    PG8_WAIT_V(6); PG8_BAR;
    for (;;) {
        const bool has_next = S.next(ui + 1, nxt);
        const char* nA = has_next ? nxt.A : cA; const char* nB = has_next ? nxt.B : cB;
        for (int t = 0; t < nt; t += 2) {
            const bool last = (t == nt - 2);
            const char* a1 = cA + (size_t)(t + 1) * kstep;
            const char* a2 = last ? nA : cA + (size_t)(t + 2) * kstep; const char* b2 = last ? nB : cB + (size_t)(t + 2) * kstep;
            const char* a3 = a2 + kstep; const char* b3 = b2 + kstep;
            PG8_LDB(B0, 0, 0); PG8_LDB(B1, 0, 1); PG8_SCHED; PG8_LDA(At, 0, 0); PG8_STAGE(PG8_SA(1, 1), a1 + hstepA, voffA);
            PG8_WAIT_V(8); PG8_WAIT_L(0); PG8_BAR; PG8_MMA(0, 0, At, B0); PG8_MMA(0, 1, At, B1); PG8_BAR; PG8_SCHED;
            PG8_LDA(At, 0, 1); PG8_STAGE(PG8_SB(0, 0), b2, voffB); PG8_STAGE(PG8_SB(0, 1), b2 + hstepB, voffB); PG8_STAGE(PG8_SA(0, 0), a2, voffA);
            PG8_WAIT_V(8); PG8_WAIT_L(0); PG8_BAR; PG8_MMA(1, 0, At, B0); PG8_MMA(1, 1, At, B1); PG8_BAR; PG8_SCHED;
            PG8_LDB(B0, 1, 0); PG8_LDB(B1, 1, 1); PG8_SCHED; PG8_LDA(At, 1, 0); PG8_STAGE(PG8_SA(0, 1), a2 + hstepA, voffA);
            PG8_WAIT_V(8); PG8_WAIT_L(0); PG8_BAR; PG8_MMA(0, 0, At, B0); PG8_MMA(0, 1, At, B1); PG8_BAR; PG8_SCHED;
            PG8_LDA(At, 1, 1); PG8_STAGE(PG8_SB(1, 0), b3, voffB); PG8_STAGE(PG8_SB(1, 1), b3 + hstepB, voffB); PG8_STAGE(PG8_SA(1, 0), a3, voffA);
            PG8_WAIT_V(8); PG8_WAIT_L(0); PG8_BAR; PG8_MMA(1, 0, At, B0); PG8_MMA(1, 1, At, B1); PG8_BAR; PG8_SCHED;
        }
        if (ALIGN_EPI) { if (wr == 0) PG8_BAR; }
        E(acc, cur, wr, wc, fr, fq);
        if (!has_next) break;
#pragma unroll
        for (int a = 0; a < 2; ++a)
#pragma unroll
            for (int b = 0; b < 2; ++b)
#pragma unroll
                for (int m = 0; m < 4; ++m)
#pragma unroll
                    for (int n = 0; n < 2; ++n) acc[a][b][m][n] = (f32x4){0.f, 0.f, 0.f, 0.f};
        cur = nxt; cA = nA; cB = nB; ++ui;
        if (ALIGN_EPI) { if (wr == 1) PG8_BAR; }
    }
    PG8_WAIT_V(0);
    if (!ALIGN_EPI) { if (wr == 0) PG8_BAR; }
    PG8_BAR;
#undef PG8_SA
#undef PG8_SB
#undef PG8_STAGE
#undef PG8_LDA
#undef PG8_LDB
#undef PG8_MMA
#undef PG8_WAIT_V
#undef PG8_WAIT_L
#undef PG8_BAR
#undef PG8_SCHED
}

typedef int v8i_t __attribute__((ext_vector_type(8)));
typedef int v4i_t __attribute__((ext_vector_type(4)));
template <class Epi, class Sched>
__device__ __forceinline__ void gemm_phase_f8(LAS unsigned char* lds, const Dims g, const Sched& S, const Epi& E) {
    int tid_l = threadIdx.x; asm volatile("" : "+v"(tid_l));
    const int tid = tid_l, wid = __builtin_amdgcn_readfirstlane(tid >> 6), lane = tid & 63, wr = wid >> 2, wc = wid & 3, fr = lane & 15, fq = lane >> 4;
    const int K = g.K, nt = K / 128;
    unsigned voffA[2], voffB[2];
#pragma unroll
    for (int i = 0; i < 2; ++i) { int R, C; stage_rc(tid * 16 + i * 8192, R, C); const int Rb = (R & ~31) + perm32(R & 31);
        voffA[i] = (unsigned)(R * g.lda) + (unsigned)C * 2u; voffB[i] = (unsigned)(Rb * g.ldb) + (unsigned)C * 2u; }
    const size_t kstep = 128, hstepA = (size_t)HALF * g.lda;
    const unsigned ldsw = (unsigned)wid * 1024u;
    const int aoff = lds_byte(wr * 64 + fr, fq * 8), boff = lds_byte(wc * 32 + fr, fq * 8);
#define F8_SA(b, h) (((b) * 2 + (h)) * HTB)
#define F8_SB(b) ((4 + (b) * 2) * HTB)
#define F8_STAGE(bufoff, gbase, voff) do { _Pragma("unroll") for (int _i = 0; _i < 2; ++_i) \
        __builtin_amdgcn_global_load_lds((const unsigned*)((const char*)(gbase) + (voff)[_i]), (LAS unsigned*)(lds + (bufoff) + ldsw + _i * 8192), 16, 0, 0); } while (0)
#define F8_CAT(x, y) __builtin_shufflevector(x, y, 0, 1, 2, 3, 4, 5, 6, 7)
#define F8_LDA(b, h) do { _Pragma("unroll") for (int m = 0; m < 4; ++m) A8[m] = F8_CAT(*(const LAS v4i_t*)(lds + F8_SA(b, h) + aoff + m * 2048), *(const LAS v4i_t*)(lds + F8_SA(b, h) + aoff + m * 2048 + 1024)); } while (0)
#define F8_LDB(b) do { _Pragma("unroll") for (int n = 0; n < 2; ++n) B8[n] = F8_CAT(*(const LAS v4i_t*)(lds + F8_SB(b) + boff + n * 2048), *(const LAS v4i_t*)(lds + F8_SB(b) + boff + n * 2048 + 1024)); } while (0)
#define F8_MMA(ai) do { __builtin_amdgcn_s_setprio(1); _Pragma("unroll") for (int m = 0; m < 4; ++m) _Pragma("unroll") for (int n = 0; n < 2; ++n) \
        acc[ai][m][n] = __builtin_amdgcn_mfma_scale_f32_16x16x128_f8f6f4(B8[n], A8[m], acc[ai][m][n], 0, 0, 0, 0, 0, 0); __builtin_amdgcn_s_setprio(0); } while (0)
#define F8_WAIT_V(n) asm volatile("s_waitcnt vmcnt(" #n ")" ::: "memory")
#define F8_WAIT_L(n) asm volatile("s_waitcnt lgkmcnt(" #n ")" ::: "memory")
#define F8_BAR __builtin_amdgcn_s_barrier()
#define F8_SCHED __builtin_amdgcn_sched_barrier(0)
    Unit cur, nxt; int ui = 0;
    if (!S.next(0, cur)) return;
    f32x4 acc[2][4][2];
#pragma unroll
    for (int a = 0; a < 2; ++a)
#pragma unroll
        for (int m = 0; m < 4; ++m)
#pragma unroll
            for (int n = 0; n < 2; ++n) acc[a][m][n] = (f32x4){0.f, 0.f, 0.f, 0.f};
    v8i_t A8[4], B8[2];
    const char* cA = cur.A; const char* cB = cur.B;
    F8_STAGE(F8_SB(0), cB, voffB); F8_STAGE(F8_SA(0, 0), cA, voffA); F8_STAGE(F8_SA(0, 1), cA + hstepA, voffA);
    if (wr == 1) F8_BAR;
    F8_WAIT_V(2); F8_BAR;
    F8_STAGE(F8_SB(1), cB + kstep, voffB); F8_STAGE(F8_SA(1, 0), cA + kstep, voffA);
    F8_WAIT_V(6); F8_BAR;
    for (;;) {
        const bool has_next = S.next(ui + 1, nxt);
        const char* nA = has_next ? nxt.A : cA; const char* nB = has_next ? nxt.B : cB;
        for (int t = 0; t < nt; t += 2) {
            const bool last = (t == nt - 2);
            const char* a1 = cA + (size_t)(t + 1) * kstep;
            const char* a2 = last ? nA : cA + (size_t)(t + 2) * kstep; const char* b2 = last ? nB : cB + (size_t)(t + 2) * kstep;
            const char* a3 = a2 + kstep; const char* b3 = b2 + kstep;
            F8_LDB(0); F8_SCHED; F8_LDA(0, 0); F8_STAGE(F8_SA(1, 1), a1 + hstepA, voffA);
            F8_WAIT_V(6); F8_WAIT_L(0); F8_BAR; F8_MMA(0); F8_BAR; F8_SCHED;
            F8_LDA(0, 1); F8_STAGE(F8_SB(0), b2, voffB); F8_STAGE(F8_SA(0, 0), a2, voffA);
            F8_WAIT_V(6); F8_WAIT_L(0); F8_BAR; F8_MMA(1); F8_BAR; F8_SCHED;
            F8_LDB(1); F8_SCHED; F8_LDA(1, 0); F8_STAGE(F8_SA(0, 1), a2 + hstepA, voffA);
            F8_WAIT_V(6); F8_WAIT_L(0); F8_BAR; F8_MMA(0); F8_BAR; F8_SCHED;
            F8_LDA(1, 1); F8_STAGE(F8_SB(1), b3, voffB); F8_STAGE(F8_SA(1, 0), a3, voffA);
            F8_WAIT_V(6); F8_WAIT_L(0); F8_BAR; F8_MMA(1); F8_BAR; F8_SCHED;
        }
        if (wr == 0) F8_BAR;
        E(acc, cur, wr, wc, fr, fq);
        if (!has_next) break;
#pragma unroll
        for (int a = 0; a < 2; ++a)
#pragma unroll
            for (int m = 0; m < 4; ++m)
#pragma unroll
                for (int n = 0; n < 2; ++n) acc[a][m][n] = (f32x4){0.f, 0.f, 0.f, 0.f};
        cur = nxt; cA = nA; cB = nB; ++ui;
        if (wr == 1) F8_BAR;
    }
    F8_WAIT_V(0);
    F8_BAR;
#undef F8_SA
#undef F8_SB
#undef F8_STAGE
#undef F8_CAT
#undef F8_LDA
#undef F8_LDB
#undef F8_MMA
#undef F8_WAIT_V
#undef F8_WAIT_L
#undef F8_BAR
#undef F8_SCHED
}

template <class Epi, class Sched>
__device__ __forceinline__ void gemm_phase_f8d(LAS unsigned char* lds, const Dims g, const Sched& S, const Epi& E) {
    int tid_l = threadIdx.x; asm volatile("" : "+v"(tid_l));
    const int tid = tid_l, wid = __builtin_amdgcn_readfirstlane(tid >> 6), lane = tid & 63, wr = wid >> 2, wq = wid >> 1, wh = wid & 1, fr = lane & 15, fq = lane >> 4;
    const int K = g.K, nt = K / 128;
    unsigned voffA[2], voffB[2];
#pragma unroll
    for (int i = 0; i < 2; ++i) { int R, C; stage_rc(tid * 16 + i * 8192, R, C); const int Rb = (R & ~31) + perm32(R & 31);
        voffA[i] = (unsigned)(R * g.lda) + (unsigned)C * 2u; voffB[i] = (unsigned)(Rb * g.ldb) + (unsigned)C * 2u; }
    const size_t hstepA = (size_t)HALF * g.lda, hstepB = (size_t)HALF * g.ldb;
    const unsigned ldsw = (unsigned)wid * 1024u;
    const int aoff = (wq >> 1) * HTB + lds_byte((wq & 1) * 64 + fr, fq * 8), boff = 2 * HTB + lds_byte(wh * 64 + fr, fq * 8);
    constexpr int STG = 4 * HTB;
#define FD_STAGE1(bufoff, gptr, voff) do { const char* gp_ = (const char*)(gptr); asm volatile("" : "+s"(gp_));     \
        _Pragma("unroll") for (int _i = 0; _i < 2; ++_i) \
        __builtin_amdgcn_global_load_lds((const unsigned*)(gp_ + (voff)[_i]), (LAS unsigned*)(lds + (bufoff) + ldsw + _i * 8192), 16, 0, 0); } while (0)
#define FD_STAGE_AB0(sb, pa, pb) do { FD_STAGE1((sb), pa, voffA); FD_STAGE1((sb) + HTB, (pa) + hstepA, voffA); FD_STAGE1((sb) + 2 * HTB, pb, voffB); } while (0)
#define FD_STAGE_B1(sb, pb) FD_STAGE1((sb) + 3 * HTB, (pb) + hstepB, voffB)
#define FD_CAT(x, y) __builtin_shufflevector(x, y, 0, 1, 2, 3, 4, 5, 6, 7)
#define FD_WAIT_V(n) asm volatile("s_waitcnt vmcnt(" #n ")" ::: "memory")
#define FD_WAIT_L(n) asm volatile("s_waitcnt lgkmcnt(" #n ")" ::: "memory")
#define FD_BAR __builtin_amdgcn_s_barrier()
#define FD_SCHED __builtin_amdgcn_sched_barrier(0)
#define FD_TILEP(base, nbase, tt) (((tt) < nt) ? (base) + (size_t)(tt) * 128 : (nbase) + (size_t)((tt) - nt) * 128)
    Unit cur, nxt; int ui = 0;
    if (!S.next(0, cur)) return;
    f32x4 acc[2][4][4];
#pragma unroll
    for (int p = 0; p < 2; ++p)
#pragma unroll
        for (int m = 0; m < 4; ++m)
#pragma unroll
            for (int n = 0; n < 4; ++n) acc[p][m][n] = (f32x4){0.f, 0.f, 0.f, 0.f};
    v8i_t A8[4], B8[4];
    const char* cA = cur.A; const char* cB = cur.B;
    int sb = 0;
    FD_STAGE_AB0(0, cA, cB); FD_STAGE_B1(0, cB); FD_STAGE_AB0(STG, cA + 128, cB + 128);
    if (wr == 1) FD_BAR;
    FD_WAIT_V(8); FD_BAR; FD_BAR;
    for (;;) {
        const bool has_next = S.next(ui + 1, nxt);
        const char* nA = has_next ? nxt.A : cA; const char* nB = has_next ? nxt.B : cB;
        _Pragma("unroll 1") for (int t = 0; t < nt; ++t) {
            const int so = STG - sb;
#pragma unroll
            for (int n = 0; n < 4; ++n) B8[n] = FD_CAT(*(const LAS v4i_t*)(lds + sb + boff + n * 2048), *(const LAS v4i_t*)(lds + sb + boff + n * 2048 + 1024));
#pragma unroll
            for (int m = 0; m < 4; ++m) A8[m] = FD_CAT(*(const LAS v4i_t*)(lds + sb + aoff + m * 2048), *(const LAS v4i_t*)(lds + sb + aoff + m * 2048 + 1024));
            { const char* pb = FD_TILEP(cB, nB, t + 1); FD_STAGE_B1(so, pb); }
            FD_WAIT_V(8); FD_WAIT_L(0); FD_BAR;
            __builtin_amdgcn_s_setprio(1);
#pragma unroll
            for (int m = 0; m < 4; ++m)
#pragma unroll
                for (int n = 0; n < 4; ++n) acc[0][m][n] = __builtin_amdgcn_mfma_scale_f32_16x16x128_f8f6f4(B8[n], A8[m], acc[0][m][n], 0, 0, 0, 0, 0, 0);
            __builtin_amdgcn_s_setprio(0);
            FD_BAR; FD_SCHED;
#pragma unroll
            for (int n = 0; n < 4; ++n) B8[n] = FD_CAT(*(const LAS v4i_t*)(lds + sb + HTB + boff + n * 2048), *(const LAS v4i_t*)(lds + sb + HTB + boff + n * 2048 + 1024));
            { const char* pa = FD_TILEP(cA, nA, t + 2); const char* pb = FD_TILEP(cB, nB, t + 2); FD_STAGE_AB0(sb, pa, pb); }
            FD_WAIT_V(8); FD_WAIT_L(0); FD_BAR;
            __builtin_amdgcn_s_setprio(1);
#pragma unroll
            for (int m = 0; m < 4; ++m)
#pragma unroll
                for (int n = 0; n < 4; ++n) acc[1][m][n] = __builtin_amdgcn_mfma_scale_f32_16x16x128_f8f6f4(B8[n], A8[m], acc[1][m][n], 0, 0, 0, 0, 0, 0);
            __builtin_amdgcn_s_setprio(0);
            FD_BAR; FD_SCHED;
            sb = so;
        }
        if (wr == 0) FD_BAR;
        E(acc, cur, wq, wh, fr, fq);
        if (!has_next) break;
#pragma unroll
        for (int p = 0; p < 2; ++p)
#pragma unroll
            for (int m = 0; m < 4; ++m)
#pragma unroll
                for (int n = 0; n < 4; ++n) acc[p][m][n] = (f32x4){0.f, 0.f, 0.f, 0.f};
        cur = nxt; cA = nA; cB = nB; ++ui;
        if (wr == 1) FD_BAR;
    }
    FD_WAIT_V(0);
    FD_BAR;
#undef FD_STAGE1
#undef FD_STAGE_AB0
#undef FD_STAGE_B1
#undef FD_CAT
#undef FD_WAIT_V
#undef FD_WAIT_L
#undef FD_BAR
#undef FD_SCHED
#undef FD_TILEP
}

struct StaticOrder {
    int nM, nN, nwg, G, c; const char* A; const char* B; size_t tsA, tsB;
    __device__ void init(int M, int N, int G_, int c_, const void* A_, const void* B_, int lda, int ldb, int es = 2, int bn = BM) { nM = M / BM; nN = N / bn; nwg = nM * nN; G = G_; c = c_; A = (const char*)A_; B = (const char*)B_; tsA = (size_t)BM * lda * es; tsB = (size_t)bn * ldb * es; }
    __device__ bool next(int i, Unit& u) const {
        const long L = (long)i * G + c; if (L >= nwg) return false;
        int wgid = (int)L; { const int q = nwg / NXCD, r = nwg % NXCD, xcd = wgid % NXCD, off = wgid / NXCD; wgid = (xcd < r ? xcd * (q + 1) : r * (q + 1) + (xcd - r) * q) + off; }
        const int nig = WGM * nN, gid = wgid / nig, fm = gid * WGM, gsz = (nM - fm) < WGM ? (nM - fm) : WGM;
        u.pm = fm + ((wgid % nig) % gsz); u.pn = (wgid % nig) / gsz; u.A = A + (size_t)u.pm * tsA; u.B = B + (size_t)u.pn * tsB; return true;
    }
};
}

struct Args {
    const float* in[22]; float* out; unsigned char* ws; int ph_lo, ph_hi, li, pad;
};
enum { I_X = 0, I_RELB, I_ANORM, I_WIN, I_QN, I_KN, I_CPOS, I_CW1, I_CB1, I_CW2, I_DQN, I_DKN, I_ONORM, I_WOUT, I_FNORM, I_FG, I_FU, I_FD, I_RW, I_EG, I_EU, I_ED };

struct Frame {
    LAS unsigned char* lds;
    int tid, lane, wave, G, wg;
    unsigned char* ws; const float* const* in; float* out;
};

struct EpiInProj {
    unsigned char* ws; const float* qn; const float* kn; const float* dqn; const float* dkn;
    __device__ __forceinline__ void operator()(const f32x4 (&acc)[2][2][4][2], const pg8::Unit& u, int wr, int wc, int fr, int fq) const {
        const int rowb = u.pm * 256 + wr * 64 + fr;
        if (u.pn == 11) {
            if (wc != 0 || fq >= 3) return;
            float* G = (float*)(ws + WS_GATES);
#pragma unroll
            for (int ai = 0; ai < 2; ++ai)
#pragma unroll
                for (int m = 0; m < 4; ++m) { const int row = rowb + ai * 128 + m * 16;
#pragma unroll
                    for (int n = 0; n < 2; ++n) { f32x4 v = acc[ai][0][m][n]; f32x4 o; o[0] = sigmoidf_(v[0]); o[1] = sigmoidf_(v[1]); o[2] = sigmoidf_(v[2]); o[3] = sigmoidf_(v[3]);
                        *(f32x4*)(G + (size_t)row * 24 + 8 * fq + 4 * n) = o; } }
            return;
        }
        const int vh = 4 * u.pn + wc;
        size_t base; int nh, hidx; const float* gain = nullptr; float scale = 1.f;
        if (vh < 8)       { base = WS_QA; nh = 8; hidx = vh; gain = qn; scale = QSCALE; }
        else if (vh < 20) { const int k = (vh - 8) >> 1; nh = 2; hidx = (vh - 8) & 1;
                            base = (k == 0) ? WS_KC : (k == 1) ? WS_VC : (k == 2) ? WS_KS : (k == 3) ? WS_VS : (k == 4) ? WS_KW : WS_VW;
                            if (k == 2) gain = kn + 64; else if (k == 4) gain = kn + 128; }
        else if (vh < 28) { base = WS_QB; nh = 8; hidx = vh - 20; gain = dqn; scale = QSCALE; }
        else if (vh < 36) { base = WS_KB; nh = 8; hidx = vh - 28; gain = dkn; }
        else              { base = WS_VB; nh = 8; hidx = vh - 36; }
        bf16_t* O = (bf16_t*)(ws + base);
        f32x4 gv[2][2];
#pragma unroll
        for (int bj = 0; bj < 2; ++bj)
#pragma unroll
            for (int n = 0; n < 2; ++n) gv[bj][n] = gain ? *(const f32x4*)(gain + 32 * bj + 8 * fq + 4 * n) : (f32x4){1.f, 1.f, 1.f, 1.f};
#pragma unroll
        for (int ai = 0; ai < 2; ++ai)
#pragma unroll
            for (int m = 0; m < 4; ++m) {
                const int row = rowb + ai * 128 + m * 16, b = row >> 12, t = row & 4095;
                float rs = scale;
                if (gain) {
                    float ss = 0.f;
#pragma unroll
                    for (int bj = 0; bj < 2; ++bj)
#pragma unroll
                        for (int n = 0; n < 2; ++n) { const f32x4 v = acc[ai][bj][m][n]; ss += (v[0] * v[0] + v[1] * v[1]) + (v[2] * v[2] + v[3] * v[3]); }
                    ss += __shfl_xor(ss, 16); ss += __shfl_xor(ss, 32);
                    rs = scale * __builtin_amdgcn_rsqf(ss * (1.0f / 64.0f) + RMS_EPS);
                }
                bf16_t* dst = O + ((size_t)(b * nh + hidx) * SEQ + t) * 64 + 8 * fq;
#pragma unroll
                for (int bj = 0; bj < 2; ++bj) { const f32x4 v0 = acc[ai][bj][m][0] * gv[bj][0] * rs, v1 = acc[ai][bj][m][1] * gv[bj][1] * rs;
                    u32x4 w; w.x = pk2(v0[0], v0[1]); w.y = pk2(v0[2], v0[3]); w.z = pk2(v1[0], v1[1]); w.w = pk2(v1[2], v1[3]);
                    *(u32x4*)(dst + 32 * bj) = w; }
            }
    }
};
__device__ __forceinline__ float gelu_tanh(float x) { const float y = 0.7978845608028654f * (x + 0.044715f * x * x * x); const float e = __builtin_amdgcn_exp2f((2.f * LOG2E) * y); return x - x * __builtin_amdgcn_rcpf(e + 1.f); }
struct EpiCmp1 {
    bf16_t* HC; const float* b1e;
    __device__ __forceinline__ void operator()(const f32x4 (&acc)[2][2][4][2], const pg8::Unit& u, int wr, int wc, int fr, int fq) const {
        const int kv = u.pm >> 4, bg = u.pm & 15;
        bf16_t* O = HC + ((size_t)kv * 4096 + bg * 256) * 256; const float* bias = b1e + kv * 256;
        const int col0 = wc * 32 + 8 * fq;
#pragma unroll
        for (int ai = 0; ai < 2; ++ai)
#pragma unroll
            for (int m = 0; m < 4; ++m) { const int r = ai * 128 + wr * 64 + m * 16 + fr;
#pragma unroll
                for (int bj = 0; bj < 2; ++bj) { const f32x4 b0 = *(const f32x4*)(bias + col0 + bj * 128), b1 = *(const f32x4*)(bias + col0 + bj * 128 + 4);
                    const f32x4 v0 = acc[ai][bj][m][0] + b0, v1 = acc[ai][bj][m][1] + b1;
                    u32x4 w; w.x = pk2(gelu_tanh(v0[0]), gelu_tanh(v0[1])); w.y = pk2(gelu_tanh(v0[2]), gelu_tanh(v0[3])); w.z = pk2(gelu_tanh(v1[0]), gelu_tanh(v1[1])); w.w = pk2(gelu_tanh(v1[2]), gelu_tanh(v1[3]));
                    *(u32x4*)(O + (size_t)r * 256 + col0 + bj * 128) = w; } }
    }
};
template <bool RESF32> struct EpiRes {
    const void* res; bf16_t* out;
    __device__ __forceinline__ void operator()(const f32x4 (&acc)[2][2][4][2], const pg8::Unit& u, int wr, int wc, int fr, int fq) const {
        const int row0 = u.pm * 256 + wr * 64 + fr, col0 = u.pn * 256 + wc * 32 + 8 * fq;
#pragma unroll
        for (int ai = 0; ai < 2; ++ai)
#pragma unroll
            for (int m = 0; m < 4; ++m) { const size_t ro = (size_t)(row0 + ai * 128 + m * 16) * DM + col0;
#pragma unroll
                for (int bj = 0; bj < 2; ++bj) {
                    f32x4 r0, r1;
                    if (RESF32) { r0 = *(const f32x4*)((const float*)res + ro + bj * 128); r1 = *(const f32x4*)((const float*)res + ro + bj * 128 + 4); }
                    else { const u32x4 rb = *(const u32x4*)((const bf16_t*)res + ro + bj * 128); r0 = (f32x4){bflo(rb.x), bfhi(rb.x), bflo(rb.y), bfhi(rb.y)}; r1 = (f32x4){bflo(rb.z), bfhi(rb.z), bflo(rb.w), bfhi(rb.w)}; }
                    const f32x4 v0 = r0 + acc[ai][bj][m][0], v1 = r1 + acc[ai][bj][m][1];
                    u32x4 w; w.x = pk2(v0[0], v0[1]); w.y = pk2(v0[2], v0[3]); w.z = pk2(v1[0], v1[1]); w.w = pk2(v1[2], v1[3]);
                    *(u32x4*)(out + ro + bj * 128) = w; } }
    }
};
__device__ __forceinline__ float silu_mul(float g, float u) { return g * u * __builtin_amdgcn_rcpf(1.0f + __builtin_amdgcn_exp2f(-LOG2E * g)); }
template <bool FP8OUT> struct EpiSwiglu {
    void* Ov; int ldc; int pm0;
    __device__ __forceinline__ void operator()(const f32x4 (&acc)[2][2][4][2], const pg8::Unit& u, int wr, int wc, int fr, int fq) const {
        const int row0 = (u.pm - pm0) * 256 + wr * 64 + fr, col0 = u.pn * 128 + wc * 32 + 8 * fq;
#pragma unroll
        for (int ai = 0; ai < 2; ++ai)
#pragma unroll
            for (int m = 0; m < 4; ++m) { const f32x4 g0 = acc[ai][0][m][0], g1 = acc[ai][0][m][1], u0 = acc[ai][1][m][0], u1 = acc[ai][1][m][1];
                if constexpr (FP8OUT) { const f32x4 s0 = u0 * FP8_ASCALE, s1 = u1 * FP8_ASCALE;
                    u32x2 w; w.x = pk4_fp8(silu_mul(g0[0], s0[0]), silu_mul(g0[1], s0[1]), silu_mul(g0[2], s0[2]), silu_mul(g0[3], s0[3]));
                    w.y = pk4_fp8(silu_mul(g1[0], s1[0]), silu_mul(g1[1], s1[1]), silu_mul(g1[2], s1[2]), silu_mul(g1[3], s1[3]));
                    *(u32x2*)((unsigned char*)Ov + (size_t)(row0 + ai * 128 + m * 16) * ldc + col0) = w; }
                else { u32x4 w; w.x = pk2(silu_mul(g0[0], u0[0]), silu_mul(g0[1], u0[1])); w.y = pk2(silu_mul(g0[2], u0[2]), silu_mul(g0[3], u0[3]));
                    w.z = pk2(silu_mul(g1[0], u1[0]), silu_mul(g1[1], u1[1])); w.w = pk2(silu_mul(g1[2], u1[2]), silu_mul(g1[3], u1[3]));
                    *(u32x4*)((bf16_t*)Ov + (size_t)(row0 + ai * 128 + m * 16) * ldc + col0) = w; } }
    }
};
struct EpiResF8 {
    bf16_t* h;
    __device__ __forceinline__ void operator()(const f32x4 (&acc)[2][4][4], const pg8::Unit& u, int wq, int wh, int fr, int fq) const {
        const int row0 = u.pm * 256 + wq * 64 + fr, col0 = u.pn * 256 + wh * 64 + 8 * fq;
#pragma unroll
        for (int p = 0; p < 2; ++p)
#pragma unroll
        for (int m = 0; m < 4; ++m)
#pragma unroll
            for (int G = 0; G < 2; ++G) { bf16_t* q = h + (size_t)(row0 + m * 16) * DM + col0 + 128 * p + 32 * G; const u32x4 rb = *(const u32x4*)q;
                const f32x4 v0 = (f32x4){bflo(rb.x), bfhi(rb.x), bflo(rb.y), bfhi(rb.y)} + acc[p][m][2 * G] * FP8_UNSCALE, v1 = (f32x4){bflo(rb.z), bfhi(rb.z), bflo(rb.w), bfhi(rb.w)} + acc[p][m][2 * G + 1] * FP8_UNSCALE;
                u32x4 w; w.x = pk2(v0[0], v0[1]); w.y = pk2(v0[2], v0[3]); w.z = pk2(v1[0], v1[1]); w.w = pk2(v1[2], v1[3]);
                *(u32x4*)q = w; }
    }
    __device__ __forceinline__ void operator()(const f32x4 (&acc)[2][4][2], const pg8::Unit& u, int wr, int wc, int fr, int fq) const {
        const int row0 = u.pm * 256 + wr * 64 + fr, col0 = u.pn * 128 + wc * 32 + 8 * fq;
#pragma unroll
        for (int ai = 0; ai < 2; ++ai)
#pragma unroll
            for (int m = 0; m < 4; ++m) { bf16_t* p = h + (size_t)(row0 + ai * 128 + m * 16) * DM + col0; const u32x4 rb = *(const u32x4*)p;
                const f32x4 v0 = (f32x4){bflo(rb.x), bfhi(rb.x), bflo(rb.y), bfhi(rb.y)} + acc[ai][m][0] * FP8_UNSCALE, v1 = (f32x4){bflo(rb.z), bfhi(rb.z), bflo(rb.w), bfhi(rb.w)} + acc[ai][m][1] * FP8_UNSCALE;
                u32x4 w; w.x = pk2(v0[0], v0[1]); w.y = pk2(v0[2], v0[3]); w.z = pk2(v1[0], v1[1]); w.w = pk2(v1[2], v1[3]);
                *(u32x4*)p = w; }
    }
};
struct EpiSwigluF8 {
    unsigned char* O; int ldc; int pm0;
    __device__ __forceinline__ void operator()(const f32x4 (&acc)[2][4][4], const pg8::Unit& u, int wq, int wh, int fr, int fq) const {
        const int row0 = (u.pm - pm0) * 256 + wq * 64 + fr, col0 = u.pn * 128 + wh * 64 + 16 * fq;
        constexpr float KE = -LOG2E * FP8_UNSCALE, KP = FP8_UNSCALE * FP8_UNSCALE * FP8_ASCALE;
#pragma unroll
        for (int m = 0; m < 4; ++m) { u32x4 w;
#pragma unroll
            for (int p = 0; p < 2; ++p)
#pragma unroll
            for (int G = 0; G < 2; ++G) { const f32x4 ga = acc[p][m][2 * G], ua = acc[p][m][2 * G + 1]; float r[4];
#pragma unroll
                for (int c = 0; c < 4; ++c) r[c] = (ga[c] * ua[c]) * KP * __builtin_amdgcn_rcpf(1.0f + __builtin_amdgcn_exp2f(KE * ga[c]));
                w[2 * p + G] = pk4_fp8(r[0], r[1], r[2], r[3]); }
            *(u32x4*)(O + (size_t)(row0 + m * 16) * ldc + col0) = w; }
    }
    __device__ __forceinline__ void operator()(const f32x4 (&acc)[2][4][2], const pg8::Unit& u, int wr, int wc, int fr, int fq) const {
        const int row0 = (u.pm - pm0) * 256 + wr * 64 + fr, col0 = u.pn * 64 + wc * 16 + 4 * fq;
#pragma unroll
        for (int ai = 0; ai < 2; ++ai)
#pragma unroll
            for (int m = 0; m < 4; ++m) { const f32x4 ga = acc[ai][m][0], ua = acc[ai][m][1];
                constexpr float KE = -LOG2E * FP8_UNSCALE, KP = FP8_UNSCALE * FP8_UNSCALE * FP8_ASCALE;
                float r[4];
#pragma unroll
                for (int c = 0; c < 4; ++c) r[c] = (ga[c] * ua[c]) * KP * __builtin_amdgcn_rcpf(1.0f + __builtin_amdgcn_exp2f(KE * ga[c]));
                *(unsigned*)(O + (size_t)(row0 + ai * 128 + m * 16) * ldc + col0) = pk4_fp8(r[0], r[1], r[2], r[3]); }
    }
};
struct EpiMoe2F8 {
    bf16_t* Y; int pm0;
    __device__ __forceinline__ void operator()(const f32x4 (&acc)[2][4][4], const pg8::Unit& u, int wq, int wh, int fr, int fq) const {
        const int row0 = (pm0 + u.pm) * 256 + wq * 64 + fr, col0 = u.pn * 256 + wh * 64 + 8 * fq;
#pragma unroll
        for (int p = 0; p < 2; ++p)
#pragma unroll
        for (int m = 0; m < 4; ++m)
#pragma unroll
            for (int G = 0; G < 2; ++G) { const f32x4 v0 = acc[p][m][2 * G] * FP8_UNSCALE, v1 = acc[p][m][2 * G + 1] * FP8_UNSCALE;
                u32x4 w; w.x = pk2(v0[0], v0[1]); w.y = pk2(v0[2], v0[3]); w.z = pk2(v1[0], v1[1]); w.w = pk2(v1[2], v1[3]);
                *(u32x4*)(Y + (size_t)(row0 + m * 16) * DM + col0 + 128 * p + 32 * G) = w; }
    }
    __device__ __forceinline__ void operator()(const f32x4 (&acc)[2][4][2], const pg8::Unit& u, int wr, int wc, int fr, int fq) const {
        const int row0 = (pm0 + u.pm) * 256 + wr * 64 + fr, col0 = u.pn * 128 + wc * 32 + 8 * fq;
#pragma unroll
        for (int ai = 0; ai < 2; ++ai)
#pragma unroll
            for (int m = 0; m < 4; ++m) { const f32x4 v0 = acc[ai][m][0] * FP8_UNSCALE, v1 = acc[ai][m][1] * FP8_UNSCALE;
                u32x4 w; w.x = pk2(v0[0], v0[1]); w.y = pk2(v0[2], v0[3]); w.z = pk2(v1[0], v1[1]); w.w = pk2(v1[2], v1[3]);
                *(u32x4*)(Y + (size_t)(row0 + ai * 128 + m * 16) * DM + col0) = w; }
    }
};
struct EpiMoe2 {
    bf16_t* Y; int pm0;
    __device__ __forceinline__ void operator()(const f32x4 (&acc)[2][2][4][2], const pg8::Unit& u, int wr, int wc, int fr, int fq) const {
        const int row0 = (pm0 + u.pm) * 256 + wr * 64 + fr, col0 = u.pn * 256 + wc * 32 + 8 * fq;
#pragma unroll
        for (int ai = 0; ai < 2; ++ai)
#pragma unroll
            for (int m = 0; m < 4; ++m) { bf16_t* o = Y + (size_t)(row0 + ai * 128 + m * 16) * DM + col0;
#pragma unroll
                for (int bj = 0; bj < 2; ++bj) { const f32x4 v0 = acc[ai][bj][m][0], v1 = acc[ai][bj][m][1];
                    u32x4 w; w.x = pk2(v0[0], v0[1]); w.y = pk2(v0[2], v0[3]); w.z = pk2(v1[0], v1[1]); w.w = pk2(v1[2], v1[3]);
                    *(u32x4*)(o + bj * 128) = w; } }
    }
};

struct SchedCmp {
    int wg; const char* KC; const char* VC; const char* W;
    __device__ bool next(int i, pg8::Unit& u) const { if (i > 0 || wg >= 32) return false; const int kv = wg >> 4, bg = wg & 15; u.pm = wg; u.pn = 0;
        u.A = (kv ? VC : KC) + (size_t)bg * SEQ * 64 * 2; u.B = W + (size_t)kv * 256 * 2048 * 2; return true; }
};
struct SchedMoe1 {
    int wg, G, c0, ncg, nchunks; const int* pstart; const char* A; const char* W;
    __device__ bool next(int i, pg8::Unit& u) const {
        if (ncg <= 0) return false;
        const int L = i * G + wg; const int cl = __builtin_amdgcn_readfirstlane(L % ncg), pn = __builtin_amdgcn_readfirstlane(L / ncg); if (pn >= 28) return false; const int c = c0 + cl; if (c >= nchunks) return false;
        int e = 0;
#pragma unroll
        for (int k = 1; k < 8; ++k) e += (c * 256 >= __builtin_amdgcn_readfirstlane(pstart[k])) ? 1 : 0;
        u.pm = c; u.pn = pn; u.A = A + (size_t)c * 256 * DM * 2; u.B = W + ((size_t)e * 7168 + (size_t)pn * 256) * DM; return true; }
};
struct SchedMoe2 {
    int wg, G, c0, ncg, nchunks; const int* pstart; const char* A; const char* W;
    __device__ bool next(int i, pg8::Unit& u) const {
        if (ncg <= 0) return false;
        const int L = i * G + wg; const int cl = __builtin_amdgcn_readfirstlane(L % ncg), pn = __builtin_amdgcn_readfirstlane(L / ncg); if (pn >= 4) return false; const int c = c0 + cl; if (c >= nchunks) return false;
        int e = 0;
#pragma unroll
        for (int k = 1; k < 8; ++k) e += (c * 256 >= __builtin_amdgcn_readfirstlane(pstart[k])) ? 1 : 0;
        u.pm = cl; u.pn = pn; u.A = A + (size_t)cl * 256 * DFE; u.B = W + ((size_t)e * 1024 + (size_t)pn * 256) * DFE; return true; }
};

__device__ __forceinline__ void transpose_block(const float* src, int ldw, bf16_t* dst, int ldt, int nvalid, LAS float* scr, int lane) {
    if (nvalid == 32) {
#pragma unroll
        for (int i = 0; i < 8; ++i) { const int kk = 8 * i + (lane >> 3), n = (lane & 7) * 4; const f32x4 v = *(const f32x4*)(src + (size_t)kk * ldw + n);
            LAS float* d = scr + kk * 33 + n; d[0] = v[0]; d[1] = v[1]; d[2] = v[2]; d[3] = v[3]; }
    } else {
#pragma unroll 8
        for (int i = 0; i < 32; ++i) { const int kk = 2 * i + (lane >> 5), n = lane & 31; scr[kk * 33 + n] = (n < nvalid) ? src[(size_t)kk * ldw + n] : 0.f; }
    }
    asm volatile("s_waitcnt lgkmcnt(0)" ::: "memory");
    const int c = lane & 7;
#pragma unroll
    for (int j = 0; j < 4; ++j) { const int n = (lane >> 3) + 8 * j; const LAS float* s = scr + (8 * c) * 33 + n;
        u32x4 o; o.x = pk2(s[0 * 33], s[1 * 33]); o.y = pk2(s[2 * 33], s[3 * 33]); o.z = pk2(s[4 * 33], s[5 * 33]); o.w = pk2(s[6 * 33], s[7 * 33]);
        *(u32x4*)(dst + (size_t)n * ldt + 8 * c) = o; }
    asm volatile("s_waitcnt lgkmcnt(0)" ::: "memory");
}
__device__ __forceinline__ void tb_load(f32x4 (&r)[8], const float* src, int ldw, int lane) {
#pragma unroll
    for (int i = 0; i < 8; ++i) r[i] = *(const f32x4*)(src + (size_t)(8 * i + (lane >> 3)) * ldw + (lane & 7) * 4);
}
template <bool FP8> __device__ __forceinline__ void tb_emit(const f32x4 (&r)[8], void* dstv, int ldt, LAS float* scr, int lane) {
#pragma unroll
    for (int i = 0; i < 8; ++i) { LAS float* d = scr + (8 * i + (lane >> 3)) * 33 + (lane & 7) * 4; d[0] = r[i][0]; d[1] = r[i][1]; d[2] = r[i][2]; d[3] = r[i][3]; }
    asm volatile("s_waitcnt lgkmcnt(0)" ::: "memory");
    const int c = lane & 7;
#pragma unroll
    for (int j = 0; j < 4; ++j) { const int n = (lane >> 3) + 8 * j; const LAS float* s = scr + (8 * c) * 33 + n;
        if constexpr (FP8) { u32x2 o; o.x = pk4_fp8(s[0 * 33] * FP8_WSCALE, s[1 * 33] * FP8_WSCALE, s[2 * 33] * FP8_WSCALE, s[3 * 33] * FP8_WSCALE); o.y = pk4_fp8(s[4 * 33] * FP8_WSCALE, s[5 * 33] * FP8_WSCALE, s[6 * 33] * FP8_WSCALE, s[7 * 33] * FP8_WSCALE);
            *(u32x2*)((unsigned char*)dstv + (size_t)n * ldt + 8 * c) = o; }
        else { u32x4 o; o.x = pk2(s[0 * 33], s[1 * 33]); o.y = pk2(s[2 * 33], s[3 * 33]); o.z = pk2(s[4 * 33], s[5 * 33]); o.w = pk2(s[6 * 33], s[7 * 33]);
            *(u32x4*)((bf16_t*)dstv + (size_t)n * ldt + 8 * c) = o; } }
    asm volatile("s_waitcnt lgkmcnt(0)" ::: "memory");
}
template <bool FP8 = false> __device__ __forceinline__ void conv_plain(const float* W, int K, int N, void* WTv, LAS float* scr, int gw, int ngw, int lane) {
    unsigned char* WT = (unsigned char*)WTv; constexpr int ES = FP8 ? 1 : 2;
    const int nkb = K / 64, nnb = N / 32, nit = nkb * nnb;
    f32x4 cur[8], nxt[8];
    int it = gw;
    if (it < nit) { const int kb = it / nnb, nb = it % nnb; tb_load(cur, W + (size_t)kb * 64 * N + nb * 32, N, lane); }
    for (; it < nit; it += ngw) {
        const int kb = it / nnb, nb = it % nnb;
        if (it + ngw < nit) { const int kb2 = (it + ngw) / nnb, nb2 = (it + ngw) % nnb; tb_load(nxt, W + (size_t)kb2 * 64 * N + nb2 * 32, N, lane); }
        tb_emit<FP8>(cur, WT + ((size_t)nb * 32 * K + kb * 64) * ES, K, scr, lane);
#pragma unroll
        for (int i = 0; i < 8; ++i) cur[i] = nxt[i];
    }
}
__device__ __forceinline__ void conv_gateup(const float* Wg, const float* Wu, int K, int N, bf16_t* WT, LAS float* scr, int gw, int ngw, int lane) {
    const int nkb = K / 64, nvb = 2 * N / 32, nit = nkb * nvb;
    f32x4 cur[8], nxt[8];
    int it = gw;
#define GU_SRC(itx) ((((((itx) % nvb) * 32) >> 7) & 1 ? Wu : Wg) + (size_t)((itx) / nvb) * 64 * N + (((((itx) % nvb) * 32) >> 8) * 128) + ((((itx) % nvb) * 32) & 127))
    if (it < nit) tb_load(cur, GU_SRC(it), N, lane);
    for (; it < nit; it += ngw) {
        const int kb = it / nvb, vb = it % nvb;
        if (it + ngw < nit) tb_load(nxt, GU_SRC(it + ngw), N, lane);
        tb_emit<false>(cur, WT + (size_t)vb * 32 * K + kb * 64, K, scr, lane);
#pragma unroll
        for (int i = 0; i < 8; ++i) cur[i] = nxt[i];
    }
#undef GU_SRC
}
__device__ __forceinline__ void conv_gateup_f8(const float* Wg, const float* Wu, int K, int N, unsigned char* WT, LAS float* scr, int gw, int ngw, int lane) {
    const int nkb = K / 64, nvb = 2 * N / 32, nit = nkb * nvb;
    f32x4 cur[8], nxt[8];
    int it = gw;
#define GU8_LOAD(r, itx) do { const int kb_ = (itx) / nvb, vb_ = (itx) % nvb, q8_ = lane & 7; const float* W_ = (q8_ & 1) ? Wu : Wg; \
        const float* src_ = W_ + (size_t)kb_ * 64 * N + (vb_ >> 3) * 128 + ((vb_ >> 1) & 1) * 64 + (q8_ >> 1) * 16 + ((vb_ >> 2) & 1) * 8 + (vb_ & 1) * 4; \
        _Pragma("unroll") for (int i = 0; i < 8; ++i) r[i] = *(const f32x4*)(src_ + (size_t)(8 * i + (lane >> 3)) * N); } while (0)
    if (it < nit) GU8_LOAD(cur, it);
    for (; it < nit; it += ngw) {
        const int kb = it / nvb, vb = it % nvb;
        if (it + ngw < nit) GU8_LOAD(nxt, it + ngw);
        tb_emit<true>(cur, WT + (size_t)vb * 32 * K + kb * 64, K, scr, lane);
#pragma unroll
        for (int i = 0; i < 8; ++i) cur[i] = nxt[i];
    }
#undef GU8_LOAD
}
__device__ __forceinline__ void conv_inproj(const float* W, bf16_t* WT, LAS float* scr, int gw, int ngw, int lane) {
    const int nkb = DM / 64, nvb = INP / 32;
    for (int it = gw; it < nkb * nvb; it += ngw) { const int kb = it / nvb, vb = it % nvb; const int v0 = vb * 32, pn = v0 >> 8, bj = (v0 >> 7) & 1, wc = (v0 >> 5) & 3;
        int col, nvalid = 32;
        if (pn < 11) { const int vh = 4 * pn + wc; col = (vh < 20 ? 64 * vh : 1304 + 64 * (vh - 20)) + 32 * bj; }
        else { col = 1280; nvalid = (bj == 0 && wc == 0) ? 24 : 0; }
        transpose_block(W + (size_t)kb * 64 * IN_W + col, IN_W, WT + (size_t)v0 * DM + kb * 64, DM, nvalid, scr, lane); }
}

__device__ __forceinline__ f32x16 mfma32(bf16x8 a, bf16x8 b, f32x16 c) { return __builtin_amdgcn_mfma_f32_32x32x16_bf16(a, b, c, 0, 0, 0); }
typedef short v4i16_t __attribute__((ext_vector_type(4)));
__device__ __forceinline__ s16x4 vtr(const LAS char* p) { return __builtin_bit_cast(s16x4, __builtin_amdgcn_ds_read_tr16_b64_v4i16((LAS v4i16_t*)p)); }

__device__ __forceinline__ void init_scores(f32x16& p0, f32x16& p1, int dbase, int dstep, int dmaxv, bool lanevalid, const LAS float* lut) {
#pragma unroll
    for (int r = 0; r < 16; ++r) {
        const int kk = (r & 3) + 8 * (r >> 2);
        const int d0 = dbase - dstep * kk, d1 = dbase - dstep * (kk + 32);
        const bool v0 = lanevalid && ((unsigned)d0 <= (unsigned)dmaxv), v1 = lanevalid && ((unsigned)d1 <= (unsigned)dmaxv);
        const int i0 = min(max(d0, 0), LUTN - 1), i1 = min(max(d1, 0), LUTN - 1);
        const float b0 = lut[(LUTN - 1) - i0], b1 = lut[(LUTN - 1) - i1];
        p0[r] = v0 ? b0 : NEGF; p1[r] = v1 ? b1 : NEGF;
    }
}
__device__ __forceinline__ void qk_tile(f32x16& p0, f32x16& p1, const LAS char* Ks, const bf16x8 (&qr)[4], int r32, int hi) {
    const LAS char* kb = Ks + hi * 1024 + r32 * 16;
#pragma unroll
    for (int d0 = 0; d0 < 4; ++d0) {
        const bf16x8 b0 = *(const LAS bf16x8*)(kb + d0 * 2048), b1 = *(const LAS bf16x8*)(kb + d0 * 2048 + 512);
        p0 = mfma32(b0, qr[d0], p0); p1 = mfma32(b1, qr[d0], p1);
    }
}
__device__ __forceinline__ void k_load(bf16x8 (&kf)[8], const LAS char* kb) {
#pragma unroll
    for (int d0 = 0; d0 < 4; ++d0) { kf[2 * d0] = *(const LAS bf16x8*)(kb + d0 * 2048); kf[2 * d0 + 1] = *(const LAS bf16x8*)(kb + d0 * 2048 + 512); }
}
__device__ __forceinline__ void qk_mma(f32x16& p0, f32x16& p1, const bf16x8 (&kf)[8], const bf16x8 (&qr)[4]) {
#pragma unroll
    for (int d0 = 0; d0 < 4; ++d0) { p0 = mfma32(kf[2 * d0], qr[d0], p0); p1 = mfma32(kf[2 * d0 + 1], qr[d0], p1); }
}
__device__ __forceinline__ bf16x8 pack8(const f32x16& p, int s) {
    u32x4 w; w.x = pk2(p[8 * s], p[8 * s + 1]); w.y = pk2(p[8 * s + 2], p[8 * s + 3]); w.z = pk2(p[8 * s + 4], p[8 * s + 5]); w.w = pk2(p[8 * s + 6], p[8 * s + 7]);
    return __builtin_bit_cast(bf16x8, w);
}
__device__ __forceinline__ void pv_tile(f32x16 (&o)[2], const LAS char* vb, const f32x16& p0, const f32x16& p1) {
    bf16x8 pf[4]; pf[0] = pack8(p0, 0); pf[1] = pack8(p0, 1); pf[2] = pack8(p1, 0); pf[3] = pack8(p1, 1);
#pragma unroll
    for (int db = 0; db < 2; ++db)
#pragma unroll
        for (int ks = 0; ks < 4; ++ks) {
            const s16x4 lo = vtr(vb + db * 4096 + ks * 1024), hh = vtr(vb + db * 4096 + ks * 1024 + 512);
            const bf16x8 vf = (bf16x8){lo[0], lo[1], lo[2], lo[3], hh[0], hh[1], hh[2], hh[3]};
            o[db] = mfma32(vf, pf[ks], o[db]);
        }
}
__device__ __forceinline__ void v_load(bf16x8 (&vf)[8], const LAS char* vb) {
#pragma unroll
    for (int db = 0; db < 2; ++db)
#pragma unroll
        for (int ks = 0; ks < 4; ++ks) {
            const s16x4 lo = vtr(vb + db * 4096 + ks * 1024), hh = vtr(vb + db * 4096 + ks * 1024 + 512);
            vf[db * 4 + ks] = (bf16x8){lo[0], lo[1], lo[2], lo[3], hh[0], hh[1], hh[2], hh[3]};
        }
}
__device__ __forceinline__ void pv_mma(f32x16 (&o)[2], const bf16x8 (&vf)[8], const f32x16& p0, const f32x16& p1) {
    bf16x8 pf[4]; pf[0] = pack8(p0, 0); pf[1] = pack8(p0, 1); pf[2] = pack8(p1, 0); pf[3] = pack8(p1, 1);
#pragma unroll
    for (int ks = 0; ks < 4; ++ks) { o[0] = mfma32(vf[ks], pf[ks], o[0]); o[1] = mfma32(vf[4 + ks], pf[ks], o[1]); }
}
#define SCHED_FENCE() __builtin_amdgcn_sched_barrier(0)
__device__ __forceinline__ float max16x2(const f32x16& a, const f32x16& b) {
    float m = fmaxf(a[0], b[0]);
#pragma unroll
    for (int r = 1; r < 16; ++r) m = fmaxf(m, fmaxf(a[r], b[r]));
    return m;
}
__device__ __forceinline__ void init_direct(f32x16& p0, f32x16& p1, const LAS float* base) {
#pragma unroll
    for (int r = 0; r < 16; ++r) { const int kk = (r & 3) + 8 * (r >> 2); p0[r] = base[kk]; p1[r] = base[kk + 32]; }
}
__device__ __forceinline__ float exp_tile(f32x16& p0, f32x16& p1) {
    float rs = 0.f;
#pragma unroll
    for (int r = 0; r < 16; ++r) { p0[r] = fexp2(p0[r]); p1[r] = fexp2(p1[r]); rs += p0[r] + p1[r]; }
    return rs;
}

constexpr int AL_KV = 0;
constexpr int LUTS_N = 64 + LUTN, LUTW_N = 64 + 512 + 128;
constexpr int AL_LUTS = 65536;
constexpr int AL_LUTW = AL_LUTS + 4 * LUTS_N * 4, AL_NEGP = AL_LUTW + 4 * LUTW_N * 4;
constexpr int AL_IMP = AL_NEGP + 512;
constexpr int AL_SEL = LDSCTL_OFF + 1024;
constexpr int AL_DLUT = 65536;
constexpr int AL_STA = AL_IMP, AL_STB = AL_SEL + 2048;
static_assert(AL_STB + 2 * 4096 <= LDS_BYTES && AL_STA + 6 * 4096 <= RING_BYTES && AL_IMP + 64 * 65 * 4 <= RING_BYTES, "attention LDS map");

__device__ __forceinline__ void glds16(const void* gsrc, unsigned lds_dst) { unsigned keep;
    asm volatile("s_mov_b32 %0, m0\n\ts_mov_b32 m0, %2\n\ts_nop 0\n\tglobal_load_lds_dwordx4 %1, off\n\ts_mov_b32 m0, %0" : "=&s"(keep) : "v"(gsrc), "s"(lds_dst) : "memory"); }
__device__ __forceinline__ void kv_dma(const bf16_t* Kt, const bf16_t* Vt, LAS char* slot, int w, int lane) {
    const unsigned base = (unsigned)__builtin_amdgcn_readfirstlane((int)(unsigned)(size_t)slot + w * 1024);
    glds16(Kt + lane * 64 + w * 8, base);
    glds16(Vt + ((w & 3) * 16 + (lane >> 2)) * 64 + (w >> 2) * 32 + (lane & 3) * 8, base + 8192u);
}
#define WAITBAR(N) asm volatile("s_waitcnt vmcnt(" #N ") lgkmcnt(0)\n\ts_barrier" ::: "memory")

__device__ __forceinline__ void stash_store(LAS char* st, const f32x16 (&o)[2]) {
#pragma unroll
    for (int k = 0; k < 4; ++k) { const f32x16& v = o[k >> 1]; const int b = 8 * (k & 1);
        u32x4 wv; wv.x = pk2(v[b], v[b + 1]); wv.y = pk2(v[b + 2], v[b + 3]); wv.z = pk2(v[b + 4], v[b + 5]); wv.w = pk2(v[b + 6], v[b + 7]); *(LAS u32x4*)(st + k * 1024) = wv; }
}
__device__ __forceinline__ void stash_load(const LAS char* st, f32x16 (&o)[2]) {
#pragma unroll
    for (int k = 0; k < 4; ++k) { const u32x4 wv = *(const LAS u32x4*)(st + k * 1024); f32x16& v = o[k >> 1]; const int b = 8 * (k & 1);
        v[b] = bflo(wv.x); v[b + 1] = bfhi(wv.x); v[b + 2] = bflo(wv.y); v[b + 3] = bfhi(wv.y); v[b + 4] = bflo(wv.z); v[b + 5] = bfhi(wv.z); v[b + 6] = bflo(wv.w); v[b + 7] = bfhi(wv.w); }
}
__device__ __forceinline__ void nsa_prepare(const Frame& F, int L, int g) {
    LAS char* lds = (LAS char*)F.lds; int tid_l = F.tid; asm volatile("" : "+v"(tid_l)); const int tid = tid_l;
    const float* LUTG = (const float*)(F.ws + WS_LUT) + (size_t)(L * 16 + g * 4) * LUTN;
    LAS float* ls = (LAS float*)(lds + AL_LUTS); LAS float* lw = (LAS float*)(lds + AL_LUTW); LAS float* np = (LAS float*)(lds + AL_NEGP);
    __syncthreads();
    for (int h = 0; h < 4; ++h) {
        for (int x = tid; x < LUTS_N; x += NTHR) ls[h * LUTS_N + x] = (x >= LUTN) ? NEGF : LUTG[h * LUTN + (LUTN - 1 - x)];
        for (int x = tid; x < LUTW_N; x += NTHR) { const int d = 639 - x; lw[h * LUTW_N + x] = (d < 0 || d > 511) ? NEGF : LUTG[h * LUTN + d]; }
    }
    if (tid < 128) np[tid] = NEGF;
    __syncthreads();
}

__device__ __forceinline__ void nsa_unit(const Frame& F, int L, int b, int g, int i) {
    LAS char* lds = (LAS char*)F.lds;
    int tid_l = F.tid; asm volatile("" : "+v"(tid_l));
    const int tid = tid_l, lane = tid & 63, w = __builtin_amdgcn_readfirstlane(tid >> 6), r32 = lane & 31, hi = lane >> 5;
    const int hh = w >> 1, qh = w & 1, head = g * 4 + hh;
    const int t0 = i * 64, tq = t0 + 32 * qh + r32;
    unsigned char* ws = F.ws;
    const bf16_t* QA = (const bf16_t*)(ws + WS_QA);
    const size_t bgoff = (size_t)(b * 2 + g) * SEQ * 64;
    const bf16_t *KS = (const bf16_t*)(ws + WS_KS) + bgoff, *VS = (const bf16_t*)(ws + WS_VS) + bgoff, *KW = (const bf16_t*)(ws + WS_KW) + bgoff, *VW = (const bf16_t*)(ws + WS_VW) + bgoff;
    const bf16_t *KCC = (const bf16_t*)(ws + WS_KCC) + (size_t)(b * 2 + g) * 256 * 64, *VCC = (const bf16_t*)(ws + WS_VCC) + (size_t)(b * 2 + g) * 256 * 64;
    LAS char* ring = lds + AL_KV;
    const LAS float* luts = (const LAS float*)(lds + AL_LUTS) + hh * LUTS_N;
    const LAS float* lutw = (const LAS float*)(lds + AL_LUTW) + hh * LUTW_N;
    const LAS float* negp = (const LAS float*)(lds + AL_NEGP);
    WAITBAR(0);
    const int ntc = (4 * i + 3 + 63) >> 6;
#pragma unroll
    for (int p = 0; p < 4; ++p) if (p < ntc) kv_dma(KCC + (size_t)p * 4096, VCC + (size_t)p * 4096, ring + p * 16384, w, lane);
    bf16x8 qr[4];
    { const bf16_t* Qp = QA + ((size_t)(b * 8 + head) * SEQ + tq) * 64;
#pragma unroll
      for (int d0 = 0; d0 < 4; ++d0) qr[d0] = *(const bf16x8*)(Qp + d0 * 16 + hi * 8); }
    const int vlane = ((lane >> 4) & 1) * 32 + (lane & 3) * 8 + (4 * hi + ((lane & 15) >> 2)) * 64 + 8192;
    const float* GT = (const float*)(ws + WS_GATES) + (size_t)(b * SEQ + tq) * 24 + head * 3;
    const float g_c = GT[0], g_s = GT[1], g_w = GT[2];
    const float cfar = luts[0];
    LAS char* stash = lds + ((w < 6) ? AL_STA + w * 4096 : AL_STB + (w - 6) * 4096) + lane * 16;
    const int j0 = (i >= 8) ? i - 8 : 0, nw = i - j0 + 1;
    f32x16 oc[2];
    {
#pragma unroll
        for (int r = 0; r < 16; ++r) { oc[0][r] = 0.f; oc[1][r] = 0.f; }
        float lc = 0.f, carry = 0.f;
        { LAS int* iz = (LAS int*)(lds + AL_IMP); for (int k = tid; k < 64 * 65; k += NTHR) iz[k] = 0; }
        WAITBAR(0);
        for (int t = 0; t < ntc; ++t) {
            f32x16 p0, p1;
            init_scores(p0, p1, (tq - 31) - 16 * (64 * t + 4 * hi), 16, 1 << 20, true, luts);
            qk_tile(p0, p1, ring + t * 16384, qr, r32, hi);
            lc += exp_tile(p0, p1);
        }
        lc += __shfl_xor(lc, 32);
        const float lcinv = (tq >= 31) ? 1.0f / lc : 0.f;
        LAS int* impq = (LAS int*)(lds + AL_IMP) + (32 * qh + r32);
        for (int t = 0; t < ntc; ++t) {
            const LAS char* buf = ring + t * 16384;
            f32x16 p0, p1; bf16x8 vf[8];
            init_scores(p0, p1, (tq - 31) - 16 * (64 * t + 4 * hi), 16, 1 << 20, true, luts);
            qk_tile(p0, p1, buf, qr, r32, hi);
            v_load(vf, buf + vlane); SCHED_FENCE();
#pragma unroll
            for (int r = 0; r < 16; ++r) { p0[r] = fexp2(p0[r]) * lcinv; p1[r] = fexp2(p1[r]) * lcinv; }
#pragma unroll
            for (int blk = 0; blk < 2; ++blk)
#pragma unroll
                for (int g4 = 0; g4 < 4; ++g4) {
                    const f32x16& p = blk ? p1 : p0;
                    const float a = p[4 * g4] + p[4 * g4 + 1] + p[4 * g4 + 2] + 0.5f * p[4 * g4 + 3], bn = 0.5f * p[4 * g4 + 3];
                    const float pb = __shfl_xor(bn, 32);
                    const float v = hi ? (a + pb) : (a + carry); carry = pb;
                    const int j = 16 * t + 8 * blk + 2 * g4 + hi;
                    (void)__hip_atomic_fetch_add(impq + j * 65, (int)(v * 67108864.0f + 0.5f), __ATOMIC_RELAXED, __HIP_MEMORY_SCOPE_WORKGROUP);
                }
            pv_mma(oc, vf, p0, p1);
        }
#pragma unroll
        for (int r = 0; r < 16; ++r) { oc[0][r] *= g_c; oc[1][r] *= g_c; }
        WAITBAR(0);
#pragma unroll
        for (int p = 0; p < 3; ++p) if (p < nw) kv_dma(KW + (size_t)(j0 + p) * 4096, VW + (size_t)(j0 + p) * 4096, ring + p * 16384, w, lane);
    }
    {
        const LAS int* imp = (const LAS int*)(lds + AL_IMP);
        LAS unsigned* selm = (LAS unsigned*)(lds + AL_SEL);
        unsigned um0 = 0u, um1 = 0u;
        for (int qq = 0; qq < 8; ++qq) {
            const int q = w * 8 + qq;
            int v = imp[lane * 65 + q];
            if (lane == 0 || lane == i || lane == i - 1) v = 0x7fffffff; else if (lane > i) v = -1;
            int thr = 0;
#pragma unroll
            for (int bit = 30; bit >= 0; --bit) { const int cand = thr | (1 << bit); if (__popcll(__ballot(v >= cand)) >= 16) thr = cand; }
            const unsigned long long gtm = __ballot(v > thr), eqm = __ballot(v == thr);
            const int need = 16 - __popcll(gtm);
            const bool sel = ((v > thr) || (v == thr && __popcll(eqm & ((1ull << lane) - 1ull)) < need)) && (lane <= i);
            const unsigned long long mk = __ballot(sel);
            if (lane == 0) { selm[q * 2] = (unsigned)mk; selm[q * 2 + 1] = (unsigned)(mk >> 32); }
            um0 |= (unsigned)mk; um1 |= (unsigned)(mk >> 32);
        }
        if (lane == 0) { selm[128 + w * 2] = um0; selm[128 + w * 2 + 1] = um1; }
        asm volatile("s_waitcnt lgkmcnt(0)\n\ts_barrier" ::: "memory");
        stash_store(stash, oc);
        if (w == 0) {
            unsigned a0 = 0u, a1 = 0u;
#pragma unroll
            for (int k = 0; k < 8; ++k) { a0 |= selm[128 + 2 * k]; a1 |= selm[128 + 2 * k + 1]; }
            const unsigned long long um = ((unsigned long long)a1 << 32) | a0;
            LAS int* ul = (LAS int*)(lds + AL_SEL + 1024);
            if ((um >> lane) & 1ull) ul[__popcll(um & ((1ull << lane) - 1ull))] = lane;
            if (lane == 0) ul[64] = __popcll(um);
        }
    }
    const int koff = hi * 1024 + r32 * 16;
#define BAR_V(N) asm volatile("s_waitcnt vmcnt(" #N ")\n\ts_barrier" ::: "memory")
#define NSA_STEP(T, C0, C1, N0, N1) do { const int t_ = (T); \
        if (t_ > 0) asm volatile("s_barrier" ::: "memory");                \
        if (t_ + 3 < n_) { NSA_DMA(t_ + 3); } \
        const int tn_ = min(t_ + 1, n_ - 1); \
        NSA_INIT(tn_, N0, N1); \
        bf16x8 kf_[8], vf_[8]; \
        k_load(kf_, ring + (tn_ & 3) * 16384 + koff); \
        v_load(vf_, ring + (t_ & 3) * 16384 + vlane); \
        if (t_ + 3 < n_) WAITBAR(2); else WAITBAR(0);                           \
        SCHED_FENCE(); \
        lsum_ += exp_tile(C0, C1); \
        qk_mma(N0, N1, kf_, qr); \
        pv_mma(o_, vf_, C0, C1); \
    } while (0)
#define NSA_STREAM() do { \
        WAITBAR(0); \
        f32x16 a0, a1, b0, b1; \
        NSA_INIT(0, a0, a1); \
        qk_tile(a0, a1, ring, qr, r32, hi); \
        if (w >= 4) asm volatile("s_barrier" ::: "memory"); \
        _Pragma("unroll 1") for (int t = 0; t < n_; t += 2) { NSA_STEP(t, a0, a1, b0, b1); if (t + 1 < n_) NSA_STEP(t + 1, b0, b1, a0, a1); } \
        if (w < 4) asm volatile("s_barrier" ::: "memory"); \
    } while (0)
    {
        f32x16 o_[2];
#pragma unroll
        for (int r = 0; r < 16; ++r) { o_[0][r] = 0.f; o_[1][r] = 0.f; }
        float lsum_ = 0.f;
        const int n_ = nw;
#define NSA_DMA(tt) kv_dma(KW + (size_t)(j0 + (tt)) * 4096, VW + (size_t)(j0 + (tt)) * 4096, ring + ((tt) & 3) * 16384, w, lane)
#define NSA_INIT(tt, S0, S1) init_direct(S0, S1, lutw + (639 - (tq - 64 * (j0 + (tt)) - 4 * hi)))
        NSA_STREAM();
#undef NSA_DMA
#undef NSA_INIT
        lsum_ += __shfl_xor(lsum_, 32); const float sc = g_w / lsum_;
        f32x16 ot[2]; stash_load(stash, ot);
#pragma unroll
        for (int r = 0; r < 16; ++r) { ot[0][r] += sc * o_[0][r]; ot[1][r] += sc * o_[1][r]; }
        stash_store(stash, ot);
    }
    WAITBAR(0);
    f32x16 ot[2];
    {
        const LAS unsigned* selm = (const LAS unsigned*)(lds + AL_SEL);
        const LAS int* ul = (const LAS int*)(lds + AL_SEL + 1024);
        const int n_ = __builtin_amdgcn_readfirstlane(ul[64]);
        const int ulv = ul[lane];
        const unsigned sm0 = selm[(32 * qh + r32) * 2], sm1 = selm[(32 * qh + r32) * 2 + 1];
        f32x16 o_[2];
#pragma unroll
        for (int r = 0; r < 16; ++r) { o_[0][r] = 0.f; o_[1][r] = 0.f; }
        float lsum_ = 0.f;
#define NSA_DMA(tt) do { const int jn_ = __builtin_amdgcn_readlane(ulv, (tt)); kv_dma(KS + (size_t)jn_ * 4096, VS + (size_t)jn_ * 4096, ring + ((tt) & 3) * 16384, w, lane); } while (0)
#define NSA_INIT(tt, S0, S1) do { const int jA_ = __builtin_amdgcn_readlane(ulv, (tt)); \
            const bool selbit_ = (jA_ < 32) ? ((sm0 >> jA_) & 1u) : ((sm1 >> (jA_ - 32)) & 1u); \
            if (t0 + 32 * qh - (64 * jA_ + 63) >= 1513) { const float c_ = selbit_ ? cfar : NEGF; \
                _Pragma("unroll") for (int r = 0; r < 16; ++r) { S0[r] = c_; S1[r] = c_; } } \
            else init_direct(S0, S1, selbit_ ? (luts + ((LUTN - 1) - (tq - 64 * jA_ - 4 * hi))) : negp); } while (0)
        for (int p = 0; p < 3; ++p) if (p < n_) NSA_DMA(p);
        NSA_STREAM();
#undef NSA_DMA
#undef NSA_INIT
        lsum_ += __shfl_xor(lsum_, 32); const float sc = g_s / lsum_;
        stash_load(stash, ot);
#pragma unroll
        for (int r = 0; r < 16; ++r) { ot[0][r] += sc * o_[0][r]; ot[1][r] += sc * o_[1][r]; }
    }
#undef NSA_STEP
#undef NSA_STREAM
    { bf16_t* O = (bf16_t*)(ws + WS_OA) + (size_t)(b * SEQ + tq) * 512 + head * 64 + 4 * hi;
#pragma unroll
      for (int db = 0; db < 2; ++db)
#pragma unroll
          for (int g4 = 0; g4 < 4; ++g4) { u32x2 v; v.x = pk2(ot[db][4 * g4], ot[db][4 * g4 + 1]); v.y = pk2(ot[db][4 * g4 + 2], ot[db][4 * g4 + 3]); *(u32x2*)(O + 32 * db + 8 * g4) = v; } }
}

__device__ __forceinline__ void dil_unit(const Frame& F, int L, int u) {
    LAS char* lds = (LAS char*)F.lds;
    int tid_l = F.tid; asm volatile("" : "+v"(tid_l));
    const int tid = tid_l, lane = tid & 63, w = __builtin_amdgcn_readfirstlane(tid >> 6), r32 = lane & 31, hi = lane >> 5;
    const int half = w >> 2, wh = w & 3, th = tid & 255;
    const int pair = u & 15, br = (u >> 4) % 3, head = (u / 48) & 7, b = u / 384;
    const int dil = (br == 0) ? 1 : (br == 1) ? 4 : 16, nb = 32 / dil;
    const int beta = 2 * pair + half, res = beta / nb, n = beta % nb;
    unsigned char* ws = F.ws;
    const size_t hoff = (size_t)(b * 8 + head) * SEQ * 64;
    const bf16_t *Q = (const bf16_t*)(ws + WS_QB) + hoff, *K = (const bf16_t*)(ws + WS_KB) + hoff, *V = (const bf16_t*)(ws + WS_VB) + hoff;
    const float* LUTG = (const float*)(ws + WS_LUT) + (size_t)(L * 16 + 8 + head) * LUTN;
    LAS float* lutd = (LAS float*)(lds + AL_DLUT);
    __syncthreads();
    if (tid < 321) { const int nd = 224 - tid; lutd[tid] = (nd < 0 || nd > 128) ? NEGF : LUTG[min(nd * dil, LUTN - 1)]; }
    const int P = 128 * n + 32 * wh + r32, tq = P * dil + res;
    bf16x8 qr[4];
    { const bf16_t* Qp = Q + (size_t)tq * 64;
#pragma unroll
      for (int d0 = 0; d0 < 4; ++d0) qr[d0] = *(const bf16x8*)(Qp + d0 * 16 + hi * 8); }
    LAS char* kvb = lds + AL_KV + half * 32768;
    const LAS char* vboff = (const LAS char*)(kvb + 8192 + ((lane >> 4) & 1) * 32 + (lane & 3) * 8 + (4 * hi + ((lane & 15) >> 2)) * 64);
    f32x16 o[2];
#pragma unroll
    for (int r = 0; r < 16; ++r) { o[0][r] = 0.f; o[1][r] = 0.f; }
    float lsum = 0.f;
    const int tt0 = (n == 0) ? 2 : 0;
    u32x4 rk[2], rv[2];
#define DIL_LOAD(tt) do { const int Pk0 = 128 * (n - 1) + 64 * (tt); if (Pk0 >= 0) { _Pragma("unroll") for (int k = 0; k < 2; ++k) { const int c = th + 256 * k; \
        rk[k] = *(const u32x4*)(K + (size_t)((Pk0 + (c & 63)) * dil + res) * 64 + (c >> 6) * 8); \
        rv[k] = *(const u32x4*)(V + (size_t)((Pk0 + ((c >> 2) & 63)) * dil + res) * 64 + (c >> 8) * 32 + (c & 3) * 8); } } } while (0)
#define DIL_STORE(bufi) do { _Pragma("unroll") for (int k = 0; k < 2; ++k) { const int c = th + 256 * k; *(LAS u32x4*)(kvb + (bufi) * 16384 + c * 16) = rk[k]; *(LAS u32x4*)(kvb + (bufi) * 16384 + 8192 + c * 16) = rv[k]; } } while (0)
    DIL_LOAD(0); DIL_STORE(0); __syncthreads();
#pragma unroll 1
    for (int tt = 0; tt < 4; ++tt) {
        if (tt + 1 < 4) DIL_LOAD(tt + 1);
        const int ndmax = 128 + 32 * wh + 31 - 64 * tt, ndmin = 128 + 32 * wh - 64 * tt - 63;
        if (tt >= tt0 && ndmax >= 0 && ndmin <= 128) {
            const LAS char* buf = kvb + (tt & 1) * 16384;
            f32x16 p0, p1;
            init_direct(p0, p1, lutd + (224 - (128 + 32 * wh + r32 - 64 * tt - 4 * hi)));
            bf16x8 vf[8];
            qk_tile(p0, p1, buf, qr, r32, hi);
            v_load(vf, vboff + (tt & 1) * 16384); SCHED_FENCE();
            lsum += exp_tile(p0, p1);
            pv_mma(o, vf, p0, p1);
        }
        if (tt + 1 < 4) DIL_STORE((tt + 1) & 1);
        __syncthreads();
    }
#undef DIL_LOAD
#undef DIL_STORE
    const float lt = lsum + __shfl_xor(lsum, 32), linv = 1.0f / lt;
    const size_t tok = (size_t)b * SEQ + tq;
    if (hi == 0) ((float*)(ws + WS_LSE))[((size_t)br * MTOK + tok) * 8 + head] = (((const float*)(ws + WS_BSH))[L] + __log2f(lt)) * LN2;
    bf16_t* O = (bf16_t*)(ws + WS_OB) + ((size_t)br * MTOK + tok) * 512 + head * 64 + 4 * hi;
#pragma unroll
    for (int db = 0; db < 2; ++db)
#pragma unroll
        for (int g4 = 0; g4 < 4; ++g4) { u32x2 v; v.x = pk2(o[db][4 * g4] * linv, o[db][4 * g4 + 1] * linv); v.y = pk2(o[db][4 * g4 + 2] * linv, o[db][4 * g4 + 3] * linv); *(u32x2*)(O + 32 * db + 8 * g4) = v; }
}

__device__ __forceinline__ void norm_row(const float* xrow, const float* gain, bf16_t* orow, int lane, f32x4 (&v)[4]) {
    float s = 0.f;
#pragma unroll
    for (int j = 0; j < 4; ++j) { v[j] = *(const f32x4*)(xrow + 4 * lane + 256 * j); s += (v[j][0] * v[j][0] + v[j][1] * v[j][1]) + (v[j][2] * v[j][2] + v[j][3] * v[j][3]); }
    const float rstd = __builtin_amdgcn_rsqf(wave_sum(s) * (1.0f / DM) + RMS_EPS);
#pragma unroll
    for (int j = 0; j < 4; ++j) { const f32x4 gg = *(const f32x4*)(gain + 4 * lane + 256 * j); v[j] = v[j] * rstd * gg;
        u32x2 o; o.x = pk2(v[j][0], v[j][1]); o.y = pk2(v[j][2], v[j][3]); *(u32x2*)(orow + 4 * lane + 256 * j) = o; }
}

__device__ __forceinline__ void norm_row_b(const bf16_t* xrow, const float* gain, bf16_t* orow, int lane, f32x4 (&v)[4]) {
    float s = 0.f;
#pragma unroll
    for (int j = 0; j < 4; ++j) { const u32x2 a = *(const u32x2*)(xrow + 4 * lane + 256 * j); v[j] = (f32x4){bflo(a.x), bfhi(a.x), bflo(a.y), bfhi(a.y)}; s += (v[j][0] * v[j][0] + v[j][1] * v[j][1]) + (v[j][2] * v[j][2] + v[j][3] * v[j][3]); }
    const float rstd = __builtin_amdgcn_rsqf(wave_sum(s) * (1.0f / DM) + RMS_EPS);
#pragma unroll
    for (int j = 0; j < 4; ++j) { const f32x4 gg = *(const f32x4*)(gain + 4 * lane + 256 * j); v[j] = v[j] * rstd * gg;
        *(unsigned*)((unsigned char*)orow + 4 * lane + 256 * j) = pk4_fp8(v[j][0] * FP8_ASCALE, v[j][1] * FP8_ASCALE, v[j][2] * FP8_ASCALE, v[j][3] * FP8_ASCALE); }
}
template <int RB> __device__ __forceinline__ void norm_rows(const float* X, const float* gain, bf16_t* U, int m0, int mstride, int lane) {
    f32x4 v[RB][4];
#pragma unroll
    for (int r = 0; r < RB; ++r)
#pragma unroll
        for (int j = 0; j < 4; ++j) v[r][j] = *(const f32x4*)(X + (size_t)(m0 + r * mstride) * DM + 4 * lane + 256 * j);
    f32x4 gg[4];
#pragma unroll
    for (int j = 0; j < 4; ++j) gg[j] = *(const f32x4*)(gain + 4 * lane + 256 * j);
#pragma unroll
    for (int r = 0; r < RB; ++r) {
        float s2 = 0.f;
#pragma unroll
        for (int j = 0; j < 4; ++j) s2 += (v[r][j][0] * v[r][j][0] + v[r][j][1] * v[r][j][1]) + (v[r][j][2] * v[r][j][2] + v[r][j][3] * v[r][j][3]);
        const float rstd = __builtin_amdgcn_rsqf(wave_sum(s2) * (1.0f / DM) + RMS_EPS);
        bf16_t* orow = U + (size_t)(m0 + r * mstride) * DM;
#pragma unroll
        for (int j = 0; j < 4; ++j) { const f32x4 x = v[r][j] * rstd * gg[j]; u32x2 o; o.x = pk2(x[0], x[1]); o.y = pk2(x[2], x[3]); *(u32x2*)(orow + 4 * lane + 256 * j) = o; }
    }
}

__device__ __forceinline__ void moe_combine(unsigned char* ws, float* out, int ncw, int cw0, bool want_tail) {
    const bf16_t* HB = (const bf16_t*)(ws + WS_HB);
    int tid_l_ = threadIdx.x; asm volatile("" : "+v"(tid_l_)); const int lane = tid_l_ & 63, wave = __builtin_amdgcn_readfirstlane(tid_l_ >> 6), cw = cw0 + wave;
    const int* tokpos = (const int*)(ws + RT_TOKPOS); const float* topG = (const float*)(ws + RT_TOPG); const bf16_t* Y = (const bf16_t*)(ws + WS_VSORT);
    for (int mb = cw; mb < MTOK; mb += 2 * ncw) {
        int pa[2], pb2[2]; float ga[2], gb[2]; bool act[2];
#pragma unroll
        for (int r = 0; r < 2; ++r) { const int m = mb + r * ncw; act[r] = (m < MTOK); const int mm = act[r] ? m : 0; pa[r] = tokpos[mm * 2]; pb2[r] = tokpos[mm * 2 + 1]; ga[r] = topG[mm * 2]; gb[r] = topG[mm * 2 + 1];
            act[r] = act[r] && (((pa[r] >= 65536) || (pb2[r] >= 65536)) == want_tail); }
        if (!(act[0] || act[1])) continue;
        u32x2 hv[2][4]; u32x2 ya[2][4], yb[2][4];
#pragma unroll
        for (int r = 0; r < 2; ++r) if (act[r]) { const int m = mb + r * ncw; const bf16_t* o = HB + (size_t)m * DM; const bf16_t* y0 = Y + (size_t)pa[r] * DM; const bf16_t* y1 = Y + (size_t)pb2[r] * DM;
#pragma unroll
            for (int j = 0; j < 4; ++j) { const int c = 4 * lane + 256 * j; hv[r][j] = *(const u32x2*)(o + c); ya[r][j] = *(const u32x2*)(y0 + c); yb[r][j] = *(const u32x2*)(y1 + c); } }
#pragma unroll
        for (int r = 0; r < 2; ++r) if (act[r]) { const int m = mb + r * ncw; float* o = out + (size_t)m * DM; const float g0 = ga[r], g1 = gb[r];
#pragma unroll
            for (int j = 0; j < 4; ++j) { const int c = 4 * lane + 256 * j; const u32x2 hb = hv[r][j]; f32x4 v = (f32x4){bflo(hb.x), bfhi(hb.x), bflo(hb.y), bfhi(hb.y)}; const u32x2 a = ya[r][j], b = yb[r][j];
                v[0] += g0 * bflo(a.x) + g1 * bflo(b.x); v[1] += g0 * bfhi(a.x) + g1 * bfhi(b.x); v[2] += g0 * bflo(a.y) + g1 * bflo(b.y); v[3] += g0 * bfhi(a.y) + g1 * bfhi(b.y);
                *(f32x4*)(o + c) = v; } }
    }
}

template <int RB, bool FP8OUT = false> __device__ __forceinline__ void norm_rows_b(const bf16_t* X, const float* gain, void* Uv, int m0, int mstride, int lane) {
    bf16_t* U = (bf16_t*)Uv;
    u32x4 x[RB][2];
#pragma unroll
    for (int r = 0; r < RB; ++r)
#pragma unroll
        for (int j = 0; j < 2; ++j) x[r][j] = *(const u32x4*)(X + (size_t)(m0 + r * mstride) * DM + 8 * lane + 512 * j);
    f32x4 gg[2][2];
#pragma unroll
    for (int j = 0; j < 2; ++j) { gg[j][0] = *(const f32x4*)(gain + 8 * lane + 512 * j); gg[j][1] = *(const f32x4*)(gain + 8 * lane + 512 * j + 4); }
#pragma unroll
    for (int r = 0; r < RB; ++r) {
        float v[2][8]; float s2 = 0.f;
#pragma unroll
        for (int j = 0; j < 2; ++j) { const u32x4 a = x[r][j]; v[j][0] = bflo(a.x); v[j][1] = bfhi(a.x); v[j][2] = bflo(a.y); v[j][3] = bfhi(a.y); v[j][4] = bflo(a.z); v[j][5] = bfhi(a.z); v[j][6] = bflo(a.w); v[j][7] = bfhi(a.w);
#pragma unroll
            for (int c = 0; c < 8; ++c) s2 += v[j][c] * v[j][c]; }
        const float rstd = __builtin_amdgcn_rsqf(wave_sum(s2) * (1.0f / DM) + RMS_EPS);
        if constexpr (FP8OUT) { unsigned char* orow = (unsigned char*)Uv + (size_t)(m0 + r * mstride) * DM; const float rs = rstd * FP8_ASCALE;
#pragma unroll
            for (int j = 0; j < 2; ++j) { u32x2 o; o.x = pk4_fp8(v[j][0] * rs * gg[j][0][0], v[j][1] * rs * gg[j][0][1], v[j][2] * rs * gg[j][0][2], v[j][3] * rs * gg[j][0][3]);
                o.y = pk4_fp8(v[j][4] * rs * gg[j][1][0], v[j][5] * rs * gg[j][1][1], v[j][6] * rs * gg[j][1][2], v[j][7] * rs * gg[j][1][3]); *(u32x2*)(orow + 8 * lane + 512 * j) = o; } }
        else { bf16_t* orow = U + (size_t)(m0 + r * mstride) * DM;
#pragma unroll
        for (int j = 0; j < 2; ++j) { u32x4 o; o.x = pk2(v[j][0] * rstd * gg[j][0][0], v[j][1] * rstd * gg[j][0][1]); o.y = pk2(v[j][2] * rstd * gg[j][0][2], v[j][3] * rstd * gg[j][0][3]);
            o.z = pk2(v[j][4] * rstd * gg[j][1][0], v[j][5] * rstd * gg[j][1][1]); o.w = pk2(v[j][6] * rstd * gg[j][1][2], v[j][7] * rstd * gg[j][1][3]); *(u32x4*)(orow + 8 * lane + 512 * j) = o; } }
    }
}

__global__ void __launch_bounds__(NTHR, 2) trunk_fwd(Args args) {
    extern __shared__ __attribute__((aligned(16))) unsigned char lds_raw[];
    Frame F;
    F.lds = (LAS unsigned char*)lds_raw;
    F.tid = threadIdx.x; F.lane = F.tid & 63; F.wave = __builtin_amdgcn_readfirstlane(F.tid >> 6);
    F.G = gridDim.x; F.wg = blockIdx.x; F.ws = args.ws; F.in = args.in; F.out = args.out;
    unsigned char* ws = args.ws;
    volatile LAS unsigned* MISC = (volatile LAS unsigned*)(F.lds + LDSCTL_OFF);
    for (int u = F.tid; u < (LDS_BYTES - LDSCTL_OFF) / 4; u += NTHR) ((LAS unsigned*)(F.lds + LDSCTL_OFF))[u] = 0u;
    __syncthreads();
    unsigned* ctl = (unsigned*)(ws + WS_CTL);
    XcdBarrier bar; bar.bar = ctl + CW_BAR + args.li * 4096; bar.x = 0; bar.st = nullptr;
    if (!MK_MULTI) bar = xcd_barrier_post(ctl + CW_BAR + args.li * 4096, MISC + 8);
    const int lo = args.ph_lo, hi_ = args.ph_hi;
#define IN(k) (lo <= (k) && (k) < hi_)
#define EN(g) (((PHMASK) >> (g)) & 1u)
#define NREP(g) ((((PROBE_DUP) >> (g)) & 1u) && L == 0 ? 2 : 1)
#define NREPX(g) ((((PROBE_DUP) >> (g)) & 1u) ? 2 : 1)
#define SEAM(k) SEAM_(k, 0)
#define SEAM_(k, MP) do { if (IN(k) && IN((k) + 1)) { if (MP && ((PROBE_MEAN >> (k)) & 1ull)) { const unsigned own_ = (unsigned)__builtin_amdgcn_s_memrealtime() - tprev_; if (threadIdx.x == 0) __hip_atomic_store(ctl + 16384 + (k) * 256 + F.wg, own_, RLX_AGENT); } \
        if ((PROBE_TM >> (k)) & 1ull) { const unsigned t1_ = (unsigned)__builtin_amdgcn_s_memrealtime(); while ((unsigned)__builtin_amdgcn_s_memrealtime() - t1_ < t1_ - tprev_) __builtin_amdgcn_s_sleep(8); } \
        xcd_barrier(bar); if (PROBE_BAR) xcd_barrier(bar); if ((PROBE_SLP >> (k)) & 1ull) { const unsigned t2_ = (unsigned)__builtin_amdgcn_s_memrealtime(); while ((unsigned)__builtin_amdgcn_s_memrealtime() - t2_ < 10000u) __builtin_amdgcn_s_sleep(8); } if (MP && ((PROBE_MEAN >> (k)) & 1ull)) { unsigned sm_ = 0u; int l0_ = (int)(threadIdx.x & 63); asm volatile("" : "+v"(l0_)); for (int j_ = l0_; j_ < 256; j_ += 64) sm_ += __hip_atomic_load(ctl + 16384 + (k) * 256 + j_, RLX_AGENT); \
            for (int o_ = 1; o_ < 64; o_ <<= 1) sm_ += __shfl_xor(sm_, o_); const unsigned mean_ = sm_ >> 8, t3_ = (unsigned)__builtin_amdgcn_s_memrealtime(); while ((unsigned)__builtin_amdgcn_s_memrealtime() - t3_ < mean_) __builtin_amdgcn_s_sleep(8); } \
        if (PROBE_TM != 0ull || PROBE_MEAN != 0ull) tprev_ = (unsigned)__builtin_amdgcn_s_memrealtime(); } } while (0)
    unsigned tprev_ = (PROBE_TM != 0ull || PROBE_MEAN != 0ull) ? (unsigned)__builtin_amdgcn_s_memrealtime() : 0u;
    const int NGW = F.G * NWAVES;
#define LAUNDER int tid_l_ = threadIdx.x; asm volatile("" : "+v"(tid_l_)); const int tid = tid_l_, lane = tid & 63, wave = __builtin_amdgcn_readfirstlane(tid >> 6), gw = F.wg * NWAVES + wave; (void)gw; (void)lane; (void)wave;

    if (EN(0) && IN(0)) { LAUNDER;
        LAS float* scr = (LAS float*)(F.lds + wave * 16384);
        for (int rep = 0; rep < NREPX(0); ++rep) for (int L = 0; L < 2; ++L) {
            conv_inproj(args.in[I_WIN] + (size_t)L * DM * IN_W, (bf16_t*)(ws + WS_WIN) + (size_t)L * INP * DM, scr, gw, NGW, lane);
            for (int kv = 0; kv < 2; ++kv) conv_plain(args.in[I_CW1] + (size_t)(L * 2 + kv) * 2048 * 256, 2048, 256, (bf16_t*)(ws + WS_WC1) + (size_t)(L * 2 + kv) * 256 * 2048, scr, gw, NGW, lane);
            conv_plain(args.in[I_WOUT] + (size_t)L * DM * DM, DM, DM, (bf16_t*)(ws + WS_WO) + (size_t)L * DM * DM, scr, gw, NGW, lane);
            for (int kv = 0; kv < 2; ++kv) conv_plain(args.in[I_CW2] + (size_t)(L * 2 + kv) * 256 * 64, 256, 64, (bf16_t*)(ws + WS_WC2) + (size_t)(L * 2 + kv) * 64 * 256, scr, gw, NGW, lane);
        }
        conv_gateup_f8(args.in[I_FG], args.in[I_FU], DM, DFF, ws + WS_WF1, scr, gw, NGW, lane);
        conv_plain<true>(args.in[I_FD], DFF, DM, ws + WS_WF2, scr, gw, NGW, lane);
        { int* rowtok = (int*)(ws + RT_ROWTOK); for (int k = F.wg * NTHR + tid; k < MOE_ROWS_MAX; k += F.G * NTHR) rowtok[k] = -1; }
        { LAS float* bsh = (LAS float*)(F.lds + 8 * 16384);
          if (wave == 0) { const float* rb = args.in[I_RELB]; float bm = 0.f;
              for (int k = lane; k < 512; k += 64) bm = fmaxf(bm, fabsf(rb[k]));
              for (int L = 0; L < 2; ++L) { float gq = fmaxf(fabsf(args.in[I_QN][L * 64 + lane]), fabsf(args.in[I_DQN][L * 64 + lane]));
                  float gk = fmaxf(fmaxf(fabsf(args.in[I_KN][L * 192 + lane]), fabsf(args.in[I_KN][L * 192 + 64 + lane])), fmaxf(fabsf(args.in[I_KN][L * 192 + 128 + lane]), fabsf(args.in[I_DKN][L * 64 + lane])));
                  float bb = bm;
#pragma unroll
                  for (int o = 1; o < 64; o <<= 1) { gq = fmaxf(gq, __shfl_xor(gq, o)); gk = fmaxf(gk, __shfl_xor(gk, o)); bb = fmaxf(bb, __shfl_xor(bb, o)); }
                  const float B = (8.0f * LOG2E * gq * gk + LOG2E * bb) * 1.002f + 0.05f;
                  if (lane == 0) { bsh[L] = B; if (F.wg == 0) ((float*)(ws + WS_BSH))[L] = B; } } }
          __syncthreads();
          float* LUT = (float*)(ws + WS_LUT); const float* rb = args.in[I_RELB];
          for (int k = F.wg * NTHR + tid; k < 2 * 16 * LUTN; k += F.G * NTHR) { const int L = k / (16 * LUTN), h = (k / LUTN) & 15, d = k % LUTN; int bk;
              if (d < 16) bk = d; else { bk = 16; bk += (d >= 22); bk += (d >= 30); bk += (d >= 40); bk += (d >= 54); bk += (d >= 73); bk += (d >= 99); bk += (d >= 134); bk += (d >= 182);
                  bk += (d >= 246); bk += (d >= 332); bk += (d >= 450); bk += (d >= 609); bk += (d >= 825); bk += (d >= 1117); bk += (d >= 1513); }
              LUT[k] = rb[bk * 16 + h] * LOG2E - bsh[L]; } }
        { float* B1P = (float*)(ws + WS_B1P);
          for (int it = gw; it < 2 * 2 * 16 * 4; it += NGW) { const int cg = it & 3, s = (it >> 2) & 15, lk = it >> 6;
              const float* pos = args.in[I_CPOS] + (size_t)lk * 2048 + s * 128; const float* w1 = args.in[I_CW1] + (size_t)lk * 2048 * 256 + (size_t)s * 128 * 256 + cg * 64 + lane;
              float a = 0.f;
              for (int p = 0; p < 128; ++p) a += pos[p] * w1[(size_t)p * 256];
              B1P[((size_t)lk * 16 + s) * 256 + cg * 64 + lane] = a; } }
    }

    for (int L = 0; L < 2; ++L) {
        const int pb = 1 + 10 * L;
        bf16_t* HB = (bf16_t*)(ws + WS_HB);
        if (EN(1) && IN(pb + 0)) { LAUNDER;
            bf16_t* U = (bf16_t*)(ws + WS_U); const float* gain = args.in[I_ANORM] + L * DM;
            if (L == 0) { for (int rep = 0; rep < NREP(1); ++rep) for (int m = gw; m < MTOK; m += 4 * NGW) norm_rows<4>(args.in[I_X], gain, U, m, NGW, lane); }
            else { for (int m = gw; m < MTOK; m += 4 * NGW) norm_rows_b<4>(HB, gain, U, m, NGW, lane); }
        }
        SEAM(pb + 0);
        if (EN(2) && IN(pb + 1)) {
            { LAUNDER;
            if (F.wg == 0) { const int kv = tid >> 8, j = tid & 255; const float* B1P = (const float*)(ws + WS_B1P) + (size_t)(L * 2 + kv) * 16 * 256;
                float a = args.in[I_CB1][(L * 2 + kv) * 256 + j];
                for (int s = 0; s < 16; ++s) a += B1P[s * 256 + j];
                ((float*)(ws + WS_B1E))[(L * 2 + kv) * 256 + j] = a; }
            }
            pg8::Dims g{DM, DM, DM}; pg8::StaticOrder S; S.init(MTOK, INP, F.G, F.wg, ws + WS_U, (bf16_t*)(ws + WS_WIN) + (size_t)L * INP * DM, DM, DM);
            EpiInProj E{ws, args.in[I_QN] + L * 64, args.in[I_KN] + L * 192, args.in[I_DQN] + L * 64, args.in[I_DKN] + L * 64};
            for (int rep = 0; rep < NREP(2); ++rep) pg8::gemm_phase<EpiInProj, pg8::StaticOrder>(F.lds, g, S, E);
        }
        SEAM(pb + 1);
        if (IN(pb + 2)) {
            if (F.wg < 32) {
                if (EN(3)) {
                    pg8::Dims g{2048, 1024, 2048}; SchedCmp S{F.wg, (const char*)(ws + WS_KC), (const char*)(ws + WS_VC), (const char*)((bf16_t*)(ws + WS_WC1) + (size_t)L * 2 * 256 * 2048)};
                    EpiCmp1 E{(bf16_t*)(ws + WS_HC), (const float*)(ws + WS_B1E) + L * 2 * 256};
                    pg8::gemm_phase<EpiCmp1, SchedCmp>(F.lds, g, S, E);
                }
                if (EN(4)) { LAUNDER;
                    asm volatile("s_waitcnt vmcnt(0)" ::: "memory"); __syncthreads();
                    __builtin_amdgcn_fence(__ATOMIC_ACQUIRE, "agent"); asm volatile("s_waitcnt vmcnt(0)" ::: "memory");
                    const bf16_t* HC = (const bf16_t*)(ws + WS_HC);
                    const int kv = F.wg >> 4, row0 = kv * 4096 + (F.wg & 15) * 256 + wave * 32, r32 = lane & 31, hi = lane >> 5;
                    const bf16_t* hrow = HC + (size_t)(row0 + r32) * 256 + hi * 8;
                    const bf16_t* wT = (const bf16_t*)(ws + WS_WC2) + (size_t)(L * 2 + kv) * 64 * 256 + (size_t)r32 * 256 + hi * 8;
                    f32x16 o0, o1;
#pragma unroll
                    for (int r = 0; r < 16; ++r) { o0[r] = 0.f; o1[r] = 0.f; }
#pragma unroll
                    for (int sk = 0; sk < 16; ++sk) { const bf16x8 bf = *(const bf16x8*)(hrow + 16 * sk), a0 = *(const bf16x8*)(wT + 16 * sk), a1 = *(const bf16x8*)(wT + 32 * 256 + 16 * sk);
                        o0 = mfma32(a0, bf, o0); o1 = mfma32(a1, bf, o1); }
                    if (kv == 0) { float ss = 0.f;
#pragma unroll
                        for (int r = 0; r < 16; ++r) ss += o0[r] * o0[r] + o1[r] * o1[r];
                        ss += __shfl_xor(ss, 32); const float rs = __builtin_amdgcn_rsqf(ss * (1.0f / 64.0f) + RMS_EPS); const float* gn = args.in[I_KN] + L * 192;
#pragma unroll
                        for (int r = 0; r < 16; ++r) { const int d = (r & 3) + 8 * (r >> 2) + 4 * hi; o0[r] *= rs * gn[d]; o1[r] *= rs * gn[d + 32]; } }
                    const int rr = (row0 + r32) & 4095; const float z = ((rr & 255) == 255) ? 0.f : 1.f;
                    bf16_t* dst = (bf16_t*)(ws + (kv ? WS_VCC : WS_KCC)) + (size_t)rr * 64 + 4 * hi;
#pragma unroll
                    for (int g4 = 0; g4 < 4; ++g4) { u32x2 v; v.x = pk2(o0[4 * g4] * z, o0[4 * g4 + 1] * z); v.y = pk2(o0[4 * g4 + 2] * z, o0[4 * g4 + 3] * z); *(u32x2*)(dst + 8 * g4) = v;
                        u32x2 w2; w2.x = pk2(o1[4 * g4] * z, o1[4 * g4 + 1] * z); w2.y = pk2(o1[4 * g4 + 2] * z, o1[4 * g4 + 3] * z); *(u32x2*)(dst + 32 + 8 * g4) = w2; }
                }
            } else if (EN(6)) {
                for (int k = 0; k < DIL_EARLY; ++k) dil_unit(F, L, (F.wg - 32) * DIL_EARLY + k);
                __syncthreads();
            }
        }
        SEAM(pb + 2);
        if (IN(pb + 4)) {
            if (EN(5) && F.wg < 512) nsa_prepare(F, L, F.wg & 1);
            if (EN(5)) for (int rep = 0; rep < NREP(5); ++rep) for (int p = F.wg; p < 512; p += F.G) { const int bg = (p & 7) + 8 * (p >> 8), s = (p >> 3) & 31; nsa_unit(F, L, bg >> 1, bg & 1, s); nsa_unit(F, L, bg >> 1, bg & 1, 63 - s); }
            if (EN(6)) for (int rep = 0; rep < NREP(6); ++rep) for (int u = (F.G - 32) * DIL_EARLY + F.wg; u < 3072; u += F.G) dil_unit(F, L, u);
            __syncthreads();
        }
        SEAM_(pb + 4, 1);
        if (EN(7) && IN(pb + 5)) { LAUNDER;
            bf16_t* ON = (bf16_t*)(ws + WS_U); const float* og = args.in[I_ONORM] + L * DM;
            const bf16_t* OA = (const bf16_t*)(ws + WS_OA); const bf16_t* OB = (const bf16_t*)(ws + WS_OB); const float* LSE = (const float*)(ws + WS_LSE);
            const f32x4 ga0 = *(const f32x4*)(og + 8 * lane), ga1 = *(const f32x4*)(og + 8 * lane + 4), gb0 = *(const f32x4*)(og + 512 + 8 * lane), gb1 = *(const f32x4*)(og + 512 + 8 * lane + 4);
            const int hd = lane >> 3;
            for (int rep = 0; rep < NREP(7); ++rep) for (int mb = gw; mb < MTOK; mb += 4 * NGW) {
                u32x4 xa[4], x0[4], x1[4], x2[4]; float q0[4], q1[4], q2[4];
#pragma unroll
                for (int r = 0; r < 4; ++r) { const size_t m = (size_t)(mb + r * NGW);
                    xa[r] = *(const u32x4*)(OA + m * 512 + 8 * lane);
                    x0[r] = *(const u32x4*)(OB + ((size_t)0 * MTOK + m) * 512 + 8 * lane); x1[r] = *(const u32x4*)(OB + ((size_t)1 * MTOK + m) * 512 + 8 * lane); x2[r] = *(const u32x4*)(OB + ((size_t)2 * MTOK + m) * 512 + 8 * lane);
                    q0[r] = LSE[((size_t)0 * MTOK + m) * 8 + hd]; q1[r] = LSE[((size_t)1 * MTOK + m) * 8 + hd]; q2[r] = LSE[((size_t)2 * MTOK + m) * 8 + hd]; }
#pragma unroll
                for (int r = 0; r < 4; ++r) { const size_t m = (size_t)(mb + r * NGW);
                    { const u32x4 a = xa[r];
                      float v[8] = {bflo(a.x), bfhi(a.x), bflo(a.y), bfhi(a.y), bflo(a.z), bfhi(a.z), bflo(a.w), bfhi(a.w)};
                      float s2 = 0.f;
#pragma unroll
                      for (int c = 0; c < 8; ++c) s2 += v[c] * v[c];
                      const float rstd = __builtin_amdgcn_rsqf(wave_sum(s2) * (1.0f / 512.0f) + RMS_EPS);
                      u32x4 o; o.x = pk2(v[0] * rstd * ga0[0], v[1] * rstd * ga0[1]); o.y = pk2(v[2] * rstd * ga0[2], v[3] * rstd * ga0[3]); o.z = pk2(v[4] * rstd * ga1[0], v[5] * rstd * ga1[1]); o.w = pk2(v[6] * rstd * ga1[2], v[7] * rstd * ga1[3]);
                      *(u32x4*)(ON + m * DM + 8 * lane) = o; }
                    { const float l0 = q0[r], l1 = q1[r], l2 = q2[r];
                      const float mx = fmaxf(l0, fmaxf(l1, l2)); const float e0 = __expf(l0 - mx), e1 = __expf(l1 - mx), e2 = __expf(l2 - mx); const float inv = __builtin_amdgcn_rcpf(e0 + e1 + e2);
                      const float w0 = e0 * inv, w1 = e1 * inv, w2 = e2 * inv;
                      const u32x4 a0 = x0[r], a1 = x1[r], a2 = x2[r];
                      float v[8];
                      v[0] = w0 * bflo(a0.x) + w1 * bflo(a1.x) + w2 * bflo(a2.x); v[1] = w0 * bfhi(a0.x) + w1 * bfhi(a1.x) + w2 * bfhi(a2.x);
                      v[2] = w0 * bflo(a0.y) + w1 * bflo(a1.y) + w2 * bflo(a2.y); v[3] = w0 * bfhi(a0.y) + w1 * bfhi(a1.y) + w2 * bfhi(a2.y);
                      v[4] = w0 * bflo(a0.z) + w1 * bflo(a1.z) + w2 * bflo(a2.z); v[5] = w0 * bfhi(a0.z) + w1 * bfhi(a1.z) + w2 * bfhi(a2.z);
                      v[6] = w0 * bflo(a0.w) + w1 * bflo(a1.w) + w2 * bflo(a2.w); v[7] = w0 * bfhi(a0.w) + w1 * bfhi(a1.w) + w2 * bfhi(a2.w);
                      float s2 = 0.f;
#pragma unroll
                      for (int c = 0; c < 8; ++c) s2 += v[c] * v[c];
                      const float rstd = __builtin_amdgcn_rsqf(wave_sum(s2) * (1.0f / 512.0f) + RMS_EPS);
                      u32x4 o; o.x = pk2(v[0] * rstd * gb0[0], v[1] * rstd * gb0[1]); o.y = pk2(v[2] * rstd * gb0[2], v[3] * rstd * gb0[3]); o.z = pk2(v[4] * rstd * gb1[0], v[5] * rstd * gb1[1]); o.w = pk2(v[6] * rstd * gb1[2], v[7] * rstd * gb1[3]);
                      *(u32x4*)(ON + m * DM + 512 + 8 * lane) = o; }
                }
            }
        }
        SEAM(pb + 5);
        if (EN(8) && IN(pb + 6)) {
            pg8::Dims g{DM, DM, DM}; pg8::StaticOrder S; S.init(MTOK, DM, F.G, F.wg, ws + WS_U, (bf16_t*)(ws + WS_WO) + (size_t)L * DM * DM, DM, DM);
            if (L == 0) { EpiRes<true> E{args.in[I_X], HB}; for (int rep = 0; rep < NREP(8); ++rep) pg8::gemm_phase<EpiRes<true>, pg8::StaticOrder>(F.lds, g, S, E); }
            else { EpiRes<false> E{HB, HB}; pg8::gemm_phase<EpiRes<false>, pg8::StaticOrder>(F.lds, g, S, E); }
        }
        SEAM(pb + 6);
        if (EN(9) && IN(pb + 7)) { LAUNDER;
            bf16_t* U = (bf16_t*)(ws + WS_U); const float* gain = args.in[I_FNORM] + L * DM;
            if (L == 0) {
                for (int m = gw; m < MTOK; m += 4 * NGW) norm_rows_b<4, true>(HB, gain, U, m, NGW, lane);
            } else {
                LAS int* lcnt = (LAS int*)(F.lds);
                if (tid < 8) lcnt[tid] = 0;
                __syncthreads();
                const float* rw = args.in[I_RW];
                int* topE = (int*)(ws + RT_TOPE); float* topG = (float*)(ws + RT_TOPG);
                const int per = MTOK / F.G, perw = per / NWAVES;
                for (int q = 0; q < perw; q += 2) { const int m0 = F.wg * per + wave * perw + q;
                    f32x4 v[2][4];
#pragma unroll
                    for (int t2 = 0; t2 < 2; ++t2) norm_row_b(HB + (size_t)(m0 + t2) * DM, gain, (bf16_t*)((unsigned char*)U + (size_t)(m0 + t2) * DM), lane, v[t2]);
                    float lg[2][8];
#pragma unroll
                    for (int t2 = 0; t2 < 2; ++t2)
#pragma unroll
                        for (int e = 0; e < 8; ++e) lg[t2][e] = 0.f;
#pragma unroll
                    for (int j = 0; j < 4; ++j)
#pragma unroll
                        for (int c = 0; c < 4; ++c) { const float* rr = rw + (size_t)(4 * lane + 256 * j + c) * 8; const f32x4 r0 = *(const f32x4*)rr, r1 = *(const f32x4*)(rr + 4);
#pragma unroll
                            for (int t2 = 0; t2 < 2; ++t2) { const float x = v[t2][j][c];
                                lg[t2][0] += x * r0[0]; lg[t2][1] += x * r0[1]; lg[t2][2] += x * r0[2]; lg[t2][3] += x * r0[3]; lg[t2][4] += x * r1[0]; lg[t2][5] += x * r1[1]; lg[t2][6] += x * r1[2]; lg[t2][7] += x * r1[3]; } }
#pragma unroll
                    for (int e = 0; e < 8; ++e) { lg[0][e] = wave_sum(lg[0][e]); lg[1][e] = wave_sum(lg[1][e]); }
#pragma unroll
                    for (int t2 = 0; t2 < 2; ++t2) { const int m = m0 + t2;
                        int e1 = 0; float l1 = lg[t2][0];
#pragma unroll
                        for (int e = 1; e < 8; ++e) if (lg[t2][e] > l1) { l1 = lg[t2][e]; e1 = e; }
                        int e2 = -1; float l2 = -3.0e38f;
#pragma unroll
                        for (int e = 0; e < 8; ++e) if (e != e1 && lg[t2][e] > l2) { l2 = lg[t2][e]; e2 = e; }
                        const float g2 = 1.0f / (1.0f + __expf(l1 - l2)), g1 = 1.0f - g2;
                        if (lane == 0) { topE[m * 2] = e1; topE[m * 2 + 1] = e2; topG[m * 2] = g1; topG[m * 2 + 1] = g2; __hip_atomic_fetch_add(&lcnt[e1], 1, __ATOMIC_RELAXED, __HIP_MEMORY_SCOPE_WORKGROUP); __hip_atomic_fetch_add(&lcnt[e2], 1, __ATOMIC_RELAXED, __HIP_MEMORY_SCOPE_WORKGROUP); } }
                }
                __syncthreads();
                if (tid < 8) ((int*)(ws + RT_CNT))[F.wg * 8 + tid] = lcnt[tid];
            }
        }
        SEAM(pb + 7);
        if (L == 0) {
            if (EN(10) && IN(pb + 8)) {
                pg8::Dims g{DM, DM, DM}; pg8::StaticOrder S; S.init(MTOK, 2 * DFF, F.G, F.wg, ws + WS_U, ws + WS_WF1, DM, DM, 1);
                EpiSwigluF8 E{ws + WS_ACT0, DFF, 0};
                for (int rep = 0; rep < NREP(10); ++rep) pg8::gemm_phase_f8d<EpiSwigluF8, pg8::StaticOrder>(F.lds, g, S, E);
            }
            SEAM(pb + 8);
            if (EN(11) && IN(pb + 9)) {
                pg8::Dims g{DFF, DFF, DFF}; pg8::StaticOrder S; S.init(MTOK, DM, F.G, F.wg, ws + WS_ACT0, ws + WS_WF2, DFF, DFF, 1);
                EpiResF8 E{HB};
                pg8::gemm_phase_f8d<EpiResF8, pg8::StaticOrder>(F.lds, g, S, E);
            }
            SEAM(pb + 9);
        }
    }
    if (EN(12) && IN(19)) { LAUNDER;
        LAS int* lc = (LAS int*)(F.lds);
        LAS int* mybase = lc + 2048;
        LAS int* wcnt = mybase + 8;
        LAS int* posl = wcnt + 32;
        const int* cnt = (const int*)(ws + RT_CNT);
        const int nwg = F.G;
        for (int k = tid; k < nwg * 8; k += NTHR) lc[k] = cnt[k];
        __syncthreads();
        if (tid < 8) { int tot = 0, before = 0; for (int w2 = 0; w2 < nwg; ++w2) { if (w2 == F.wg) before = tot; tot += lc[w2 * 8 + tid]; } wcnt[tid] = tot; mybase[tid] = before; }
        __syncthreads();
        if (tid == 0) { int ps = 0; int pst[9]; for (int e = 0; e < 8; ++e) { pst[e] = ps; ps += (wcnt[e] + 255) & ~255; } pst[8] = ps;
            for (int e = 0; e < 8; ++e) mybase[e] += pst[e];
            if (F.wg == 0) { int* P = (int*)(ws + RT_PSTART); for (int e = 0; e < 9; ++e) P[e] = pst[e]; P[9] = ps >> 8; } }
        __syncthreads();
        const int per = MTOK / F.G;
        const int* topE = (const int*)(ws + RT_TOPE); const float* topG = (const float*)(ws + RT_TOPG);
        int myE = -1, myTok = 0; float myG = 0.f; int rank = 0;
        if (tid < 2 * per) { myTok = F.wg * per + (tid >> 1); myE = topE[myTok * 2 + (tid & 1)]; myG = topG[myTok * 2 + (tid & 1)]; }
        if (wave < 4) {
#pragma unroll
            for (int e = 0; e < 8; ++e) { const unsigned long long bm = __ballot(myE == e); if (myE == e) rank = __popcll(bm & ((1ull << lane) - 1ull)); if (lane == 0) wcnt[wave * 8 + e] = __popcll(bm); }
        }
        __syncthreads();
        if (tid < 2 * per) { int pos = mybase[myE] + rank; for (int w2 = 0; w2 < wave; ++w2) pos += wcnt[w2 * 8 + myE];
            ((int*)(ws + RT_ROWTOK))[pos] = myTok; ((float*)(ws + RT_ROWGATE))[pos] = myG; posl[tid] = pos; ((int*)(ws + RT_TOKPOS))[myTok * 2 + (tid & 1)] = pos; }
        __syncthreads();
        const bf16_t* U = (const bf16_t*)(ws + WS_U); bf16_t* VS = (bf16_t*)(ws + WS_VSORT);
        for (int a = wave; a < 2 * per; a += NWAVES) { const int tok = F.wg * per + (a >> 1), pos = posl[a];
            const u32x4* src = (const u32x4*)((const unsigned char*)U + (size_t)tok * DM); u32x4* dst = (u32x4*)(VS + (size_t)pos * DM);
            dst[lane] = src[lane]; }
    }
    __syncthreads();
    if (EN(13) && IN(20)) { LAUNDER;
        LAS float* scr = (LAS float*)(F.lds + wave * 16384);
        for (int rep = 0; rep < NREPX(13); ++rep) for (int e = 0; e < NEXP; ++e) {
            conv_gateup_f8(args.in[I_EG] + (size_t)e * DM * DFE, args.in[I_EU] + (size_t)e * DM * DFE, DM, DFE, ws + WS_WE1 + (size_t)e * 7168 * DM, scr, gw, NGW, lane);
            conv_plain<true>(args.in[I_ED] + (size_t)e * DFE * DM, DFE, DM, ws + WS_WE2 + (size_t)e * DM * DFE, scr, gw, NGW, lane);
        }
    }
    SEAM(20);
    for (int gi = 0; gi < MOE_NG; ++gi) {
        const int* P = (const int*)(ws + RT_PSTART);
        if (EN(14) && IN(21 + 2 * gi)) {
            const int nchunks = __builtin_amdgcn_readfirstlane(P[9]);
            pg8::Dims g{DM, 2 * DM, DM}; SchedMoe1 S{F.wg, F.G, gi * MOE_GROUP, MOE_GROUP, nchunks, P, (const char*)(ws + WS_VSORT), (const char*)(ws + WS_WE1)};
            EpiSwigluF8 E{(unsigned char*)args.out, DFE, gi * MOE_GROUP};
            for (int rep = 0; rep < NREPX(14); ++rep) pg8::gemm_phase_f8d<EpiSwigluF8, SchedMoe1>(F.lds, g, S, E);
        }
        SEAM(21 + 2 * gi);
        if (EN(15) && IN(22 + 2 * gi)) {
            const int nchunks = __builtin_amdgcn_readfirstlane(P[9]);
            { pg8::Dims g{DFE, DFE, DFE}; SchedMoe2 S{F.wg, F.G, gi * MOE_GROUP, MOE_GROUP, nchunks, P, (const char*)args.out, (const char*)(ws + WS_WE2)};
              EpiMoe2F8 E{(bf16_t*)(ws + WS_VSORT), gi * MOE_GROUP};
              for (int rep = 0; rep < NREPX(15); ++rep) pg8::gemm_phase_f8d<EpiMoe2F8, SchedMoe2>(F.lds, g, S, E); }
            if (gi == MOE_NG - 1) { pg8::Dims g{DM, 2 * DM, DM}; SchedMoe1 S{F.wg, F.G, 256, nchunks - 256, nchunks, P, (const char*)(ws + WS_VSORT), (const char*)(ws + WS_WE1)};
              EpiSwigluF8 E{ws + WS_U, DFE, 256};
              pg8::gemm_phase_f8d<EpiSwigluF8, SchedMoe1>(F.lds, g, S, E); }
        }
        SEAM(22 + 2 * gi);
    }
    if (EN(16) && IN(21 + 2 * MOE_NG)) {
        const int* P = (const int*)(ws + RT_PSTART); const int nchunks = __builtin_amdgcn_readfirstlane(P[9]), ntail = nchunks - 256, nmoe = 4 * ntail;
        if ((int)F.wg < nmoe) {
            pg8::Dims g{DFE, DFE, DFE}; SchedMoe2 S{F.wg, F.G, 256, ntail, nchunks, P, (const char*)(ws + WS_U), (const char*)(ws + WS_WE2)};
            EpiMoe2F8 E{(bf16_t*)(ws + WS_VSORT), 256};
            pg8::gemm_phase_f8d<EpiMoe2F8, SchedMoe2>(F.lds, g, S, E);
        } else moe_combine(ws, args.out, (F.G - nmoe) * NWAVES, (F.wg - nmoe) * NWAVES, false);
    }
    SEAM(21 + 2 * MOE_NG);
    if (EN(16) && IN(22 + 2 * MOE_NG)) moe_combine(ws, args.out, F.G * NWAVES, F.wg * NWAVES, true);
#undef IN
#undef SEAM
}

constexpr int N_PHASES = 23 + 2 * MOE_NG;

extern "C" void kernel_launch(void* const* d_in, const int* in_sizes, int n_in, void* d_out, int out_size, void* d_ws, size_t ws_size, hipStream_t stream) {
    static int grid = 0;
    if (grid == 0) {
        if (n_in != 22 || out_size != MTOK * DM || ws_size < WS_END) { fprintf(stderr, "kernel_launch: unexpected shapes (n_in %d out %d ws %zu need %zu)\n", n_in, out_size, ws_size, (size_t)WS_END); grid = -1; return; }
        int dev = 0, cus = 0, per_cu = 0;
        if (hipGetDevice(&dev) != hipSuccess || hipDeviceGetAttribute(&cus, hipDeviceAttributeMultiprocessorCount, dev) != hipSuccess) { grid = -1; return; }
        if (hipFuncSetAttribute((const void*)trunk_fwd, hipFuncAttributeMaxDynamicSharedMemorySize, LDS_BYTES) != hipSuccess) { fprintf(stderr, "kernel_launch: hipFuncSetAttribute failed\n"); grid = -1; return; }
        if (hipOccupancyMaxActiveBlocksPerMultiprocessor(&per_cu, (const void*)trunk_fwd, NTHR, LDS_BYTES) != hipSuccess || per_cu < 1) fprintf(stderr, "kernel_launch: occupancy query reports %d\n", per_cu);
        (void)hipGetLastError();
        grid = cus;
        if (grid > 256) grid = 256;
        if (MTOK % (grid * NWAVES) != 0) { fprintf(stderr, "kernel_launch: grid %d unsupported\n", grid); grid = -1; return; }
    }
    if (grid < 0) return;
    if (hipMemsetAsync((char*)d_ws + WS_CTL, 0, CTL_BYTES, stream) != hipSuccess) return;
    Args a{};
    for (int i = 0; i < 22; ++i) a.in[i] = (const float*)d_in[i];
    a.out = (float*)d_out; a.ws = (unsigned char*)d_ws; a.pad = 0;
#if MK_MULTI
    for (int p = 0; p < N_PHASES; ++p) { a.ph_lo = p; a.ph_hi = p + 1; a.li = 0; hipLaunchKernelGGL(trunk_fwd, dim3(grid), dim3(NTHR), LDS_BYTES, stream, a); }
#else
    a.ph_lo = 0; a.ph_hi = N_PHASES; a.li = 0;
    hipLaunchKernelGGL(trunk_fwd, dim3(grid), dim3(NTHR), LDS_BYTES, stream, a);
#endif
}
```

```cpp
#include <hip/hip_runtime.h>
#include <cstdio>
#include <cstdint>

#ifndef PHMASK
#define PHMASK 0xFFFFFFFFu
#endif
#ifndef PROBE_DUP
#define PROBE_DUP 0u
#endif
#ifndef PROBE_NSA
#define PROBE_NSA 0
#endif
#ifndef PROBE_BAR
#define PROBE_BAR 0
#endif
#ifndef PROBE_SLP
#define PROBE_SLP 0x0ull
#endif
#ifndef PROBE_MEAN
#define PROBE_MEAN 0x0ull
#endif
#ifndef PROBE_TM
#define PROBE_TM 0x0ull
#endif
#ifndef MK_MULTI
#define MK_MULTI 0
#endif

#define LAS __attribute__((address_space(3)))
#define GAS __attribute__((address_space(1)))
typedef unsigned short bf16_t;
typedef short bf16x8 __attribute__((ext_vector_type(8)));
typedef short s16x4 __attribute__((ext_vector_type(4)));
typedef float f32x2 __attribute__((ext_vector_type(2)));
typedef float f32x4 __attribute__((ext_vector_type(4)));
typedef float f32x16 __attribute__((ext_vector_type(16)));
typedef unsigned u32x2 __attribute__((ext_vector_type(2)));
typedef unsigned u32x4 __attribute__((ext_vector_type(4)));
typedef __bf16 bf16x2_t __attribute__((ext_vector_type(2)));

constexpr int NB = 8, SEQ = 4096, DM = 1024, MTOK = NB * SEQ;
constexpr int HD = 64;
constexpr int IN_W = 2840, INP = 3072;
constexpr int DFF = 2816, DFE = 3584, NEXP = 8;
constexpr int CMPH = 256;
constexpr float RMS_EPS = 1e-6f;
constexpr float LOG2E = 1.4426950408889634f, LN2 = 0.6931471805599453f;
constexpr float QSCALE = 0.125f * LOG2E;
constexpr float NEGF = -1e30f;
constexpr int LUTN = 1664;
constexpr int NWAVES = 8, NTHR = 512;
constexpr int MOE_ROWS_MAX = (256 + 8) * 256;
constexpr int MOE_GROUP = 128;
constexpr int MOE_NG = 256 / MOE_GROUP;
constexpr int DIL_EARLY = 14;

constexpr size_t MiB = 1u << 20;
constexpr size_t WS_CTL = 0, CTL_BYTES = 1 * MiB;
constexpr size_t WS_LUT = 1 * MiB;
constexpr size_t WS_B1P = 1 * MiB + 224 * 1024;
constexpr size_t WS_B1E = WS_B1P + 2 * 2 * 16 * 256 * 4;
constexpr size_t WS_BSH = WS_B1E + 2 * 2 * 256 * 4;
constexpr size_t WS_WC2 = 1 * MiB + 512 * 1024;
static_assert(2 * 16 * LUTN * 4 <= 224 * 1024, "lut region");
constexpr size_t WS_ROUTE = 2 * MiB;
constexpr size_t RT_ROWTOK = WS_ROUTE;
constexpr size_t RT_ROWGATE = RT_ROWTOK + MOE_ROWS_MAX * 4;
constexpr size_t RT_TOPE = RT_ROWGATE + MOE_ROWS_MAX * 4;
constexpr size_t RT_TOPG = RT_TOPE + MTOK * 2 * 4;
constexpr size_t RT_CNT = RT_TOPG + MTOK * 2 * 4;
constexpr size_t RT_PSTART = RT_CNT + 256 * 8 * 4;
constexpr size_t RT_TOKPOS = RT_PSTART + 64;
static_assert(RT_TOKPOS + MTOK * 2 * 4 <= 4 * MiB, "route region");
constexpr size_t WS_WIN = 4 * MiB;
constexpr size_t WS_WC1 = 16 * MiB;
constexpr size_t WS_WO = 20 * MiB;
constexpr size_t WS_WF1 = 24 * MiB;
constexpr size_t WS_WF2 = 35 * MiB;
constexpr size_t SB = 44 * MiB;
constexpr size_t WS_QA = SB + 0 * MiB;
constexpr size_t WS_KC = SB + 32 * MiB, WS_VC = SB + 40 * MiB, WS_KS = SB + 48 * MiB, WS_VS = SB + 56 * MiB, WS_KW = SB + 64 * MiB, WS_VW = SB + 72 * MiB;
constexpr size_t WS_GATES = SB + 80 * MiB;
constexpr size_t WS_QB = SB + 84 * MiB, WS_KB = SB + 116 * MiB, WS_VB = SB + 148 * MiB;
constexpr size_t WS_KCC = SB + 180 * MiB, WS_VCC = SB + 181 * MiB;
constexpr size_t WS_HC = SB + 182 * MiB;
constexpr size_t WS_SS = WS_HC;
constexpr size_t WS_OA = SB + 186 * MiB;
constexpr size_t WS_SSA = WS_OA;
constexpr size_t WS_RA = WS_OA + 2 * MiB;
constexpr size_t WS_OB = SB + 218 * MiB;
constexpr size_t WS_LSE = SB + 314 * MiB;
constexpr size_t WS_HB = SB + 352 * MiB;
constexpr size_t WS_U = SB + 420 * MiB;
constexpr size_t WS_ACT0 = SB + 0 * MiB;
constexpr size_t WS_WE1 = SB + 0 * MiB;
constexpr size_t WS_WE2 = SB + 112 * MiB;
constexpr size_t WS_TACT = SB + 64 * MiB;
constexpr size_t WS_VSORT = SB + 168 * MiB;
constexpr size_t WS_ACT1 = SB + 300 * MiB;
constexpr size_t WS_END = SB + 484 * MiB;
static_assert((size_t)MOE_GROUP * 256 * DFE <= (size_t)MTOK * DM * 4, "moe act in d_out");
static_assert(WS_LSE + 3 * (size_t)MTOK * 8 * 4 <= WS_U, "attn map");

constexpr int CW_BAR = 4096;
constexpr int CTL_WORDS = (int)(CTL_BYTES / 4);

constexpr int RING_BYTES = 131072;
constexpr int LDSCTL_OFF = RING_BYTES;
constexpr int LDS_BYTES = 147456;

#define RLX_AGENT __ATOMIC_RELAXED, __HIP_MEMORY_SCOPE_AGENT
__device__ __forceinline__ unsigned f2bf(float f) { unsigned u = __builtin_bit_cast(unsigned, f); return (u + 0x7fffu + ((u >> 16) & 1u)) >> 16; }
__device__ __forceinline__ unsigned pk2(float lo, float hi) { f32x2 v = {lo, hi}; bf16x2_t b = __builtin_convertvector(v, bf16x2_t); return __builtin_bit_cast(unsigned, b); }
constexpr float FP8_ASCALE = 8.0f, FP8_WSCALE = 64.0f;
constexpr float FP8_UNSCALE = 1.0f / (FP8_ASCALE * FP8_WSCALE);
__device__ __forceinline__ unsigned pk4_fp8(float a, float b, float c, float d) {
    a = __builtin_amdgcn_fmed3f(a, -448.f, 448.f); b = __builtin_amdgcn_fmed3f(b, -448.f, 448.f); c = __builtin_amdgcn_fmed3f(c, -448.f, 448.f); d = __builtin_amdgcn_fmed3f(d, -448.f, 448.f);
    int w = __builtin_amdgcn_cvt_pk_fp8_f32(a, b, 0, false); w = __builtin_amdgcn_cvt_pk_fp8_f32(c, d, w, true); return (unsigned)w; }
__device__ __forceinline__ float bflo(unsigned u) { return __builtin_bit_cast(float, u << 16); }
__device__ __forceinline__ float bfhi(unsigned u) { return __builtin_bit_cast(float, u & 0xffff0000u); }
#define DPP_ADD(v, ctrl) ((v) + __builtin_bit_cast(float, __builtin_amdgcn_update_dpp(0, __builtin_bit_cast(int, (v)), (ctrl), 0xF, 0xF, true)))
__device__ __forceinline__ float wave_sum(float v) {
    v = DPP_ADD(v, 0xB1); v = DPP_ADD(v, 0x4E); v = DPP_ADD(v, 0x141); v = DPP_ADD(v, 0x140);
    const int iv = __builtin_bit_cast(int, v);
    return (__builtin_bit_cast(float, __builtin_amdgcn_readlane(iv, 0)) + __builtin_bit_cast(float, __builtin_amdgcn_readlane(iv, 16))) + (__builtin_bit_cast(float, __builtin_amdgcn_readlane(iv, 32)) + __builtin_bit_cast(float, __builtin_amdgcn_readlane(iv, 48)));
}
__device__ __forceinline__ float fexp2(float x) { return __builtin_amdgcn_exp2f(x); }
__device__ __forceinline__ float sigmoidf_(float x) { return __builtin_amdgcn_rcpf(1.0f + __builtin_amdgcn_exp2f(-LOG2E * x)); }

#define XB_TMO      128
#define XB_XCNT(j)  (256  + 64 * (j))
#define XB_XSUB(j)  (1280 + 64 * (j))
#define XB_XGEN(j)  (2304 + 64 * (j))
#define XB_TOP      3328
#define XB_TOPGEN   3392
#define XCD_BAR_WORDS 3456
#define XB_SPIN_CAP (1u << 18)
__device__ __forceinline__ unsigned xb_ld(unsigned* p)              { return __hip_atomic_load(p, __ATOMIC_RELAXED, __HIP_MEMORY_SCOPE_AGENT); }
__device__ __forceinline__ unsigned xb_add(unsigned* p, unsigned v) { return __hip_atomic_fetch_add(p, v, __ATOMIC_RELAXED, __HIP_MEMORY_SCOPE_AGENT); }
__device__ __forceinline__ unsigned xb_xcc_id() { return (unsigned)__builtin_amdgcn_s_getreg((3 << 11) | 20) & 0xFu; }
#define XB_SPIN(cond, bar) do { unsigned _sp = 0; while (cond) { __builtin_amdgcn_s_sleep(1); \
    if ((++_sp & 255u) == 0u) { if (xb_ld(&(bar)[XB_TMO])) break; if (_sp > XB_SPIN_CAP) { atomicAdd(&(bar)[XB_TMO], 1u); break; } } } } while (0)
struct XcdBarrier { unsigned* bar; unsigned x; volatile LAS unsigned* st; };
__device__ __forceinline__ XcdBarrier xcd_barrier_post(unsigned* bar, volatile LAS unsigned* st) {
    XcdBarrier b; b.bar = bar; b.x = xb_xcc_id(); b.st = st;
    if (threadIdx.x == 0) (void)xb_add(&bar[XB_XCNT(b.x)], 1u);
    return b;
}
__device__ __forceinline__ void xcd_barrier_complete(unsigned* bar, unsigned x, unsigned& nloc, unsigned& nx) {
    const unsigned G = gridDim.x * gridDim.y * gridDim.z;
    unsigned sum, cnt, mine, sp = 0u;
    for (;;) {
        sum = 0u; cnt = 0u; mine = 0u;
#pragma unroll
        for (unsigned j = 0; j < 16; ++j) { const unsigned c = xb_ld(&bar[XB_XCNT(j)]); sum += c; cnt += (c > 0u) ? 1u : 0u; mine = (j == x) ? c : mine; }
        if (sum == G) break;
        __builtin_amdgcn_s_sleep(1);
        if ((++sp & 255u) == 0u) { if (xb_ld(&bar[XB_TMO])) break; if (sp > XB_SPIN_CAP) { atomicAdd(&bar[XB_TMO], 1u); break; } }
    }
    nloc = mine > 0u ? mine : 1u; nx = cnt > 0u ? cnt : 1u;
}
__device__ __forceinline__ void xcd_barrier(const XcdBarrier& b) {
    asm volatile("s_waitcnt vmcnt(0)" ::: "memory");
    __syncthreads();
    if (threadIdx.x == 0) {
        unsigned* bar = b.bar;
        __builtin_amdgcn_s_waitcnt(0);
        unsigned nloc = b.st[0], nx = b.st[1];
        if (nloc == 0u) { xcd_barrier_complete(bar, b.x, nloc, nx); b.st[0] = nloc; b.st[1] = nx; }
        const unsigned old = xb_add(&bar[XB_XSUB(b.x)], 1u);
        const unsigned gen = old / nloc;
        if (old + 1u == (gen + 1u) * nloc) {
            __builtin_amdgcn_fence(__ATOMIC_RELEASE, "agent");
            asm volatile("s_waitcnt vmcnt(0)" ::: "memory");
            const unsigned og = xb_add(&bar[XB_TOP], 1u);
            const unsigned tg = og / nx;
            if (og + 1u == (tg + 1u) * nx) xb_add(&bar[XB_TOPGEN], 1u);
            else XB_SPIN(xb_ld(&bar[XB_TOPGEN]) == tg, bar);
            __builtin_amdgcn_fence(__ATOMIC_ACQUIRE, "agent");
            xb_add(&bar[XB_XGEN(b.x)], 1u);
            asm volatile("s_waitcnt vmcnt(0)" ::: "memory");
        } else {
            XB_SPIN(xb_ld(&bar[XB_XGEN(b.x)]) == gen, bar);
            __builtin_amdgcn_fence(__ATOMIC_ACQUIRE, "agent");
            asm volatile("s_waitcnt vmcnt(0)" ::: "memory");
        }
    }
    __syncthreads();
}

namespace pg8 {
constexpr int BM = 256, BK = 64, HALF = 128, HTB = HALF * BK * 2, STAGE_BYTES = 8 * HTB, NXCD = 8, WGM = 8;
__host__ __device__ __forceinline__ int lds_byte(int r, int c) { const int st = (r >> 4) * 2 + (c >> 5), rr = r & 15, cc = c & 31, ob = rr * 64 + cc * 2; return st * 1024 + (ob ^ (((ob >> 9) & 1) << 5)); }
__host__ __device__ __forceinline__ void stage_rc(int b, int& R, int& C) { const int st = b / 1024, sb = b % 1024, swz = sb ^ (((sb >> 9) & 1) << 5); R = (st >> 1) * 16 + swz / 64; C = (st & 1) * 32 + (swz % 64) / 2; }
__host__ __device__ __forceinline__ int perm32(int rho) { const int n = rho >> 4, i = rho & 15; return 8 * (i >> 2) + 4 * n + (i & 3); }

struct Unit { int pm, pn; const char* A; const char* B; };
struct Dims { int K, lda, ldb; };

template <class Epi, class Sched, bool ALIGN_EPI = true, int SKPN = -1>
__device__ __forceinline__ void gemm_phase(LAS unsigned char* lds, const Dims g, const Sched& S, const Epi& E) {
    int tid_l = threadIdx.x; asm volatile("" : "+v"(tid_l));
    const int tid = tid_l, wid = __builtin_amdgcn_readfirstlane(tid >> 6), lane = tid & 63, wr = wid >> 2, wc = wid & 3, fr = lane & 15, fq = lane >> 4;
    const int K = g.K, nt = K / BK;
    unsigned voffA[2], voffB[2];
#pragma unroll
    for (int i = 0; i < 2; ++i) { int R, C; stage_rc(tid * 16 + i * 8192, R, C); const int Rb = (R & ~31) + perm32(R & 31);
        voffA[i] = (unsigned)(R * g.lda + C) * 2u; voffB[i] = (unsigned)(Rb * g.ldb + C) * 2u; }
    const size_t kstep = (size_t)(BK * 2);
    const size_t hstepA = (size_t)HALF * g.lda * 2, hstepB = (size_t)HALF * g.ldb * 2;
    const unsigned ldsw = (unsigned)wid * 1024u;
    const int aoff = lds_byte(wr * 64 + fr, fq * 8), boff = lds_byte(wc * 32 + fr, fq * 8);
#define PG8_SA(b, h) (((b) * 2 + (h)) * HTB)
#define PG8_SB(b, h) ((4 + (b) * 2 + (h)) * HTB)
#define PG8_STAGE(bufoff, gbase, voff) do { _Pragma("unroll") for (int _i = 0; _i < 2; ++_i) \
        __builtin_amdgcn_global_load_lds((const unsigned*)((const char*)(gbase) + (voff)[_i]), (LAS unsigned*)(lds + (bufoff) + ldsw + _i * 8192), 16, 0, 0); } while (0)
#define PG8_LDA(dst, b, h) do { _Pragma("unroll") for (int m = 0; m < 4; ++m) _Pragma("unroll") for (int k = 0; k < 2; ++k) dst[m][k] = *(const LAS bf16x8*)(lds + PG8_SA(b, h) + aoff + m * 2048 + k * 1024); } while (0)
#define PG8_LDB(dst, b, h) do { _Pragma("unroll") for (int n = 0; n < 2; ++n) _Pragma("unroll") for (int k = 0; k < 2; ++k) dst[n][k] = *(const LAS bf16x8*)(lds + PG8_SB(b, h) + boff + n * 2048 + k * 1024); } while (0)
#define PG8_MMA(ai, bj, At, Bt) do { if (!(SKPN >= 0 && skinny) || ((bj) == 0 && wc == 0)) { __builtin_amdgcn_s_setprio(1); _Pragma("unroll") for (int m = 0; m < 4; ++m) _Pragma("unroll") for (int n = 0; n < 2; ++n) _Pragma("unroll") for (int k = 0; k < 2; ++k) \
        acc[ai][bj][m][n] = __builtin_amdgcn_mfma_f32_16x16x32_bf16(Bt[n][k], At[m][k], acc[ai][bj][m][n], 0, 0, 0); __builtin_amdgcn_s_setprio(0); } } while (0)
#define PG8_WAIT_V(n) asm volatile("s_waitcnt vmcnt(" #n ")" ::: "memory")
#define PG8_WAIT_L(n) asm volatile("s_waitcnt lgkmcnt(" #n ")" ::: "memory")
#define PG8_BAR __builtin_amdgcn_s_barrier()
#define PG8_SCHED __builtin_amdgcn_sched_barrier(0)
    Unit cur, nxt; int ui = 0;
    if (!S.next(0, cur)) return;
    f32x4 acc[2][2][4][2];
#pragma unroll
    for (int a = 0; a < 2; ++a)
#pragma unroll
        for (int b = 0; b < 2; ++b)
#pragma unroll
            for (int m = 0; m < 4; ++m)
#pragma unroll
                for (int n = 0; n < 2; ++n) acc[a][b][m][n] = (f32x4){0.f, 0.f, 0.f, 0.f};
    bf16x8 At[4][2], B0[2][2], B1[2][2];
    bool skinny = (SKPN >= 0) && (cur.pn == SKPN);
    const char* cA = cur.A; const char* cB = cur.B;
    PG8_STAGE(PG8_SB(0, 0), cB, voffB); PG8_STAGE(PG8_SB(0, 1), cB + hstepB, voffB); PG8_STAGE(PG8_SA(0, 0), cA, voffA); PG8_STAGE(PG8_SA(0, 1), cA + hstepA, voffA);
    if (wr == 1) PG8_BAR;
    PG8_WAIT_V(2); PG8_BAR;
    PG8_STAGE(PG8_SB(1, 0), cB + kstep, voffB); PG8_STAGE(PG8_SA(1, 0), cA + kstep, voffA); PG8_STAGE(PG8_SB(1, 1), cB + hstepB + kstep, voffB);
    PG8_WAIT_V(6); PG8_BAR;
    for (;;) {
        const bool has_next = S.next(ui + 1, nxt);
        const char* nA = has_next ? nxt.A : cA; const char* nB = has_next ? nxt.B : cB;
        for (int t = 0; t < nt; t += 2) {
            const bool last = (t == nt - 2);
            const char* a1 = cA + (size_t)(t + 1) * kstep;
            const char* a2 = last ? nA : cA + (size_t)(t + 2) * kstep; const char* b2 = last ? nB : cB + (size_t)(t + 2) * kstep;
            const char* a3 = a2 + kstep; const char* b3 = b2 + kstep;
            PG8_LDB(B0, 0, 0); PG8_LDB(B1, 0, 1); PG8_SCHED; PG8_LDA(At, 0, 0); PG8_STAGE(PG8_SA(1, 1), a1 + hstepA, voffA);
            PG8_WAIT_V(8); PG8_WAIT_L(0); PG8_BAR; PG8_MMA(0, 0, At, B0); PG8_MMA(0, 1, At, B1); PG8_BAR; PG8_SCHED;
            PG8_LDA(At, 0, 1); PG8_STAGE(PG8_SB(0, 0), b2, voffB); PG8_STAGE(PG8_SB(0, 1), b2 + hstepB, voffB); PG8_STAGE(PG8_SA(0, 0), a2, voffA);
            PG8_WAIT_V(8); PG8_WAIT_L(0); PG8_BAR; PG8_MMA(1, 0, At, B0); PG8_MMA(1, 1, At, B1); PG8_BAR; PG8_SCHED;
            PG8_LDB(B0, 1, 0); PG8_LDB(B1, 1, 1); PG8_SCHED; PG8_LDA(At, 1, 0); PG8_STAGE(PG8_SA(0, 1), a2 + hstepA, voffA);
            PG8_WAIT_V(8); PG8_WAIT_L(0); PG8_BAR; PG8_MMA(0, 0, At, B0); PG8_MMA(0, 1, At, B1); PG8_BAR; PG8_SCHED;
            PG8_LDA(At, 1, 1); PG8_STAGE(PG8_SB(1, 0), b3, voffB); PG8_STAGE(PG8_SB(1, 1), b3 + hstepB, voffB); PG8_STAGE(PG8_SA(1, 0), a3, voffA);
            PG8_WAIT_V(8); PG8_WAIT_L(0); PG8_BAR; PG8_MMA(1, 0, At, B0); PG8_MMA(1, 1, At, B1); PG8_BAR; PG8_SCHED;
        }
        if (ALIGN_EPI) { if (wr == 0) PG8_BAR; }
        E(acc, cur, wr, wc, fr, fq);
        if (!has_next) break;
#pragma unroll
        for (int a = 0; a < 2; ++a)
#pragma unroll
            for (int b = 0; b < 2; ++b)
#pragma unroll
                for (int m = 0; m < 4; ++m)
#pragma unroll
                    for (int n = 0; n < 2; ++n) acc[a][b][m][n] = (f32x4){0.f, 0.f, 0.f, 0.f};
        cur = nxt; cA = nA; cB = nB; ++ui; skinny = (SKPN >= 0) && (cur.pn == SKPN);
        if (ALIGN_EPI) { if (wr == 1) PG8_BAR; }
    }
    PG8_WAIT_V(0);
    if (!ALIGN_EPI) { if (wr == 0) PG8_BAR; }
    PG8_BAR;
#undef PG8_SA
#undef PG8_SB
#undef PG8_STAGE
#undef PG8_LDA
#undef PG8_LDB
#undef PG8_MMA
#undef PG8_WAIT_V
#undef PG8_WAIT_L
#undef PG8_BAR
#undef PG8_SCHED
}

typedef int v8i_t __attribute__((ext_vector_type(8)));
typedef int v4i_t __attribute__((ext_vector_type(4)));
template <class Epi, class Sched>
__device__ __forceinline__ void gemm_phase_f8(LAS unsigned char* lds, const Dims g, const Sched& S, const Epi& E) {
    int tid_l = threadIdx.x; asm volatile("" : "+v"(tid_l));
    const int tid = tid_l, wid = __builtin_amdgcn_readfirstlane(tid >> 6), lane = tid & 63, wr = wid >> 2, wc = wid & 3, fr = lane & 15, fq = lane >> 4;
    const int K = g.K, nt = K / 128;
    unsigned voffA[2], voffB[2];
#pragma unroll
    for (int i = 0; i < 2; ++i) { int R, C; stage_rc(tid * 16 + i * 8192, R, C); const int Rb = (R & ~31) + perm32(R & 31);
        voffA[i] = (unsigned)(R * g.lda) + (unsigned)C * 2u; voffB[i] = (unsigned)(Rb * g.ldb) + (unsigned)C * 2u; }
    const size_t kstep = 128, hstepA = (size_t)HALF * g.lda;
    const unsigned ldsw = (unsigned)wid * 1024u;
    const int aoff = lds_byte(wr * 64 + fr, fq * 8), boff = lds_byte(wc * 32 + fr, fq * 8);
#define F8_SA(b, h) (((b) * 2 + (h)) * HTB)
#define F8_SB(b) ((4 + (b) * 2) * HTB)
#define F8_STAGE(bufoff, gbase, voff) do { _Pragma("unroll") for (int _i = 0; _i < 2; ++_i) \
        __builtin_amdgcn_global_load_lds((const unsigned*)((const char*)(gbase) + (voff)[_i]), (LAS unsigned*)(lds + (bufoff) + ldsw + _i * 8192), 16, 0, 0); } while (0)
#define F8_CAT(x, y) __builtin_shufflevector(x, y, 0, 1, 2, 3, 4, 5, 6, 7)
#define F8_LDA(b, h) do { _Pragma("unroll") for (int m = 0; m < 4; ++m) A8[m] = F8_CAT(*(const LAS v4i_t*)(lds + F8_SA(b, h) + aoff + m * 2048), *(const LAS v4i_t*)(lds + F8_SA(b, h) + aoff + m * 2048 + 1024)); } while (0)
#define F8_LDB(b) do { _Pragma("unroll") for (int n = 0; n < 2; ++n) B8[n] = F8_CAT(*(const LAS v4i_t*)(lds + F8_SB(b) + boff + n * 2048), *(const LAS v4i_t*)(lds + F8_SB(b) + boff + n * 2048 + 1024)); } while (0)
#define F8_MMA(ai) do { __builtin_amdgcn_s_setprio(1); _Pragma("unroll") for (int m = 0; m < 4; ++m) _Pragma("unroll") for (int n = 0; n < 2; ++n) \
        acc[ai][m][n] = __builtin_amdgcn_mfma_scale_f32_16x16x128_f8f6f4(B8[n], A8[m], acc[ai][m][n], 0, 0, 0, 0, 0, 0); __builtin_amdgcn_s_setprio(0); } while (0)
#define F8_WAIT_V(n) asm volatile("s_waitcnt vmcnt(" #n ")" ::: "memory")
#define F8_WAIT_L(n) asm volatile("s_waitcnt lgkmcnt(" #n ")" ::: "memory")
#define F8_BAR __builtin_amdgcn_s_barrier()
#define F8_SCHED __builtin_amdgcn_sched_barrier(0)
    Unit cur, nxt; int ui = 0;
    if (!S.next(0, cur)) return;
    f32x4 acc[2][4][2];
#pragma unroll
    for (int a = 0; a < 2; ++a)
#pragma unroll
        for (int m = 0; m < 4; ++m)
#pragma unroll
            for (int n = 0; n < 2; ++n) acc[a][m][n] = (f32x4){0.f, 0.f, 0.f, 0.f};
    v8i_t A8[4], B8[2];
    const char* cA = cur.A; const char* cB = cur.B;
    F8_STAGE(F8_SB(0), cB, voffB); F8_STAGE(F8_SA(0, 0), cA, voffA); F8_STAGE(F8_SA(0, 1), cA + hstepA, voffA);
    if (wr == 1) F8_BAR;
    F8_WAIT_V(2); F8_BAR;
    F8_STAGE(F8_SB(1), cB + kstep, voffB); F8_STAGE(F8_SA(1, 0), cA + kstep, voffA);
    F8_WAIT_V(6); F8_BAR;
    for (;;) {
        const bool has_next = S.next(ui + 1, nxt);
        const char* nA = has_next ? nxt.A : cA; const char* nB = has_next ? nxt.B : cB;
        for (int t = 0; t < nt; t += 2) {
            const bool last = (t == nt - 2);
            const char* a1 = cA + (size_t)(t + 1) * kstep;
            const char* a2 = last ? nA : cA + (size_t)(t + 2) * kstep; const char* b2 = last ? nB : cB + (size_t)(t + 2) * kstep;
            const char* a3 = a2 + kstep; const char* b3 = b2 + kstep;
            F8_LDB(0); F8_SCHED; F8_LDA(0, 0); F8_STAGE(F8_SA(1, 1), a1 + hstepA, voffA);
            F8_WAIT_V(6); F8_WAIT_L(0); F8_BAR; F8_MMA(0); F8_BAR; F8_SCHED;
            F8_LDA(0, 1); F8_STAGE(F8_SB(0), b2, voffB); F8_STAGE(F8_SA(0, 0), a2, voffA);
            F8_WAIT_V(6); F8_WAIT_L(0); F8_BAR; F8_MMA(1); F8_BAR; F8_SCHED;
            F8_LDB(1); F8_SCHED; F8_LDA(1, 0); F8_STAGE(F8_SA(0, 1), a2 + hstepA, voffA);
            F8_WAIT_V(6); F8_WAIT_L(0); F8_BAR; F8_MMA(0); F8_BAR; F8_SCHED;
            F8_LDA(1, 1); F8_STAGE(F8_SB(1), b3, voffB); F8_STAGE(F8_SA(1, 0), a3, voffA);
            F8_WAIT_V(6); F8_WAIT_L(0); F8_BAR; F8_MMA(1); F8_BAR; F8_SCHED;
        }
        if (wr == 0) F8_BAR;
        E(acc, cur, wr, wc, fr, fq);
        if (!has_next) break;
#pragma unroll
        for (int a = 0; a < 2; ++a)
#pragma unroll
            for (int m = 0; m < 4; ++m)
#pragma unroll
                for (int n = 0; n < 2; ++n) acc[a][m][n] = (f32x4){0.f, 0.f, 0.f, 0.f};
        cur = nxt; cA = nA; cB = nB; ++ui;
        if (wr == 1) F8_BAR;
    }
    F8_WAIT_V(0);
    F8_BAR;
#undef F8_SA
#undef F8_SB
#undef F8_STAGE
#undef F8_CAT
#undef F8_LDA
#undef F8_LDB
#undef F8_MMA
#undef F8_WAIT_V
#undef F8_WAIT_L
#undef F8_BAR
#undef F8_SCHED
}

template <class Epi, class Sched, bool GATH = false>
__device__ __forceinline__ void gemm_phase_f8d(LAS unsigned char* lds, const Dims g, const Sched& S, const Epi& E) {
    int tid_l = threadIdx.x; asm volatile("" : "+v"(tid_l));
    const int tid = tid_l, wid = __builtin_amdgcn_readfirstlane(tid >> 6), lane = tid & 63, wr = wid >> 2, wq = wid >> 1, wh = wid & 1, fr = lane & 15, fq = lane >> 4;
    const int K = g.K, nt = K / 128;
    unsigned voffA[2], voffB[2], colA[2]; int rowA[2];
#pragma unroll
    for (int i = 0; i < 2; ++i) { int R, C; stage_rc(tid * 16 + i * 8192, R, C); const int Rb = (R & ~31) + perm32(R & 31); rowA[i] = R; colA[i] = (unsigned)C * 2u;
        voffA[i] = (unsigned)(R * g.lda) + (unsigned)C * 2u; voffB[i] = (unsigned)(Rb * g.ldb) + (unsigned)C * 2u; }
    const size_t hstepA = (size_t)HALF * g.lda, hstepB = (size_t)HALF * g.ldb;
    unsigned vc0[2] = {0u, 0u}, vc1[2] = {0u, 0u}, vn0[2] = {0u, 0u}, vn1[2] = {0u, 0u};
#define FD_GLOAD(d0, d1, un) do { if constexpr (GATH) { _Pragma("unroll") for (int i_ = 0; i_ < 2; ++i_) { const int t0_ = S.rowtok[(un).pm * 256 + rowA[i_]], t1_ = S.rowtok[(un).pm * 256 + 128 + rowA[i_]]; \
        d0[i_] = (unsigned)max(t0_, 0) * 1024u + colA[i_]; d1[i_] = (unsigned)max(t1_, 0) * 1024u + colA[i_]; } } } while (0)
    const unsigned ldsw = (unsigned)wid * 1024u;
    const int aoff = (wq >> 1) * HTB + lds_byte((wq & 1) * 64 + fr, fq * 8), boff = 2 * HTB + lds_byte(wh * 64 + fr, fq * 8);
    constexpr int STG = 4 * HTB;
#define FD_STAGE1(bufoff, gptr, voff) do { const char* gp_ = (const char*)(gptr); asm volatile("" : "+s"(gp_));     \
        _Pragma("unroll") for (int _i = 0; _i < 2; ++_i) \
        __builtin_amdgcn_global_load_lds((const unsigned*)(gp_ + (voff)[_i]), (LAS unsigned*)(lds + (bufoff) + ldsw + _i * 8192), 16, 0, 0); } while (0)
#define FD_STAGE_AB0(sb, pa, pb, NX) do { if constexpr (GATH) { unsigned w0_[2], w1_[2]; _Pragma("unroll") for (int i_ = 0; i_ < 2; ++i_) { w0_[i_] = (NX) ? vn0[i_] : vc0[i_]; w1_[i_] = (NX) ? vn1[i_] : vc1[i_]; } \
            FD_STAGE1((sb), pa, w0_); FD_STAGE1((sb) + HTB, pa, w1_); } else { FD_STAGE1((sb), pa, voffA); FD_STAGE1((sb) + HTB, (pa) + hstepA, voffA); } FD_STAGE1((sb) + 2 * HTB, pb, voffB); } while (0)
#define FD_STAGE_B1(sb, pb) FD_STAGE1((sb) + 3 * HTB, (pb) + hstepB, voffB)
#define FD_CAT(x, y) __builtin_shufflevector(x, y, 0, 1, 2, 3, 4, 5, 6, 7)
#define FD_WAIT_V(n) asm volatile("s_waitcnt vmcnt(" #n ")" ::: "memory")
#define FD_WAIT_L(n) asm volatile("s_waitcnt lgkmcnt(" #n ")" ::: "memory")
#define FD_BAR __builtin_amdgcn_s_barrier()
#define FD_SCHED __builtin_amdgcn_sched_barrier(0)
#define FD_TILEP(base, nbase, tt) (((tt) < nt) ? (base) + (size_t)(tt) * 128 : (nbase) + (size_t)((tt) - nt) * 128)
    Unit cur, nxt; int ui = 0;
    if (!S.next(0, cur)) return;
    f32x4 acc[2][4][4];
#pragma unroll
    for (int p = 0; p < 2; ++p)
#pragma unroll
        for (int m = 0; m < 4; ++m)
#pragma unroll
            for (int n = 0; n < 4; ++n) acc[p][m][n] = (f32x4){0.f, 0.f, 0.f, 0.f};
    v8i_t A8[4], B8[4];
    const char* cA = cur.A; const char* cB = cur.B;
    int sb = 0;
    FD_GLOAD(vc0, vc1, cur);
    FD_STAGE_AB0(0, cA, cB, false); FD_STAGE_B1(0, cB); FD_STAGE_AB0(STG, cA + 128, cB + 128, false);
    if (wr == 1) FD_BAR;
    FD_WAIT_V(8); FD_BAR; FD_BAR;
    for (;;) {
        const bool has_next = S.next(ui + 1, nxt);
        const char* nA = has_next ? nxt.A : cA; const char* nB = has_next ? nxt.B : cB;
        if (has_next) FD_GLOAD(vn0, vn1, nxt);
        _Pragma("unroll 1") for (int t = 0; t < nt; ++t) {
            const int so = STG - sb;
#pragma unroll
            for (int n = 0; n < 4; ++n) B8[n] = FD_CAT(*(const LAS v4i_t*)(lds + sb + boff + n * 2048), *(const LAS v4i_t*)(lds + sb + boff + n * 2048 + 1024));
#pragma unroll
            for (int m = 0; m < 4; ++m) A8[m] = FD_CAT(*(const LAS v4i_t*)(lds + sb + aoff + m * 2048), *(const LAS v4i_t*)(lds + sb + aoff + m * 2048 + 1024));
            { const char* pb = FD_TILEP(cB, nB, t + 1); FD_STAGE_B1(so, pb); }
            FD_WAIT_V(8); FD_WAIT_L(0); FD_BAR;
            __builtin_amdgcn_s_setprio(1);
#pragma unroll
            for (int m = 0; m < 4; ++m)
#pragma unroll
                for (int n = 0; n < 4; ++n) acc[0][m][n] = __builtin_amdgcn_mfma_scale_f32_16x16x128_f8f6f4(B8[n], A8[m], acc[0][m][n], 0, 0, 0, 0, 0, 0);
            __builtin_amdgcn_s_setprio(0);
            FD_BAR; FD_SCHED;
#pragma unroll
            for (int n = 0; n < 4; ++n) B8[n] = FD_CAT(*(const LAS v4i_t*)(lds + sb + HTB + boff + n * 2048), *(const LAS v4i_t*)(lds + sb + HTB + boff + n * 2048 + 1024));
            { const char* pa = FD_TILEP(cA, nA, t + 2); const char* pb = FD_TILEP(cB, nB, t + 2); FD_STAGE_AB0(sb, pa, pb, (t + 2 >= nt)); }
            FD_WAIT_V(8); FD_WAIT_L(0); FD_BAR;
            __builtin_amdgcn_s_setprio(1);
#pragma unroll
            for (int m = 0; m < 4; ++m)
#pragma unroll
                for (int n = 0; n < 4; ++n) acc[1][m][n] = __builtin_amdgcn_mfma_scale_f32_16x16x128_f8f6f4(B8[n], A8[m], acc[1][m][n], 0, 0, 0, 0, 0, 0);
            __builtin_amdgcn_s_setprio(0);
            FD_BAR; FD_SCHED;
            sb = so;
        }
        if (wr == 0) FD_BAR;
        E(acc, cur, wq, wh, fr, fq);
        if (!has_next) break;
#pragma unroll
        for (int p = 0; p < 2; ++p)
#pragma unroll
            for (int m = 0; m < 4; ++m)
#pragma unroll
                for (int n = 0; n < 4; ++n) acc[p][m][n] = (f32x4){0.f, 0.f, 0.f, 0.f};
        cur = nxt; cA = nA; cB = nB; ++ui;
        if constexpr (GATH) { _Pragma("unroll") for (int i_ = 0; i_ < 2; ++i_) { vc0[i_] = vn0[i_]; vc1[i_] = vn1[i_]; } }
        if (wr == 1) FD_BAR;
    }
    FD_WAIT_V(0);
    FD_BAR;
#undef FD_STAGE1
#undef FD_STAGE_AB0
#undef FD_GLOAD
#undef FD_STAGE_B1
#undef FD_CAT
#undef FD_WAIT_V
#undef FD_WAIT_L
#undef FD_BAR
#undef FD_SCHED
#undef FD_TILEP
}

struct StaticOrder {
    int nM, nN, nwg, G, c; const char* A; const char* B; size_t tsA, tsB;
    __device__ void init(int M, int N, int G_, int c_, const void* A_, const void* B_, int lda, int ldb, int es = 2, int bn = BM) { nM = M / BM; nN = N / bn; nwg = nM * nN; G = G_; c = c_; A = (const char*)A_; B = (const char*)B_; tsA = (size_t)BM * lda * es; tsB = (size_t)bn * ldb * es; }
    __device__ bool next(int i, Unit& u) const {
        const long L = (long)i * G + c; if (L >= nwg) return false;
        int wgid = (int)L; { const int q = nwg / NXCD, r = nwg % NXCD, xcd = wgid % NXCD, off = wgid / NXCD; wgid = (xcd < r ? xcd * (q + 1) : r * (q + 1) + (xcd - r) * q) + off; }
        const int nig = WGM * nN, gid = wgid / nig, fm = gid * WGM, gsz = (nM - fm) < WGM ? (nM - fm) : WGM;
        u.pm = fm + ((wgid % nig) % gsz); u.pn = (wgid % nig) / gsz; u.A = A + (size_t)u.pm * tsA; u.B = B + (size_t)u.pn * tsB; return true;
    }
};
}

struct Args {
    const float* in[22]; float* out; unsigned char* ws; int ph_lo, ph_hi, li, pad;
};
enum { I_X = 0, I_RELB, I_ANORM, I_WIN, I_QN, I_KN, I_CPOS, I_CW1, I_CB1, I_CW2, I_DQN, I_DKN, I_ONORM, I_WOUT, I_FNORM, I_FG, I_FU, I_FD, I_RW, I_EG, I_EU, I_ED };

struct Frame {
    LAS unsigned char* lds;
    int tid, lane, wave, G, wg;
    unsigned char* ws; const float* const* in; float* out;
};

struct EpiInProj {
    unsigned char* ws; const float* qn; const float* kn; const float* dqn; const float* dkn;
    const float* ss;
    __device__ __forceinline__ float rstd_of(int row) const { const f32x4 a = *(const f32x4*)(ss + (size_t)row * 8), b = *(const f32x4*)(ss + (size_t)row * 8 + 4); return __builtin_amdgcn_rsqf((((a[0] + a[1]) + (a[2] + a[3])) + ((b[0] + b[1]) + (b[2] + b[3]))) * (1.0f / DM) + RMS_EPS); }
    __device__ __forceinline__ void operator()(const f32x4 (&acc)[2][2][4][2], const pg8::Unit& u, int wr, int wc, int fr, int fq) const {
        const int rowb = u.pm * 256 + wr * 64 + fr;
        if (u.pn == 11) {
            if (wc != 0 || fq >= 3) return;
            float* G = (float*)(ws + WS_GATES);
#pragma unroll
            for (int ai = 0; ai < 2; ++ai)
#pragma unroll
                for (int m = 0; m < 4; ++m) { const int row = rowb + ai * 128 + m * 16; const float rr = ss ? rstd_of(row) : 1.0f;
#pragma unroll
                    for (int n = 0; n < 2; ++n) { f32x4 v = acc[ai][0][m][n] * rr; f32x4 o; o[0] = sigmoidf_(v[0]); o[1] = sigmoidf_(v[1]); o[2] = sigmoidf_(v[2]); o[3] = sigmoidf_(v[3]);
                        *(f32x4*)(G + (size_t)row * 24 + 8 * fq + 4 * n) = o; } }
            return;
        }
        const int vh = 4 * u.pn + wc;
        size_t base; int nh, hidx; const float* gain = nullptr; float scale = 1.f;
        if (vh < 8)       { base = WS_QA; nh = 8; hidx = vh; gain = qn; scale = QSCALE; }
        else if (vh < 20) { const int k = (vh - 8) >> 1; nh = 2; hidx = (vh - 8) & 1;
                            base = (k == 0) ? WS_KC : (k == 1) ? WS_VC : (k == 2) ? WS_KS : (k == 3) ? WS_VS : (k == 4) ? WS_KW : WS_VW;
                            if (k == 2) gain = kn + 64; else if (k == 4) gain = kn + 128; }
        else if (vh < 28) { base = WS_QB; nh = 8; hidx = vh - 20; gain = dqn; scale = QSCALE; }
        else if (vh < 36) { base = WS_KB; nh = 8; hidx = vh - 28; gain = dkn; }
        else              { base = WS_VB; nh = 8; hidx = vh - 36; }
        bf16_t* O = (bf16_t*)(ws + base);
        f32x4 gv[2][2];
#pragma unroll
        for (int bj = 0; bj < 2; ++bj)
#pragma unroll
            for (int n = 0; n < 2; ++n) gv[bj][n] = gain ? *(const f32x4*)(gain + 32 * bj + 8 * fq + 4 * n) : (f32x4){1.f, 1.f, 1.f, 1.f};
#pragma unroll
        for (int ai = 0; ai < 2; ++ai)
#pragma unroll
            for (int m = 0; m < 4; ++m) {
                const int row = rowb + ai * 128 + m * 16, b = row >> 12, t = row & 4095;
                float rs = scale;
                if (!gain && ss) rs = rstd_of(row);
                if (gain) {
                    float ss = 0.f;
#pragma unroll
                    for (int bj = 0; bj < 2; ++bj)
#pragma unroll
                        for (int n = 0; n < 2; ++n) { const f32x4 v = acc[ai][bj][m][n]; ss += (v[0] * v[0] + v[1] * v[1]) + (v[2] * v[2] + v[3] * v[3]); }
                    ss += __shfl_xor(ss, 16); ss += __shfl_xor(ss, 32);
                    rs = scale * __builtin_amdgcn_rsqf(ss * (1.0f / 64.0f) + RMS_EPS);
                }
                bf16_t* dst = O + ((size_t)(b * nh + hidx) * SEQ + t) * 64 + 8 * fq;
#pragma unroll
                for (int bj = 0; bj < 2; ++bj) { const f32x4 v0 = acc[ai][bj][m][0] * gv[bj][0] * rs, v1 = acc[ai][bj][m][1] * gv[bj][1] * rs;
                    u32x4 w; w.x = pk2(v0[0], v0[1]); w.y = pk2(v0[2], v0[3]); w.z = pk2(v1[0], v1[1]); w.w = pk2(v1[2], v1[3]);
                    *(u32x4*)(dst + 32 * bj) = w; }
            }
    }
};
__device__ __forceinline__ float gelu_tanh(float x) { const float y = 0.7978845608028654f * (x + 0.044715f * x * x * x); const float e = __builtin_amdgcn_exp2f((2.f * LOG2E) * y); return x - x * __builtin_amdgcn_rcpf(e + 1.f); }
struct EpiCmp1 {
    bf16_t* HC; const float* b1e;
    __device__ __forceinline__ void operator()(const f32x4 (&acc)[2][2][4][2], const pg8::Unit& u, int wr, int wc, int fr, int fq) const {
        const int kv = u.pm >> 4, bg = u.pm & 15;
        bf16_t* O = HC + ((size_t)kv * 4096 + bg * 256) * 256; const float* bias = b1e + kv * 256;
        const int col0 = wc * 32 + 8 * fq;
#pragma unroll
        for (int ai = 0; ai < 2; ++ai)
#pragma unroll
            for (int m = 0; m < 4; ++m) { const int r = ai * 128 + wr * 64 + m * 16 + fr;
#pragma unroll
                for (int bj = 0; bj < 2; ++bj) { const f32x4 b0 = *(const f32x4*)(bias + col0 + bj * 128), b1 = *(const f32x4*)(bias + col0 + bj * 128 + 4);
                    const f32x4 v0 = acc[ai][bj][m][0] + b0, v1 = acc[ai][bj][m][1] + b1;
                    u32x4 w; w.x = pk2(gelu_tanh(v0[0]), gelu_tanh(v0[1])); w.y = pk2(gelu_tanh(v0[2]), gelu_tanh(v0[3])); w.z = pk2(gelu_tanh(v1[0]), gelu_tanh(v1[1])); w.w = pk2(gelu_tanh(v1[2]), gelu_tanh(v1[3]));
                    *(u32x4*)(O + (size_t)r * 256 + col0 + bj * 128) = w; } }
    }
};
template <bool RESF32> struct EpiRes {
    const void* res; bf16_t* out; const float* ra;
    __device__ __forceinline__ void operator()(const f32x4 (&acc)[2][2][4][2], const pg8::Unit& u, int wr, int wc, int fr, int fq) const {
        const int row0 = u.pm * 256 + wr * 64 + fr, col0 = u.pn * 256 + wc * 32 + 8 * fq;
#pragma unroll
        for (int ai = 0; ai < 2; ++ai)
#pragma unroll
            for (int m = 0; m < 4; ++m) { const size_t ro = (size_t)(row0 + ai * 128 + m * 16) * DM + col0; const float rr = ra[row0 + ai * 128 + m * 16];
#pragma unroll
                for (int bj = 0; bj < 2; ++bj) {
                    f32x4 r0, r1;
                    if (RESF32) { r0 = __builtin_nontemporal_load((const f32x4*)((const float*)res + ro + bj * 128)); r1 = __builtin_nontemporal_load((const f32x4*)((const float*)res + ro + bj * 128 + 4)); }
                    else { const u32x4 rb = *(const u32x4*)((const bf16_t*)res + ro + bj * 128); r0 = (f32x4){bflo(rb.x), bfhi(rb.x), bflo(rb.y), bfhi(rb.y)}; r1 = (f32x4){bflo(rb.z), bfhi(rb.z), bflo(rb.w), bfhi(rb.w)}; }
                    const f32x4 v0 = r0 + acc[ai][bj][m][0] * rr, v1 = r1 + acc[ai][bj][m][1] * rr;
                    u32x4 w; w.x = pk2(v0[0], v0[1]); w.y = pk2(v0[2], v0[3]); w.z = pk2(v1[0], v1[1]); w.w = pk2(v1[2], v1[3]);
                    *(u32x4*)(out + ro + bj * 128) = w; } }
    }
};
__device__ __forceinline__ float silu_mul(float g, float u) { return g * u * __builtin_amdgcn_rcpf(1.0f + __builtin_amdgcn_exp2f(-LOG2E * g)); }
template <bool FP8OUT> struct EpiSwiglu {
    void* Ov; int ldc; int pm0;
    __device__ __forceinline__ void operator()(const f32x4 (&acc)[2][2][4][2], const pg8::Unit& u, int wr, int wc, int fr, int fq) const {
        const int row0 = (u.pm - pm0) * 256 + wr * 64 + fr, col0 = u.pn * 128 + wc * 32 + 8 * fq;
#pragma unroll
        for (int ai = 0; ai < 2; ++ai)
#pragma unroll
            for (int m = 0; m < 4; ++m) { const f32x4 g0 = acc[ai][0][m][0], g1 = acc[ai][0][m][1], u0 = acc[ai][1][m][0], u1 = acc[ai][1][m][1];
                if constexpr (FP8OUT) { const f32x4 s0 = u0 * FP8_ASCALE, s1 = u1 * FP8_ASCALE;
                    u32x2 w; w.x = pk4_fp8(silu_mul(g0[0], s0[0]), silu_mul(g0[1], s0[1]), silu_mul(g0[2], s0[2]), silu_mul(g0[3], s0[3]));
                    w.y = pk4_fp8(silu_mul(g1[0], s1[0]), silu_mul(g1[1], s1[1]), silu_mul(g1[2], s1[2]), silu_mul(g1[3], s1[3]));
                    *(u32x2*)((unsigned char*)Ov + (size_t)(row0 + ai * 128 + m * 16) * ldc + col0) = w; }
                else { u32x4 w; w.x = pk2(silu_mul(g0[0], u0[0]), silu_mul(g0[1], u0[1])); w.y = pk2(silu_mul(g0[2], u0[2]), silu_mul(g0[3], u0[3]));
                    w.z = pk2(silu_mul(g1[0], u1[0]), silu_mul(g1[1], u1[1])); w.w = pk2(silu_mul(g1[2], u1[2]), silu_mul(g1[3], u1[3]));
                    *(u32x4*)((bf16_t*)Ov + (size_t)(row0 + ai * 128 + m * 16) * ldc + col0) = w; } }
    }
};
struct EpiResF8 {
    bf16_t* h; float* ss;
    __device__ __forceinline__ void operator()(const f32x4 (&acc)[2][4][4], const pg8::Unit& u, int wq, int wh, int fr, int fq) const {
        const int row0 = u.pm * 256 + wq * 64 + fr, col0 = u.pn * 256 + wh * 64 + 8 * fq;
#pragma unroll
        for (int m = 0; m < 4; ++m) { float sq = 0.f;
#pragma unroll
        for (int p = 0; p < 2; ++p)
#pragma unroll
            for (int G = 0; G < 2; ++G) { bf16_t* q = h + (size_t)(row0 + m * 16) * DM + col0 + 128 * p + 32 * G; const u32x4 rb = *(const u32x4*)q;
                const f32x4 v0 = (f32x4){bflo(rb.x), bfhi(rb.x), bflo(rb.y), bfhi(rb.y)} + acc[p][m][2 * G] * FP8_UNSCALE, v1 = (f32x4){bflo(rb.z), bfhi(rb.z), bflo(rb.w), bfhi(rb.w)} + acc[p][m][2 * G + 1] * FP8_UNSCALE;
                u32x4 w; w.x = pk2(v0[0], v0[1]); w.y = pk2(v0[2], v0[3]); w.z = pk2(v1[0], v1[1]); w.w = pk2(v1[2], v1[3]);
                *(u32x4*)q = w;
                sq += (v0[0] * v0[0] + v0[1] * v0[1]) + (v0[2] * v0[2] + v0[3] * v0[3]) + (v1[0] * v1[0] + v1[1] * v1[1]) + (v1[2] * v1[2] + v1[3] * v1[3]); }
            if (ss) { sq += __shfl_xor(sq, 16); sq += __shfl_xor(sq, 32); if (fq == 0) ss[(size_t)(row0 + m * 16) * 8 + u.pn * 2 + wh] = sq; } }
    }
    __device__ __forceinline__ void operator()(const f32x4 (&acc)[2][4][2], const pg8::Unit& u, int wr, int wc, int fr, int fq) const {
        const int row0 = u.pm * 256 + wr * 64 + fr, col0 = u.pn * 128 + wc * 32 + 8 * fq;
#pragma unroll
        for (int ai = 0; ai < 2; ++ai)
#pragma unroll
            for (int m = 0; m < 4; ++m) { bf16_t* p = h + (size_t)(row0 + ai * 128 + m * 16) * DM + col0; const u32x4 rb = *(const u32x4*)p;
                const f32x4 v0 = (f32x4){bflo(rb.x), bfhi(rb.x), bflo(rb.y), bfhi(rb.y)} + acc[ai][m][0] * FP8_UNSCALE, v1 = (f32x4){bflo(rb.z), bfhi(rb.z), bflo(rb.w), bfhi(rb.w)} + acc[ai][m][1] * FP8_UNSCALE;
                u32x4 w; w.x = pk2(v0[0], v0[1]); w.y = pk2(v0[2], v0[3]); w.z = pk2(v1[0], v1[1]); w.w = pk2(v1[2], v1[3]);
                *(u32x4*)p = w; }
    }
};
struct EpiSwigluF8 {
    unsigned char* O; int ldc; int pm0;
    __device__ __forceinline__ void operator()(const f32x4 (&acc)[2][4][4], const pg8::Unit& u, int wq, int wh, int fr, int fq) const {
        const int row0 = (u.pm - pm0) * 256 + wq * 64 + fr, col0 = u.pn * 128 + wh * 64 + 16 * fq;
        constexpr float KE = -LOG2E * FP8_UNSCALE, KP = FP8_UNSCALE * FP8_UNSCALE * FP8_ASCALE;
#pragma unroll
        for (int m = 0; m < 4; ++m) { u32x4 w;
#pragma unroll
            for (int p = 0; p < 2; ++p)
#pragma unroll
            for (int G = 0; G < 2; ++G) { const f32x4 ga = acc[p][m][2 * G], ua = acc[p][m][2 * G + 1]; float r[4];
#pragma unroll
                for (int c = 0; c < 4; ++c) r[c] = (ga[c] * ua[c]) * KP * __builtin_amdgcn_rcpf(1.0f + __builtin_amdgcn_exp2f(KE * ga[c]));
                w[2 * p + G] = pk4_fp8(r[0], r[1], r[2], r[3]); }
            *(u32x4*)(O + (size_t)(row0 + m * 16) * ldc + col0) = w; }
    }
    __device__ __forceinline__ void operator()(const f32x4 (&acc)[2][4][2], const pg8::Unit& u, int wr, int wc, int fr, int fq) const {
        const int row0 = (u.pm - pm0) * 256 + wr * 64 + fr, col0 = u.pn * 64 + wc * 16 + 4 * fq;
#pragma unroll
        for (int ai = 0; ai < 2; ++ai)
#pragma unroll
            for (int m = 0; m < 4; ++m) { const f32x4 ga = acc[ai][m][0], ua = acc[ai][m][1];
                constexpr float KE = -LOG2E * FP8_UNSCALE, KP = FP8_UNSCALE * FP8_UNSCALE * FP8_ASCALE;
                float r[4];
#pragma unroll
                for (int c = 0; c < 4; ++c) r[c] = (ga[c] * ua[c]) * KP * __builtin_amdgcn_rcpf(1.0f + __builtin_amdgcn_exp2f(KE * ga[c]));
                *(unsigned*)(O + (size_t)(row0 + ai * 128 + m * 16) * ldc + col0) = pk4_fp8(r[0], r[1], r[2], r[3]); }
    }
};
struct EpiMoe2F8 {
    bf16_t* Y; int pm0;
    __device__ __forceinline__ void operator()(const f32x4 (&acc)[2][4][4], const pg8::Unit& u, int wq, int wh, int fr, int fq) const {
        const int row0 = (pm0 + u.pm) * 256 + wq * 64 + fr, col0 = u.pn * 256 + wh * 64 + 8 * fq;
#pragma unroll
        for (int p = 0; p < 2; ++p)
#pragma unroll
        for (int m = 0; m < 4; ++m)
#pragma unroll
            for (int G = 0; G < 2; ++G) { const f32x4 v0 = acc[p][m][2 * G] * FP8_UNSCALE, v1 = acc[p][m][2 * G + 1] * FP8_UNSCALE;
                u32x4 w; w.x = pk2(v0[0], v0[1]); w.y = pk2(v0[2], v0[3]); w.z = pk2(v1[0], v1[1]); w.w = pk2(v1[2], v1[3]);
                *(u32x4*)(Y + (size_t)(row0 + m * 16) * DM + col0 + 128 * p + 32 * G) = w; }
    }
    __device__ __forceinline__ void operator()(const f32x4 (&acc)[2][4][2], const pg8::Unit& u, int wr, int wc, int fr, int fq) const {
        const int row0 = (pm0 + u.pm) * 256 + wr * 64 + fr, col0 = u.pn * 128 + wc * 32 + 8 * fq;
#pragma unroll
        for (int ai = 0; ai < 2; ++ai)
#pragma unroll
            for (int m = 0; m < 4; ++m) { const f32x4 v0 = acc[ai][m][0] * FP8_UNSCALE, v1 = acc[ai][m][1] * FP8_UNSCALE;
                u32x4 w; w.x = pk2(v0[0], v0[1]); w.y = pk2(v0[2], v0[3]); w.z = pk2(v1[0], v1[1]); w.w = pk2(v1[2], v1[3]);
                *(u32x4*)(Y + (size_t)(row0 + ai * 128 + m * 16) * DM + col0) = w; }
    }
};
struct EpiMoe2 {
    bf16_t* Y; int pm0;
    __device__ __forceinline__ void operator()(const f32x4 (&acc)[2][2][4][2], const pg8::Unit& u, int wr, int wc, int fr, int fq) const {
        const int row0 = (pm0 + u.pm) * 256 + wr * 64 + fr, col0 = u.pn * 256 + wc * 32 + 8 * fq;
#pragma unroll
        for (int ai = 0; ai < 2; ++ai)
#pragma unroll
            for (int m = 0; m < 4; ++m) { bf16_t* o = Y + (size_t)(row0 + ai * 128 + m * 16) * DM + col0;
#pragma unroll
                for (int bj = 0; bj < 2; ++bj) { const f32x4 v0 = acc[ai][bj][m][0], v1 = acc[ai][bj][m][1];
                    u32x4 w; w.x = pk2(v0[0], v0[1]); w.y = pk2(v0[2], v0[3]); w.z = pk2(v1[0], v1[1]); w.w = pk2(v1[2], v1[3]);
                    *(u32x4*)(o + bj * 128) = w; } }
    }
};

struct SchedCmp {
    int wg; const char* KC; const char* VC; const char* W;
    __device__ bool next(int i, pg8::Unit& u) const { if (i > 0 || wg >= 32) return false; const int kv = wg >> 4, bg = wg & 15; u.pm = wg; u.pn = 0;
        u.A = (kv ? VC : KC) + (size_t)bg * SEQ * 64 * 2; u.B = W + (size_t)kv * 256 * 2048 * 2; return true; }
};
struct SchedMoe1 {
    int wg, G, c0, ncg, nchunks; const int* pstart; const char* A; const char* W; const int* rowtok;
    int ps[8];
    __device__ void load() { for (int k = 1; k < 8; ++k) ps[k] = __builtin_amdgcn_readfirstlane(pstart[k]); }
    __device__ bool next(int i, pg8::Unit& u) const {
        if (ncg <= 0) return false;
        const int L = i * G + wg; const int cl = __builtin_amdgcn_readfirstlane(L % ncg), pn = __builtin_amdgcn_readfirstlane(L / ncg); if (pn >= 28) return false; const int c = c0 + cl; if (c >= nchunks) return false;
        int e = 0;
#pragma unroll
        for (int k = 1; k < 8; ++k) e += (c * 256 >= ps[k]) ? 1 : 0;
        u.pm = c; u.pn = pn; u.A = A; u.B = W + ((size_t)e * 7168 + (size_t)pn * 256) * DM; return true; }
};
struct SchedMoe2 {
    int wg, G, c0, ncg, nchunks; const int* pstart; const char* A; const char* W;
    int ps[8];
    __device__ void load() { for (int k = 1; k < 8; ++k) ps[k] = __builtin_amdgcn_readfirstlane(pstart[k]); }
    __device__ bool next(int i, pg8::Unit& u) const {
        if (ncg <= 0) return false;
        const int L = i * G + wg; const int cl = __builtin_amdgcn_readfirstlane(L % ncg), pn = __builtin_amdgcn_readfirstlane(L / ncg); if (pn >= 4) return false; const int c = c0 + cl; if (c >= nchunks) return false;
        int e = 0;
#pragma unroll
        for (int k = 1; k < 8; ++k) e += (c * 256 >= ps[k]) ? 1 : 0;
        u.pm = cl; u.pn = pn; u.A = A + (size_t)cl * 256 * DFE; u.B = W + ((size_t)e * 1024 + (size_t)pn * 256) * DFE; return true; }
};

__device__ __forceinline__ void transpose_block(const float* src, int ldw, bf16_t* dst, int ldt, int nvalid, LAS float* scr, int lane, const float* gk = nullptr) {
    if (nvalid == 32) {
#pragma unroll
        for (int i = 0; i < 8; ++i) { const int kk = 8 * i + (lane >> 3), n = (lane & 7) * 4; const f32x4 v = *(const f32x4*)(src + (size_t)kk * ldw + n) * (gk ? gk[kk] : 1.0f);
            LAS float* d = scr + kk * 33 + n; d[0] = v[0]; d[1] = v[1]; d[2] = v[2]; d[3] = v[3]; }
    } else {
#pragma unroll 8
        for (int i = 0; i < 32; ++i) { const int kk = 2 * i + (lane >> 5), n = lane & 31; scr[kk * 33 + n] = (n < nvalid) ? src[(size_t)kk * ldw + n] * (gk ? gk[kk] : 1.0f) : 0.f; }
    }
    asm volatile("s_waitcnt lgkmcnt(0)" ::: "memory");
    const int c = lane & 7;
#pragma unroll
    for (int j = 0; j < 4; ++j) { const int n = (lane >> 3) + 8 * j; const LAS float* s = scr + (8 * c) * 33 + n;
        u32x4 o; o.x = pk2(s[0 * 33], s[1 * 33]); o.y = pk2(s[2 * 33], s[3 * 33]); o.z = pk2(s[4 * 33], s[5 * 33]); o.w = pk2(s[6 * 33], s[7 * 33]);
        *(u32x4*)(dst + (size_t)n * ldt + 8 * c) = o; }
    asm volatile("s_waitcnt lgkmcnt(0)" ::: "memory");
}
__device__ __forceinline__ void tb_load(f32x4 (&r)[8], const float* src, int ldw, int lane) {
#pragma unroll
    for (int i = 0; i < 8; ++i) r[i] = *(const f32x4*)(src + (size_t)(8 * i + (lane >> 3)) * ldw + (lane & 7) * 4);
}
template <bool FP8> __device__ __forceinline__ void tb_emit(const f32x4 (&r)[8], void* dstv, int ldt, LAS float* scr, int lane) {
#pragma unroll
    for (int i = 0; i < 8; ++i) { LAS float* d = scr + (8 * i + (lane >> 3)) * 33 + (lane & 7) * 4; d[0] = r[i][0]; d[1] = r[i][1]; d[2] = r[i][2]; d[3] = r[i][3]; }
    asm volatile("s_waitcnt lgkmcnt(0)" ::: "memory");
    const int c = lane & 7;
#pragma unroll
    for (int j = 0; j < 4; ++j) { const int n = (lane >> 3) + 8 * j; const LAS float* s = scr + (8 * c) * 33 + n;
        if constexpr (FP8) { u32x2 o; o.x = pk4_fp8(s[0 * 33] * FP8_WSCALE, s[1 * 33] * FP8_WSCALE, s[2 * 33] * FP8_WSCALE, s[3 * 33] * FP8_WSCALE); o.y = pk4_fp8(s[4 * 33] * FP8_WSCALE, s[5 * 33] * FP8_WSCALE, s[6 * 33] * FP8_WSCALE, s[7 * 33] * FP8_WSCALE);
            *(u32x2*)((unsigned char*)dstv + (size_t)n * ldt + 8 * c) = o; }
        else { u32x4 o; o.x = pk2(s[0 * 33], s[1 * 33]); o.y = pk2(s[2 * 33], s[3 * 33]); o.z = pk2(s[4 * 33], s[5 * 33]); o.w = pk2(s[6 * 33], s[7 * 33]);
            *(u32x4*)((bf16_t*)dstv + (size_t)n * ldt + 8 * c) = o; } }
    asm volatile("s_waitcnt lgkmcnt(0)" ::: "memory");
}
template <bool FP8 = false> __device__ __forceinline__ void conv_plain(const float* W, int K, int N, void* WTv, LAS float* scr, int gw, int ngw, int lane) {
    unsigned char* WT = (unsigned char*)WTv; constexpr int ES = FP8 ? 1 : 2;
    const int nkb = K / 64, nnb = N / 32, nit = nkb * nnb;
    f32x4 cur[8], nxt[8];
    int it = gw;
    if (it < nit) { const int kb = it / nnb, nb = it % nnb; tb_load(cur, W + (size_t)kb * 64 * N + nb * 32, N, lane); }
    for (; it < nit; it += ngw) {
        const int kb = it / nnb, nb = it % nnb;
        if (it + ngw < nit) { const int kb2 = (it + ngw) / nnb, nb2 = (it + ngw) % nnb; tb_load(nxt, W + (size_t)kb2 * 64 * N + nb2 * 32, N, lane); }
        tb_emit<FP8>(cur, WT + ((size_t)nb * 32 * K + kb * 64) * ES, K, scr, lane);
#pragma unroll
        for (int i = 0; i < 8; ++i) cur[i] = nxt[i];
    }
}
__device__ __forceinline__ void conv_gateup(const float* Wg, const float* Wu, int K, int N, bf16_t* WT, LAS float* scr, int gw, int ngw, int lane) {
    const int nkb = K / 64, nvb = 2 * N / 32, nit = nkb * nvb;
    f32x4 cur[8], nxt[8];
    int it = gw;
#define GU_SRC(itx) ((((((itx) % nvb) * 32) >> 7) & 1 ? Wu : Wg) + (size_t)((itx) / nvb) * 64 * N + (((((itx) % nvb) * 32) >> 8) * 128) + ((((itx) % nvb) * 32) & 127))
    if (it < nit) tb_load(cur, GU_SRC(it), N, lane);
    for (; it < nit; it += ngw) {
        const int kb = it / nvb, vb = it % nvb;
        if (it + ngw < nit) tb_load(nxt, GU_SRC(it + ngw), N, lane);
        tb_emit<false>(cur, WT + (size_t)vb * 32 * K + kb * 64, K, scr, lane);
#pragma unroll
        for (int i = 0; i < 8; ++i) cur[i] = nxt[i];
    }
#undef GU_SRC
}
__device__ __forceinline__ void conv_gateup_f8(const float* Wg, const float* Wu, int K, int N, unsigned char* WT, LAS float* scr, int gw, int ngw, int lane) {
    const int nkb = K / 64, nsp = N / 64, nit = nkb * nsp * 2;
    f32x4 cur[16], nxt[16];
#define GU8_LOAD(r, itx) do { const int src_ = (itx) & 1, sp_ = ((itx) >> 1) % nsp, kb_ = ((itx) >> 1) / nsp; const float* W_ = (src_ ? Wu : Wg) + (size_t)kb_ * 64 * N + sp_ * 64 + (lane & 15) * 4; \
        _Pragma("unroll") for (int i = 0; i < 16; ++i) r[i] = __builtin_nontemporal_load((const f32x4*)(W_ + (size_t)(4 * i + (lane >> 4)) * N)); } while (0)
    int it = gw;
    if (it < nit) GU8_LOAD(cur, it);
    for (; it < nit; it += ngw) {
        if (it + ngw < nit) GU8_LOAD(nxt, it + ngw);
        const int src = it & 1, sp = (it >> 1) % nsp, kb = (it >> 1) / nsp;
#pragma unroll
        for (int i = 0; i < 16; ++i) { const int k = 4 * i + (lane >> 4); *(LAS f32x4*)(scr + k * 64 + (((lane & 15) * 4) ^ (8 * (k >> 3)))) = cur[i] * FP8_WSCALE; }
        asm volatile("s_waitcnt lgkmcnt(0)" ::: "memory");
        const int c = lane & 7, sl = lane >> 3;
#pragma unroll
        for (int jj = 0; jj < 8; ++jj) { const int sc = sl + 8 * jj; const LAS float* q = scr + (8 * c) * 64 + (sc ^ (8 * c));
            u32x2 o; o.x = pk4_fp8(q[0 * 64], q[1 * 64], q[2 * 64], q[3 * 64]); o.y = pk4_fp8(q[4 * 64], q[5 * 64], q[6 * 64], q[7 * 64]);
            const int row = 32 * (8 * (sp >> 1) + 4 * ((sc >> 3) & 1) + 2 * (sp & 1) + ((sc >> 2) & 1)) + 8 * (sc >> 4) + 4 * src + (sc & 3);
            *(u32x2*)(WT + (size_t)row * K + kb * 64 + 8 * c) = o; }
        asm volatile("s_waitcnt lgkmcnt(0)" ::: "memory");
#pragma unroll
        for (int i = 0; i < 16; ++i) cur[i] = nxt[i];
    }
#undef GU8_LOAD
}
__device__ __forceinline__ void conv_experts_f8(const float* EG, const float* EU, const float* ED, unsigned char* WE1, unsigned char* WE2, LAS float* scr, int gw, int ngw, int lane) {
    constexpr int IT_GU = (DM / 64) * (DFE / 64) * 2, IT_DN = (DFE / 64) * (DM / 64), IT_E = IT_GU + IT_DN, NIT = NEXP * IT_E;
    f32x4 cur[16], nxt[16];
#define CE_LOAD(r, itx) do { const int e_ = (itx) / IT_E, q_ = (itx) % IT_E; const float* W_; int N_; \
        if (q_ < IT_GU) { const int sp_ = (q_ >> 1) % (DFE / 64), kb_ = (q_ >> 1) / (DFE / 64); W_ = ((q_ & 1) ? EU : EG) + (size_t)e_ * DM * DFE + (size_t)kb_ * 64 * DFE + sp_ * 64; N_ = DFE; } \
        else { const int q2_ = q_ - IT_GU, nb_ = q2_ % (DM / 64), kb_ = q2_ / (DM / 64); W_ = ED + (size_t)e_ * DFE * DM + (size_t)kb_ * 64 * DM + nb_ * 64; N_ = DM; } \
        W_ += (lane & 15) * 4; \
        _Pragma("unroll") for (int i = 0; i < 16; ++i) r[i] = __builtin_nontemporal_load((const f32x4*)(W_ + (size_t)(4 * i + (lane >> 4)) * N_)); } while (0)
    int it = gw;
    if (it < NIT) CE_LOAD(cur, it);
    for (; it < NIT; it += ngw) {
        if (it + ngw < NIT) CE_LOAD(nxt, it + ngw);
        const int e = it / IT_E, q = it % IT_E;
#pragma unroll
        for (int i = 0; i < 16; ++i) { const int k = 4 * i + (lane >> 4); *(LAS f32x4*)(scr + k * 64 + (((lane & 15) * 4) ^ (8 * (k >> 3)))) = cur[i] * FP8_WSCALE; }
        asm volatile("s_waitcnt lgkmcnt(0)" ::: "memory");
        const int c = lane & 7, sl = lane >> 3;
        unsigned char* dbase; int rowmul, src = 0, sp = 0, nb = 0; bool gu = (q < IT_GU);
        if (gu) { src = q & 1; sp = (q >> 1) % (DFE / 64); const int kb = (q >> 1) / (DFE / 64); dbase = WE1 + (size_t)e * 7168 * DM + kb * 64 + 8 * c; rowmul = DM; }
        else { const int q2 = q - IT_GU; nb = q2 % (DM / 64); const int kb = q2 / (DM / 64); dbase = WE2 + (size_t)e * DM * DFE + kb * 64 + 8 * c; rowmul = DFE; }
#pragma unroll
        for (int jj = 0; jj < 8; ++jj) { const int sc = sl + 8 * jj; const LAS float* p = scr + (8 * c) * 64 + (sc ^ (8 * c));
            u32x2 o; o.x = pk4_fp8(p[0 * 64], p[1 * 64], p[2 * 64], p[3 * 64]); o.y = pk4_fp8(p[4 * 64], p[5 * 64], p[6 * 64], p[7 * 64]);
            const int row = gu ? (32 * (8 * (sp >> 1) + 4 * ((sc >> 3) & 1) + 2 * (sp & 1) + ((sc >> 2) & 1)) + 8 * (sc >> 4) + 4 * src + (sc & 3)) : (nb * 64 + sc);
            *(u32x2*)(dbase + (size_t)row * rowmul) = o; }
        asm volatile("s_waitcnt lgkmcnt(0)" ::: "memory");
#pragma unroll
        for (int i = 0; i < 16; ++i) cur[i] = nxt[i];
    }
#undef CE_LOAD
}
__device__ __forceinline__ void conv_inproj(const float* W, bf16_t* WT, LAS float* scr, int gw, int ngw, int lane, const float* gain = nullptr) {
    const int nkb = DM / 64, nvb = INP / 32;
    for (int it = gw; it < nkb * nvb; it += ngw) { const int kb = it / nvb, vb = it % nvb; const int v0 = vb * 32, pn = v0 >> 8, bj = (v0 >> 7) & 1, wc = (v0 >> 5) & 3;
        int col, nvalid = 32;
        if (pn < 11) { const int vh = 4 * pn + wc; col = (vh < 20 ? 64 * vh : 1304 + 64 * (vh - 20)) + 32 * bj; }
        else { col = 1280; nvalid = (bj == 0 && wc == 0) ? 24 : 0; }
        transpose_block(W + (size_t)kb * 64 * IN_W + col, IN_W, WT + (size_t)v0 * DM + kb * 64, DM, nvalid, scr, lane, gain ? gain + kb * 64 : nullptr); }
}

struct CJob { const float* src; int ldw; unsigned char* dst; int ldt; int nvalid; int fp8; const float* gk; };
__device__ __forceinline__ CJob conv_job(const float* const* in, unsigned char* ws, int L, int it) {
    CJob j; j.gk = nullptr; j.fp8 = 0; j.nvalid = 32;
    if (it < 1536) {
        const int kb = it / 96, vb = it % 96, v0 = vb * 32, pn = v0 >> 8, bj = (v0 >> 7) & 1, wc = (v0 >> 5) & 3; int col;
        if (pn < 11) { const int vh = 4 * pn + wc; col = (vh < 20 ? 64 * vh : 1304 + 64 * (vh - 20)) + 32 * bj; } else { col = 1280; j.nvalid = (bj == 0 && wc == 0) ? 24 : 0; }
        j.src = in[I_WIN] + (size_t)L * DM * IN_W + (size_t)kb * 64 * IN_W + col; j.ldw = IN_W;
        j.dst = ws + WS_WIN + ((size_t)L * INP * DM + (size_t)v0 * DM + kb * 64) * 2; j.ldt = DM;
        if (L == 1) j.gk = in[I_ANORM] + DM + kb * 64;
        return j; }
    it -= 1536;
    if (it < 512) { const int kv = it >> 8, r = it & 255, kb = r >> 3, nb = r & 7;
        j.src = in[I_CW1] + (size_t)(L * 2 + kv) * 2048 * 256 + (size_t)kb * 64 * 256 + nb * 32; j.ldw = 256;
        j.dst = ws + WS_WC1 + ((size_t)(L * 2 + kv) * 256 * 2048 + (size_t)nb * 32 * 2048 + kb * 64) * 2; j.ldt = 2048; return j; }
    it -= 512;
    if (it < 512) { const int kb = it >> 5, nb = it & 31;
        j.src = in[I_WOUT] + (size_t)L * DM * DM + (size_t)kb * 64 * DM + nb * 32; j.ldw = DM;
        j.dst = ws + WS_WO + ((size_t)L * DM * DM + (size_t)nb * 32 * DM + kb * 64) * 2; j.ldt = DM;
        if (kb < 8) j.gk = in[I_ONORM] + (size_t)L * DM + kb * 64;
        return j; }
    it -= 512;
    if (it < 16) { const int kv = it >> 3, r = it & 7, kb = r >> 1, nb = r & 1;
        j.src = in[I_CW2] + (size_t)(L * 2 + kv) * 256 * 64 + (size_t)kb * 64 * 64 + nb * 32; j.ldw = 64;
        j.dst = ws + WS_WC2 + ((size_t)(L * 2 + kv) * 64 * 256 + (size_t)nb * 32 * 256 + kb * 64) * 2; j.ldt = 256; return j; }
    it -= 16;
    { const int kb = it >> 5, nb = it & 31;
      j.src = in[I_FD] + (size_t)kb * 64 * DM + nb * 32; j.ldw = DM; j.dst = ws + WS_WF2 + (size_t)nb * 32 * DFF + kb * 64; j.ldt = DFF; j.fp8 = 1; return j; }
}
__device__ __forceinline__ void conv_blocks(const float* const* in, unsigned char* ws, int L, bool with_fd, LAS float* scr, int gw, int ngw, int lane) {
    const int nit = 1536 + 512 + 512 + 16 + (with_fd ? (DFF / 64) * 32 : 0);
    f32x4 cur[8], nxt[8];
#define CB_LOAD(r, J) do { _Pragma("unroll") for (int i = 0; i < 8; ++i) { const int kk = 8 * i + (lane >> 3), n = (lane & 7) * 4; \
        f32x4 v_ = (n < (J).nvalid) ? __builtin_nontemporal_load((const f32x4*)((J).src + (size_t)kk * (J).ldw + n)) : (f32x4){0.f, 0.f, 0.f, 0.f}; if ((J).gk) v_ = v_ * (J).gk[kk]; r[i] = v_; } } while (0)
    int it = gw;
    if (it < nit) { const CJob j0 = conv_job(in, ws, L, it); CB_LOAD(cur, j0); }
    for (; it < nit; it += ngw) {
        if (it + ngw < nit) { const CJob jn = conv_job(in, ws, L, it + ngw); CB_LOAD(nxt, jn); }
        const CJob j = conv_job(in, ws, L, it);
        if (j.fp8) tb_emit<true>(cur, j.dst, j.ldt, scr, lane); else tb_emit<false>(cur, j.dst, j.ldt, scr, lane);
#pragma unroll
        for (int i = 0; i < 8; ++i) cur[i] = nxt[i];
    }
#undef CB_LOAD
}

__device__ __forceinline__ f32x16 mfma32(bf16x8 a, bf16x8 b, f32x16 c) { return __builtin_amdgcn_mfma_f32_32x32x16_bf16(a, b, c, 0, 0, 0); }
typedef short v4i16_t __attribute__((ext_vector_type(4)));
__device__ __forceinline__ s16x4 vtr(const LAS char* p) { return __builtin_bit_cast(s16x4, __builtin_amdgcn_ds_read_tr16_b64_v4i16((LAS v4i16_t*)p)); }

__device__ __forceinline__ void init_scores(f32x16& p0, f32x16& p1, int dbase, int dstep, int dmaxv, bool lanevalid, const LAS float* lut) {
#pragma unroll
    for (int r = 0; r < 16; ++r) {
        const int kk = (r & 3) + 8 * (r >> 2);
        const int d0 = dbase - dstep * kk, d1 = dbase - dstep * (kk + 32);
        const bool v0 = lanevalid && ((unsigned)d0 <= (unsigned)dmaxv), v1 = lanevalid && ((unsigned)d1 <= (unsigned)dmaxv);
        const int i0 = min(max(d0, 0), LUTN - 1), i1 = min(max(d1, 0), LUTN - 1);
        const float b0 = lut[(LUTN - 1) - i0], b1 = lut[(LUTN - 1) - i1];
        p0[r] = v0 ? b0 : NEGF; p1[r] = v1 ? b1 : NEGF;
    }
}
__device__ __forceinline__ void qk_tile(f32x16& p0, f32x16& p1, const LAS char* Ks, const bf16x8 (&qr)[4], int r32, int hi) {
    const LAS char* kb = Ks + r32 * 128; const int sx = (r32 >> 1) & 7;
#pragma unroll
    for (int d0 = 0; d0 < 4; ++d0) { const int off = ((2 * d0 + hi) ^ sx) * 16;
        const bf16x8 b0 = *(const LAS bf16x8*)(kb + off), b1 = *(const LAS bf16x8*)(kb + off + 4096);
        p0 = mfma32(b0, qr[d0], p0); p1 = mfma32(b1, qr[d0], p1);
    }
}
__device__ __forceinline__ void k_load(bf16x8 (&kf)[8], const LAS char* Ks, int r32, int hi) {
    const LAS char* kb = Ks + r32 * 128; const int sx = (r32 >> 1) & 7;
#pragma unroll
    for (int d0 = 0; d0 < 4; ++d0) { const int off = ((2 * d0 + hi) ^ sx) * 16; kf[2 * d0] = *(const LAS bf16x8*)(kb + off); kf[2 * d0 + 1] = *(const LAS bf16x8*)(kb + off + 4096); }
}
__device__ __forceinline__ void qk_mma(f32x16& p0, f32x16& p1, const bf16x8 (&kf)[8], const bf16x8 (&qr)[4]) {
#pragma unroll
    for (int d0 = 0; d0 < 4; ++d0) { p0 = mfma32(kf[2 * d0], qr[d0], p0); p1 = mfma32(kf[2 * d0 + 1], qr[d0], p1); }
}
__device__ __forceinline__ bf16x8 pack8(const f32x16& p, int s) {
    u32x4 w; w.x = pk2(p[8 * s], p[8 * s + 1]); w.y = pk2(p[8 * s + 2], p[8 * s + 3]); w.z = pk2(p[8 * s + 4], p[8 * s + 5]); w.w = pk2(p[8 * s + 6], p[8 * s + 7]);
    return __builtin_bit_cast(bf16x8, w);
}
__device__ __forceinline__ void pv_tile(f32x16 (&o)[2], const LAS char* vb, const f32x16& p0, const f32x16& p1) {
    bf16x8 pf[4]; pf[0] = pack8(p0, 0); pf[1] = pack8(p0, 1); pf[2] = pack8(p1, 0); pf[3] = pack8(p1, 1);
#pragma unroll
    for (int db = 0; db < 2; ++db)
#pragma unroll
        for (int ks = 0; ks < 4; ++ks) {
            const s16x4 lo = vtr(vb + db * 4096 + ks * 1024), hh = vtr(vb + db * 4096 + ks * 1024 + 512);
            const bf16x8 vf = (bf16x8){lo[0], lo[1], lo[2], lo[3], hh[0], hh[1], hh[2], hh[3]};
            o[db] = mfma32(vf, pf[ks], o[db]);
        }
}
__device__ __forceinline__ void v_load(bf16x8 (&vf)[8], const LAS char* vb) {
#pragma unroll
    for (int db = 0; db < 2; ++db)
#pragma unroll
        for (int ks = 0; ks < 4; ++ks) {
            const s16x4 lo = vtr(vb + db * 4096 + ks * 1024), hh = vtr(vb + db * 4096 + ks * 1024 + 512);
            vf[db * 4 + ks] = (bf16x8){lo[0], lo[1], lo[2], lo[3], hh[0], hh[1], hh[2], hh[3]};
        }
}
__device__ __forceinline__ void pv_mma(f32x16 (&o)[2], const bf16x8 (&vf)[8], const f32x16& p0, const f32x16& p1) {
    bf16x8 pf[4]; pf[0] = pack8(p0, 0); pf[1] = pack8(p0, 1); pf[2] = pack8(p1, 0); pf[3] = pack8(p1, 1);
#pragma unroll
    for (int ks = 0; ks < 4; ++ks) { o[0] = mfma32(vf[ks], pf[ks], o[0]); o[1] = mfma32(vf[4 + ks], pf[ks], o[1]); }
}
#define SCHED_FENCE() __builtin_amdgcn_sched_barrier(0)
__device__ __forceinline__ float max16x2(const f32x16& a, const f32x16& b) {
    float m = fmaxf(a[0], b[0]);
#pragma unroll
    for (int r = 1; r < 16; ++r) m = fmaxf(m, fmaxf(a[r], b[r]));
    return m;
}
__device__ __forceinline__ void init_direct(f32x16& p0, f32x16& p1, const LAS float* base) {
#pragma unroll
    for (int r = 0; r < 16; ++r) { const int kk = (r & 3) + 8 * (r >> 2); p0[r] = base[kk]; p1[r] = base[kk + 32]; }
}
__device__ __forceinline__ float exp_tile(f32x16& p0, f32x16& p1) {
    float rs = 0.f;
#pragma unroll
    for (int r = 0; r < 16; ++r) { p0[r] = fexp2(p0[r]); p1[r] = fexp2(p1[r]); rs += p0[r] + p1[r]; }
    return rs;
}

constexpr int AL_KV = 0;
constexpr int LUTS_N = 64 + LUTN, LUTW_N = 64 + 512 + 128;
constexpr int AL_LUTS = 65536;
constexpr int AL_LUTW = AL_LUTS + 4 * LUTS_N * 4, AL_NEGP = AL_LUTW + 4 * LUTW_N * 4;
constexpr int AL_IMP = AL_NEGP + 512;
constexpr int AL_SEL = LDSCTL_OFF + 1024;
constexpr int AL_DLUT = 65536;
constexpr int AL_STA = AL_IMP, AL_STB = AL_SEL + 2048;
static_assert(AL_STB + 2 * 4096 <= LDS_BYTES && AL_STA + 6 * 4096 <= RING_BYTES && AL_IMP + 64 * 65 * 4 <= RING_BYTES, "attention LDS map");

__device__ __forceinline__ void glds16(const void* gsrc, unsigned lds_dst) { unsigned keep;
    asm volatile("s_mov_b32 %0, m0\n\ts_mov_b32 m0, %2\n\ts_nop 0\n\tglobal_load_lds_dwordx4 %1, off\n\ts_mov_b32 m0, %0" : "=&s"(keep) : "v"(gsrc), "s"(lds_dst) : "memory"); }
__device__ __forceinline__ void kv_dma(const bf16_t* Kt, const bf16_t* Vt, LAS char* slot, int w, int lane) {
    const unsigned base = (unsigned)__builtin_amdgcn_readfirstlane((int)(unsigned)(size_t)slot + w * 1024);
    { const int kt = 8 * w + (lane >> 3); glds16(Kt + kt * 64 + (((lane & 7) ^ ((kt >> 1) & 7)) * 8), base); }
    glds16(Vt + ((w & 3) * 16 + (lane >> 2)) * 64 + (w >> 2) * 32 + (lane & 3) * 8, base + 8192u);
}
#define WAITBAR(N) asm volatile("s_waitcnt vmcnt(" #N ") lgkmcnt(0)\n\ts_barrier" ::: "memory")

__device__ __forceinline__ void stash_store(LAS char* st, const f32x16 (&o)[2]) {
#pragma unroll
    for (int k = 0; k < 4; ++k) { const f32x16& v = o[k >> 1]; const int b = 8 * (k & 1);
        u32x4 wv; wv.x = pk2(v[b], v[b + 1]); wv.y = pk2(v[b + 2], v[b + 3]); wv.z = pk2(v[b + 4], v[b + 5]); wv.w = pk2(v[b + 6], v[b + 7]); *(LAS u32x4*)(st + k * 1024) = wv; }
}
__device__ __forceinline__ void stash_load(const LAS char* st, f32x16 (&o)[2]) {
#pragma unroll
    for (int k = 0; k < 4; ++k) { const u32x4 wv = *(const LAS u32x4*)(st + k * 1024); f32x16& v = o[k >> 1]; const int b = 8 * (k & 1);
        v[b] = bflo(wv.x); v[b + 1] = bfhi(wv.x); v[b + 2] = bflo(wv.y); v[b + 3] = bfhi(wv.y); v[b + 4] = bflo(wv.z); v[b + 5] = bfhi(wv.z); v[b + 6] = bflo(wv.w); v[b + 7] = bfhi(wv.w); }
}
__device__ __forceinline__ void store_o32(bf16_t* Orow8, const f32x16 (&o)[2], float sc) {
#pragma unroll
    for (int db = 0; db < 2; ++db)
#pragma unroll
        for (int k = 0; k < 2; ++k) { const int r0 = 8 * k;
            const unsigned ax = pk2(o[db][r0] * sc, o[db][r0 + 1] * sc), ay = pk2(o[db][r0 + 2] * sc, o[db][r0 + 3] * sc), bx = pk2(o[db][r0 + 4] * sc, o[db][r0 + 5] * sc), by = pk2(o[db][r0 + 6] * sc, o[db][r0 + 7] * sc);
            const auto rx = __builtin_amdgcn_permlane32_swap(ax, bx, false, false); const auto ry = __builtin_amdgcn_permlane32_swap(ay, by, false, false);
            u32x4 w; w.x = rx[0]; w.y = ry[0]; w.z = rx[1]; w.w = ry[1];
            *(u32x4*)(Orow8 + 32 * db + 16 * k) = w; }
}
constexpr float OB8_SCALE = 16.0f;
__device__ __forceinline__ void store_o8(unsigned char* Orow8, const f32x16 (&o)[2], float sc) {
#pragma unroll
    for (int db = 0; db < 2; ++db)
#pragma unroll
        for (int k = 0; k < 2; ++k) { const int r0 = 8 * k;
            const unsigned a = pk4_fp8(o[db][r0] * sc, o[db][r0 + 1] * sc, o[db][r0 + 2] * sc, o[db][r0 + 3] * sc), b = pk4_fp8(o[db][r0 + 4] * sc, o[db][r0 + 5] * sc, o[db][r0 + 6] * sc, o[db][r0 + 7] * sc);
            const auto rr = __builtin_amdgcn_permlane32_swap(a, b, false, false);
            u32x2 w; w.x = rr[0]; w.y = rr[1];
            *(u32x2*)(Orow8 + 32 * db + 16 * k) = w; }
}
__device__ __forceinline__ void nsa_prepare(const Frame& F, int L, int g) {
    LAS char* lds = (LAS char*)F.lds; int tid_l = F.tid; asm volatile("" : "+v"(tid_l)); const int tid = tid_l;
    const float* LUTG = (const float*)(F.ws + WS_LUT) + (size_t)(L * 16 + g * 4) * LUTN;
    LAS float* ls = (LAS float*)(lds + AL_LUTS); LAS float* lw = (LAS float*)(lds + AL_LUTW); LAS float* np = (LAS float*)(lds + AL_NEGP);
    __syncthreads();
    for (int h = 0; h < 4; ++h) {
        for (int x = tid; x < LUTS_N; x += NTHR) ls[h * LUTS_N + x] = (x >= LUTN) ? NEGF : LUTG[h * LUTN + (LUTN - 1 - x)];
        for (int x = tid; x < LUTW_N; x += NTHR) { const int d = 639 - x; lw[h * LUTW_N + x] = (d < 0 || d > 511) ? NEGF : LUTG[h * LUTN + d]; }
    }
    if (tid < 128) np[tid] = NEGF;
    __syncthreads();
}

__device__ __forceinline__ void nsa_unit(const Frame& F, int L, int b, int g, int i) {
    LAS char* lds = (LAS char*)F.lds;
    int tid_l = F.tid; asm volatile("" : "+v"(tid_l));
    const int tid = tid_l, lane = tid & 63, w = __builtin_amdgcn_readfirstlane(tid >> 6), r32 = lane & 31, hi = lane >> 5;
    const int hh = w >> 1, qh = w & 1, head = g * 4 + hh;
    const int t0 = i * 64, tq = t0 + 32 * qh + r32;
    unsigned char* ws = F.ws;
    const bf16_t* QA = (const bf16_t*)(ws + WS_QA);
    const size_t bgoff = (size_t)(b * 2 + g) * SEQ * 64;
    const bf16_t *KS = (const bf16_t*)(ws + WS_KS) + bgoff, *VS = (const bf16_t*)(ws + WS_VS) + bgoff, *KW = (const bf16_t*)(ws + WS_KW) + bgoff, *VW = (const bf16_t*)(ws + WS_VW) + bgoff;
    const bf16_t *KCC = (const bf16_t*)(ws + WS_KCC) + (size_t)(b * 2 + g) * 256 * 64, *VCC = (const bf16_t*)(ws + WS_VCC) + (size_t)(b * 2 + g) * 256 * 64;
    LAS char* ring = lds + AL_KV;
    const LAS float* luts = (const LAS float*)(lds + AL_LUTS) + hh * LUTS_N;
    const LAS float* lutw = (const LAS float*)(lds + AL_LUTW) + hh * LUTW_N;
    const LAS float* negp = (const LAS float*)(lds + AL_NEGP);
    WAITBAR(0);
    const int ntc = (4 * i + 3 + 63) >> 6;
#pragma unroll
    for (int p = 0; p < 4; ++p) if (p < ntc) kv_dma(KCC + (size_t)p * 4096, VCC + (size_t)p * 4096, ring + p * 16384, w, lane);
    bf16x8 qr[4];
    { const bf16_t* Qp = QA + ((size_t)(b * 8 + head) * SEQ + tq) * 64;
#pragma unroll
      for (int d0 = 0; d0 < 4; ++d0) qr[d0] = *(const bf16x8*)(Qp + d0 * 16 + hi * 8); }
    const int vlane = ((lane >> 4) & 1) * 32 + (lane & 3) * 8 + (4 * hi + ((lane & 15) >> 2)) * 64 + 8192;
    const float* GT = (const float*)(ws + WS_GATES) + (size_t)(b * SEQ + tq) * 24 + head * 3;
    const float g_c = GT[0], g_s = GT[1], g_w = GT[2];
    const float cfar = luts[0];
    LAS char* stash = lds + ((w < 6) ? AL_STA + w * 4096 : AL_STB + (w - 6) * 4096) + lane * 16;
    const int j0 = (i >= 8) ? i - 8 : 0, nw = i - j0 + 1;
    f32x16 oc[2];
    {
#pragma unroll
        for (int r = 0; r < 16; ++r) { oc[0][r] = 0.f; oc[1][r] = 0.f; }
        float lc = 0.f, carry = 0.f;
        { LAS int* iz = (LAS int*)(lds + AL_IMP); for (int k = tid; k < 64 * 65; k += NTHR) iz[k] = 0; }
        WAITBAR(0);
        for (int t = 0; t < ntc; ++t) {
            f32x16 p0, p1;
            init_scores(p0, p1, (tq - 31) - 16 * (64 * t + 4 * hi), 16, 1 << 20, true, luts);
            qk_tile(p0, p1, ring + t * 16384, qr, r32, hi);
            lc += exp_tile(p0, p1);
        }
        lc += __shfl_xor(lc, 32);
        const float lcinv = (tq >= 31) ? 1.0f / lc : 0.f;
        LAS int* impq = (LAS int*)(lds + AL_IMP) + (32 * qh + r32);
        for (int t = 0; t < ntc; ++t) {
            const LAS char* buf = ring + t * 16384;
            f32x16 p0, p1; bf16x8 vf[8];
            init_scores(p0, p1, (tq - 31) - 16 * (64 * t + 4 * hi), 16, 1 << 20, true, luts);
            qk_tile(p0, p1, buf, qr, r32, hi);
            v_load(vf, buf + vlane); SCHED_FENCE();
#pragma unroll
            for (int r = 0; r < 16; ++r) { p0[r] = fexp2(p0[r]) * lcinv; p1[r] = fexp2(p1[r]) * lcinv; }
#pragma unroll
            for (int blk = 0; blk < 2; ++blk)
#pragma unroll
                for (int g4 = 0; g4 < 4; ++g4) {
                    const f32x16& p = blk ? p1 : p0;
                    const float a = p[4 * g4] + p[4 * g4 + 1] + p[4 * g4 + 2] + 0.5f * p[4 * g4 + 3], bn = 0.5f * p[4 * g4 + 3];
                    const float pb = __shfl_xor(bn, 32);
                    const float v = hi ? (a + pb) : (a + carry); carry = pb;
                    const int j = 16 * t + 8 * blk + 2 * g4 + hi;
                    (void)__hip_atomic_fetch_add(impq + j * 65, (int)(v * 67108864.0f + 0.5f), __ATOMIC_RELAXED, __HIP_MEMORY_SCOPE_WORKGROUP);
                }
            pv_mma(oc, vf, p0, p1);
        }
#pragma unroll
        for (int r = 0; r < 16; ++r) { oc[0][r] *= g_c; oc[1][r] *= g_c; }
        WAITBAR(0);
#pragma unroll
        for (int p = 0; p < 3; ++p) if (p < nw) kv_dma(KW + (size_t)(j0 + p) * 4096, VW + (size_t)(j0 + p) * 4096, ring + p * 16384, w, lane);
    }
    {
        const LAS int* imp = (const LAS int*)(lds + AL_IMP);
        LAS unsigned* selm = (LAS unsigned*)(lds + AL_SEL);
        unsigned um0 = 0u, um1 = 0u;
        for (int q4 = 0; q4 < 8; q4 += 4) {
            int v[4], thr[4];
#pragma unroll
            for (int k = 0; k < 4; ++k) { v[k] = imp[lane * 65 + w * 8 + q4 + k]; thr[k] = 0;
                if (lane == 0 || lane == i || lane == i - 1) v[k] = 0x7fffffff; else if (lane > i) v[k] = -1; }
#pragma unroll
            for (int bit = 30; bit >= 0; --bit) {
#pragma unroll
                for (int k = 0; k < 4; ++k) { const int cand = thr[k] | (1 << bit); if (__popcll(__ballot(v[k] >= cand)) >= 16) thr[k] = cand; } }
#pragma unroll
            for (int k = 0; k < 4; ++k) { const int q = w * 8 + q4 + k;
                const unsigned long long gtm = __ballot(v[k] > thr[k]), eqm = __ballot(v[k] == thr[k]);
                const int need = 16 - __popcll(gtm);
                const bool sel = ((v[k] > thr[k]) || (v[k] == thr[k] && __popcll(eqm & ((1ull << lane) - 1ull)) < need)) && (lane <= i);
                const unsigned long long mk = __ballot(sel);
                if (lane == 0) { selm[q * 2] = (unsigned)mk; selm[q * 2 + 1] = (unsigned)(mk >> 32); }
                um0 |= (unsigned)mk; um1 |= (unsigned)(mk >> 32); }
        }
        if (lane == 0) { selm[128 + w * 2] = um0; selm[128 + w * 2 + 1] = um1; }
        asm volatile("s_waitcnt lgkmcnt(0)\n\ts_barrier" ::: "memory");
        stash_store(stash, oc);
        if (w == 0) {
            unsigned a0 = 0u, a1 = 0u;
#pragma unroll
            for (int k = 0; k < 8; ++k) { a0 |= selm[128 + 2 * k]; a1 |= selm[128 + 2 * k + 1]; }
            const unsigned long long um = ((unsigned long long)a1 << 32) | a0;
            LAS int* ul = (LAS int*)(lds + AL_SEL + 1024);
            if ((um >> lane) & 1ull) ul[__popcll(um & ((1ull << lane) - 1ull))] = lane;
            if (lane == 0) ul[64] = __popcll(um);
        }
    }
#define BAR_V(N) asm volatile("s_waitcnt vmcnt(" #N ")\n\ts_barrier" ::: "memory")
#define NSA_STEP(T, C0, C1, N0, N1) do { const int t_ = (T); \
        if (t_ > 0) asm volatile("s_barrier" ::: "memory");                \
        if (t_ + 3 < n_) { NSA_DMA(t_ + 3); } \
        const int tn_ = min(t_ + 1, n_ - 1); \
        NSA_INIT(tn_, N0, N1); \
        bf16x8 kf_[8], vf_[8]; \
        k_load(kf_, ring + (tn_ & 3) * 16384, r32, hi); \
        v_load(vf_, ring + (t_ & 3) * 16384 + vlane); \
        if (t_ + 3 < n_) WAITBAR(2); else WAITBAR(0);                           \
        SCHED_FENCE(); \
        lsum_ += exp_tile(C0, C1); \
        qk_mma(N0, N1, kf_, qr); \
        pv_mma(o_, vf_, C0, C1); \
    } while (0)
#define NSA_STREAM() do { \
        WAITBAR(0); \
        f32x16 a0, a1, b0, b1; \
        NSA_INIT(0, a0, a1); \
        qk_tile(a0, a1, ring, qr, r32, hi); \
        if (w >= 4) asm volatile("s_barrier" ::: "memory"); \
        _Pragma("unroll 1") for (int t = 0; t < n_; t += 2) { NSA_STEP(t, a0, a1, b0, b1); if (t + 1 < n_) NSA_STEP(t + 1, b0, b1, a0, a1); } \
        if (w < 4) asm volatile("s_barrier" ::: "memory"); \
    } while (0)
    {
        f32x16 o_[2];
#pragma unroll
        for (int r = 0; r < 16; ++r) { o_[0][r] = 0.f; o_[1][r] = 0.f; }
        float lsum_ = 0.f;
        const int n_ = nw;
#define NSA_DMA(tt) kv_dma(KW + (size_t)(j0 + (tt)) * 4096, VW + (size_t)(j0 + (tt)) * 4096, ring + ((tt) & 3) * 16384, w, lane)
#define NSA_INIT(tt, S0, S1) init_direct(S0, S1, lutw + (639 - (tq - 64 * (j0 + (tt)) - 4 * hi)))
        NSA_STREAM();
#undef NSA_DMA
#undef NSA_INIT
        lsum_ += __shfl_xor(lsum_, 32); const float sc = g_w / lsum_;
        f32x16 ot[2]; stash_load(stash, ot);
#pragma unroll
        for (int r = 0; r < 16; ++r) { ot[0][r] += sc * o_[0][r]; ot[1][r] += sc * o_[1][r]; }
        stash_store(stash, ot);
    }
    WAITBAR(0);
    f32x16 ot[2];
    {
        const LAS unsigned* selm = (const LAS unsigned*)(lds + AL_SEL);
        const LAS int* ul = (const LAS int*)(lds + AL_SEL + 1024);
        const int n_ = __builtin_amdgcn_readfirstlane(ul[64]);
        const int ulv = ul[lane];
        const unsigned sm0 = selm[(32 * qh + r32) * 2], sm1 = selm[(32 * qh + r32) * 2 + 1];
        f32x16 o_[2];
#pragma unroll
        for (int r = 0; r < 16; ++r) { o_[0][r] = 0.f; o_[1][r] = 0.f; }
        float lsum_ = 0.f;
#define NSA_DMA(tt) do { const int jn_ = __builtin_amdgcn_readlane(ulv, (tt)); kv_dma(KS + (size_t)jn_ * 4096, VS + (size_t)jn_ * 4096, ring + ((tt) & 3) * 16384, w, lane); } while (0)
#define NSA_INIT(tt, S0, S1) do { const int jA_ = __builtin_amdgcn_readlane(ulv, (tt)); \
            const bool selbit_ = (jA_ < 32) ? ((sm0 >> jA_) & 1u) : ((sm1 >> (jA_ - 32)) & 1u); \
            if (t0 + 32 * qh - (64 * jA_ + 63) >= 1513) { const float c_ = selbit_ ? cfar : NEGF; \
                _Pragma("unroll") for (int r = 0; r < 16; ++r) { S0[r] = c_; S1[r] = c_; } } \
            else init_direct(S0, S1, selbit_ ? (luts + ((LUTN - 1) - (tq - 64 * jA_ - 4 * hi))) : negp); } while (0)
        for (int p = 0; p < 3; ++p) if (p < n_) NSA_DMA(p);
        NSA_STREAM();
#undef NSA_DMA
#undef NSA_INIT
        lsum_ += __shfl_xor(lsum_, 32); const float sc = g_s / lsum_;
        stash_load(stash, ot);
#pragma unroll
        for (int r = 0; r < 16; ++r) { ot[0][r] += sc * o_[0][r]; ot[1][r] += sc * o_[1][r]; }
    }
#undef NSA_STEP
#undef NSA_STREAM
    store_o32((bf16_t*)(ws + WS_U) + (size_t)(b * SEQ + tq) * DM + head * 64 + 8 * hi, ot, 1.0f);
    { float sq = 0.f;
#pragma unroll
      for (int r = 0; r < 16; ++r) sq += ot[0][r] * ot[0][r] + ot[1][r] * ot[1][r];
      sq += __shfl_xor(sq, 32);
      if (hi == 0) ((float*)(ws + WS_SSA))[(size_t)(b * SEQ + tq) * 8 + head] = sq; }
}

constexpr int AL_DLUT2 = LDSCTL_OFF + 12288;
static_assert(AL_DLUT2 + 2 * 384 * 4 <= LDS_BYTES && AL_STB + 2 * 4096 <= AL_DLUT2, "dilated LUT images");
struct DilP { int dil, res, n, br, head, b; size_t hoff; };
__device__ __forceinline__ DilP dil_params(int u, int half) {
    DilP p; const int pair = u & 15; p.br = (u >> 4) % 3; p.head = (u / 48) & 7; p.b = u / 384;
    p.dil = (p.br == 0) ? 1 : (p.br == 1) ? 4 : 16; const int nb = 32 / p.dil, beta = 2 * pair + half; p.res = beta / nb; p.n = beta % nb;
    p.hoff = (size_t)(p.b * 8 + p.head) * SEQ * 64; return p;
}
#define DIL_UNIT_OF(q_) (48 * (X + 8 * ((q_) / 48)) + (q_) % 48)
__device__ __forceinline__ void dil_stream(const Frame& F, int L, int X, int q0, int qs, int cnt) {
    if (cnt <= 0) return;
    LAS char* lds = (LAS char*)F.lds;
    int tid_l = F.tid; asm volatile("" : "+v"(tid_l));
    const int tid = tid_l, lane = tid & 63, w = __builtin_amdgcn_readfirstlane(tid >> 6), r32 = lane & 31, hi = lane >> 5;
    const int half = w >> 2, wh = w & 3;
    unsigned char* ws = F.ws;
    const bf16_t *Qb = (const bf16_t*)(ws + WS_QB), *Kb = (const bf16_t*)(ws + WS_KB), *Vb = (const bf16_t*)(ws + WS_VB);
    const float* LUTL = (const float*)(ws + WS_LUT) + (size_t)(L * 16 + 8) * LUTN;
    const float bshift = ((const float*)(ws + WS_BSH))[L];
    const int th = tid & 255;
    LAS float* lutd = (LAS float*)(lds + LDSCTL_OFF + 4096 + half * 3072);
    LAS char* kvb = lds + half * 65536;
    const int voff = 8192 + ((lane >> 4) & 1) * 32 + (lane & 3) * 8 + (4 * hi + ((lane & 15) >> 2)) * 64;
    int koff[4];
#pragma unroll
    for (int d0 = 0; d0 < 4; ++d0) koff[d0] = r32 * 128 + (((2 * d0 + hi) ^ ((r32 >> 1) & 7)) * 16);
    const int T = 4 * cnt;
    DilP cur = dil_params(DIL_UNIT_OF(q0), half), nxt = dil_params(DIL_UNIT_OF(q0 + (cnt > 1 ? qs : 0)), half);
    bf16x8 qr[4], qn[4]; float lutv0, lutv1;
#define DIL_QLOAD(dst, P) do { const bf16_t* Qp_ = Qb + (P).hoff + (size_t)((128 * (P).n + 32 * wh + r32) * (P).dil + (P).res) * 64; \
        _Pragma("unroll") for (int d0 = 0; d0 < 4; ++d0) dst[d0] = *(const bf16x8*)(Qp_ + d0 * 16 + hi * 8); } while (0)
#define DIL_LUTV(P, e_) (((e_) < 321) ? (((224 - (e_)) < 0 || (224 - (e_)) > 128) ? NEGF : LUTL[(size_t)(P).head * LUTN + min((224 - (e_)) * (P).dil, LUTN - 1)]) : 0.f)
#define DIL_DMA(P, tt_, slot_) do { const int Pk0_ = 128 * ((P).n - 1) + 64 * (tt_); \
        const int kg_ = 8 * wh + (lane >> 3), ka_ = max(Pk0_ + kg_, 0), kb_ = max(Pk0_ + kg_ + 32, 0), kv_ = max(Pk0_ + wh * 16 + (lane >> 2), 0); \
        const int sw_ = ((lane & 7) ^ ((kg_ >> 1) & 7)) * 8; \
        const bf16_t* ksa_ = Kb + (P).hoff + (size_t)(ka_ * (P).dil + (P).res) * 64 + sw_; \
        const bf16_t* ksb_ = Kb + (P).hoff + (size_t)(kb_ * (P).dil + (P).res) * 64 + sw_; \
        const bf16_t* vs_ = Vb + (P).hoff + (size_t)(kv_ * (P).dil + (P).res) * 64 + (lane & 3) * 8; \
        const unsigned base_ = (unsigned)__builtin_amdgcn_readfirstlane((int)(unsigned)(size_t)(kvb + (slot_) * 16384 + wh * 1024)); \
        glds16(ksa_, base_); glds16(ksb_, base_ + 4096u); glds16(vs_, base_ + 8192u); glds16(vs_ + 32, base_ + 12288u); } while (0)
    __syncthreads();
    DIL_DMA(cur, 0, 0); DIL_DMA(cur, 1, 1); DIL_DMA(cur, 2, 2);
    DIL_QLOAD(qr, cur); lutv0 = DIL_LUTV(cur, th); lutv1 = DIL_LUTV(cur, th + 256);
    lutd[th] = lutv0; if (th < 65) lutd[th + 256] = lutv1;
    if (half == 1) asm volatile("s_waitcnt lgkmcnt(0)\n\ts_barrier" ::: "memory");
    f32x16 o[2];
#pragma unroll
    for (int r = 0; r < 16; ++r) { o[0][r] = 0.f; o[1][r] = 0.f; }
    float lsum = 0.f;
#pragma unroll 1
    for (int k = 0; k < cnt; ++k) {
        const bool more = (k + 1 < cnt);
        const LAS float* lut = lutd + (k & 1) * 384;
        const int tt0 = (cur.n == 0) ? 2 : 0;
#pragma unroll
        for (int tt = 0; tt < 4; ++tt) {
            const int sg = 4 * k + tt;
            if (sg + 2 < T) WAITBAR(8); else if (sg + 1 < T) WAITBAR(4); else WAITBAR(0);
            if (tt == 2 && more) { DIL_QLOAD(qn, nxt); lutv0 = DIL_LUTV(nxt, th); lutv1 = DIL_LUTV(nxt, th + 256); }
            if (tt == 0) DIL_DMA(cur, 3, 3);
            else if (more) DIL_DMA(nxt, tt - 1, tt - 1);
            const int ndmax = 128 + 32 * wh + 31 - 64 * tt, ndmin = 128 + 32 * wh - 64 * tt - 63;
            const bool act = (tt >= tt0 && ndmax >= 0 && ndmin <= 128);
            f32x16 p0, p1; bf16x8 vf[8];
            const bool u0 = !((wh == 1 && tt == 0) || (wh == 3 && tt == 1)), u1 = !((wh == 0 && tt == 2) || (wh == 2 && tt == 3));
            if (act) {
                const LAS char* buf = kvb + tt * 16384; const LAS float* lb = lut + (224 - (128 + 32 * wh + r32 - 64 * tt - 4 * hi));
                if (u0) {
#pragma unroll
                    for (int r = 0; r < 16; ++r) p0[r] = lb[(r & 3) + 8 * (r >> 2)];
#pragma unroll
                    for (int d0 = 0; d0 < 4; ++d0) p0 = mfma32(*(const LAS bf16x8*)(buf + koff[d0]), qr[d0], p0);
#pragma unroll
                    for (int db = 0; db < 2; ++db)
#pragma unroll
                        for (int ks = 0; ks < 2; ++ks) { const s16x4 lo = vtr(buf + voff + db * 4096 + ks * 1024), hh = vtr(buf + voff + db * 4096 + ks * 1024 + 512);
                            vf[db * 4 + ks] = (bf16x8){lo[0], lo[1], lo[2], lo[3], hh[0], hh[1], hh[2], hh[3]}; }
                }
                if (u1) {
#pragma unroll
                    for (int r = 0; r < 16; ++r) p1[r] = lb[(r & 3) + 8 * (r >> 2) + 32];
#pragma unroll
                    for (int d0 = 0; d0 < 4; ++d0) p1 = mfma32(*(const LAS bf16x8*)(buf + koff[d0] + 4096), qr[d0], p1);
#pragma unroll
                    for (int db = 0; db < 2; ++db)
#pragma unroll
                        for (int ks = 2; ks < 4; ++ks) { const s16x4 lo = vtr(buf + voff + db * 4096 + ks * 1024), hh = vtr(buf + voff + db * 4096 + ks * 1024 + 512);
                            vf[db * 4 + ks] = (bf16x8){lo[0], lo[1], lo[2], lo[3], hh[0], hh[1], hh[2], hh[3]}; }
                }
            }
            SCHED_FENCE(); asm volatile("s_barrier" ::: "memory"); SCHED_FENCE();
            if (act) {
                if (u0) { float rs = 0.f;
#pragma unroll
                    for (int r = 0; r < 16; ++r) { p0[r] = fexp2(p0[r]); rs += p0[r]; }
                    lsum += rs;
                    const bf16x8 pa = pack8(p0, 0), pb = pack8(p0, 1);
                    o[0] = mfma32(vf[0], pa, o[0]); o[1] = mfma32(vf[4], pa, o[1]); o[0] = mfma32(vf[1], pb, o[0]); o[1] = mfma32(vf[5], pb, o[1]); }
                if (u1) { float rs = 0.f;
#pragma unroll
                    for (int r = 0; r < 16; ++r) { p1[r] = fexp2(p1[r]); rs += p1[r]; }
                    lsum += rs;
                    const bf16x8 pa = pack8(p1, 0), pb = pack8(p1, 1);
                    o[0] = mfma32(vf[2], pa, o[0]); o[1] = mfma32(vf[6], pa, o[1]); o[0] = mfma32(vf[3], pb, o[0]); o[1] = mfma32(vf[7], pb, o[1]); }
            }
        }
        {
            const float lt = lsum + __shfl_xor(lsum, 32), linv = 1.0f / lt;
            const size_t tok = (size_t)cur.b * SEQ + (size_t)((128 * cur.n + 32 * wh + r32) * cur.dil + cur.res);
            if (hi == 0) ((float*)(ws + WS_LSE))[(tok * 3 + cur.br) * 8 + cur.head] = (bshift + __log2f(lt)) * LN2;
            store_o8(ws + WS_OB + (tok * 3 + cur.br) * 512 + cur.head * 64 + 8 * hi, o, linv * OB8_SCALE);
#pragma unroll
            for (int r = 0; r < 16; ++r) { o[0][r] = 0.f; o[1][r] = 0.f; }
            lsum = 0.f;
        }
        if (more) {
#pragma unroll
            for (int d0 = 0; d0 < 4; ++d0) qr[d0] = qn[d0];
            lutd[((k + 1) & 1) * 384 + th] = lutv0; if (th < 65) lutd[((k + 1) & 1) * 384 + th + 256] = lutv1;
            cur = nxt; nxt = dil_params(DIL_UNIT_OF(q0 + ((k + 2 < cnt) ? (k + 2) : (k + 1)) * qs), half);
        }
    }
    if (half == 0) asm volatile("s_barrier" ::: "memory");
#undef DIL_QLOAD
#undef DIL_UNIT_OF
#undef DIL_LUTV
#undef DIL_DMA
}

__device__ __forceinline__ void norm_row(const float* xrow, const float* gain, bf16_t* orow, int lane, f32x4 (&v)[4]) {
    float s = 0.f;
#pragma unroll
    for (int j = 0; j < 4; ++j) { v[j] = *(const f32x4*)(xrow + 4 * lane + 256 * j); s += (v[j][0] * v[j][0] + v[j][1] * v[j][1]) + (v[j][2] * v[j][2] + v[j][3] * v[j][3]); }
    const float rstd = __builtin_amdgcn_rsqf(wave_sum(s) * (1.0f / DM) + RMS_EPS);
#pragma unroll
    for (int j = 0; j < 4; ++j) { const f32x4 gg = *(const f32x4*)(gain + 4 * lane + 256 * j); v[j] = v[j] * rstd * gg;
        u32x2 o; o.x = pk2(v[j][0], v[j][1]); o.y = pk2(v[j][2], v[j][3]); *(u32x2*)(orow + 4 * lane + 256 * j) = o; }
}

__device__ __forceinline__ void norm_row_b(const bf16_t* xrow, const float* gain, bf16_t* orow, int lane, f32x4 (&v)[4]) {
    float s = 0.f;
#pragma unroll
    for (int j = 0; j < 4; ++j) { const u32x2 a = *(const u32x2*)(xrow + 4 * lane + 256 * j); v[j] = (f32x4){bflo(a.x), bfhi(a.x), bflo(a.y), bfhi(a.y)}; s += (v[j][0] * v[j][0] + v[j][1] * v[j][1]) + (v[j][2] * v[j][2] + v[j][3] * v[j][3]); }
    const float rstd = __builtin_amdgcn_rsqf(wave_sum(s) * (1.0f / DM) + RMS_EPS);
#pragma unroll
    for (int j = 0; j < 4; ++j) { const f32x4 gg = *(const f32x4*)(gain + 4 * lane + 256 * j); v[j] = v[j] * rstd * gg;
        *(unsigned*)((unsigned char*)orow + 4 * lane + 256 * j) = pk4_fp8(v[j][0] * FP8_ASCALE, v[j][1] * FP8_ASCALE, v[j][2] * FP8_ASCALE, v[j][3] * FP8_ASCALE); }
}
template <int RB> __device__ __forceinline__ void norm_rows(const float* X, const float* gain, bf16_t* U, int m0, int mstride, int lane) {
    f32x4 v[RB][4];
#pragma unroll
    for (int r = 0; r < RB; ++r)
#pragma unroll
        for (int j = 0; j < 4; ++j) v[r][j] = __builtin_nontemporal_load((const f32x4*)(X + (size_t)(m0 + r * mstride) * DM + 4 * lane + 256 * j));
    f32x4 gg[4];
#pragma unroll
    for (int j = 0; j < 4; ++j) gg[j] = *(const f32x4*)(gain + 4 * lane + 256 * j);
#pragma unroll
    for (int r = 0; r < RB; ++r) {
        float s2 = 0.f;
#pragma unroll
        for (int j = 0; j < 4; ++j) s2 += (v[r][j][0] * v[r][j][0] + v[r][j][1] * v[r][j][1]) + (v[r][j][2] * v[r][j][2] + v[r][j][3] * v[r][j][3]);
        const float rstd = __builtin_amdgcn_rsqf(wave_sum(s2) * (1.0f / DM) + RMS_EPS);
        bf16_t* orow = U + (size_t)(m0 + r * mstride) * DM;
#pragma unroll
        for (int j = 0; j < 4; ++j) { const f32x4 x = v[r][j] * rstd * gg[j]; u32x2 o; o.x = pk2(x[0], x[1]); o.y = pk2(x[2], x[3]); *(u32x2*)(orow + 4 * lane + 256 * j) = o; }
    }
}

__device__ __forceinline__ void moe_combine(unsigned char* ws, float* out, int ncw, int cw0, bool want_tail) {
    const bf16_t* HB = (const bf16_t*)(ws + WS_HB);
    int tid_l_ = threadIdx.x; asm volatile("" : "+v"(tid_l_)); const int lane = tid_l_ & 63, wave = __builtin_amdgcn_readfirstlane(tid_l_ >> 6), cw = cw0 + wave;
    const int* tokpos = (const int*)(ws + RT_TOKPOS); const float* topG = (const float*)(ws + RT_TOPG); const bf16_t* Y = (const bf16_t*)(ws + WS_VSORT);
    for (int mb = cw; mb < MTOK; mb += 2 * ncw) {
        int pa[2], pb2[2]; float ga[2], gb[2]; bool act[2];
#pragma unroll
        for (int r = 0; r < 2; ++r) { const int m = mb + r * ncw; act[r] = (m < MTOK); const int mm = act[r] ? m : 0; pa[r] = tokpos[mm * 2]; pb2[r] = tokpos[mm * 2 + 1]; ga[r] = topG[mm * 2]; gb[r] = topG[mm * 2 + 1];
            act[r] = act[r] && (((pa[r] >= 65536) || (pb2[r] >= 65536)) == want_tail); }
        if (!(act[0] || act[1])) continue;
        u32x2 hv[2][4]; u32x2 ya[2][4], yb[2][4];
#pragma unroll
        for (int r = 0; r < 2; ++r) if (act[r]) { const int m = mb + r * ncw; const bf16_t* o = HB + (size_t)m * DM; const bf16_t* y0 = Y + (size_t)pa[r] * DM; const bf16_t* y1 = Y + (size_t)pb2[r] * DM;
#pragma unroll
            for (int j = 0; j < 4; ++j) { const int c = 4 * lane + 256 * j; hv[r][j] = __builtin_nontemporal_load((const u32x2*)(o + c)); ya[r][j] = __builtin_nontemporal_load((const u32x2*)(y0 + c)); yb[r][j] = __builtin_nontemporal_load((const u32x2*)(y1 + c)); } }
#pragma unroll
        for (int r = 0; r < 2; ++r) if (act[r]) { const int m = mb + r * ncw; float* o = out + (size_t)m * DM; const float g0 = ga[r], g1 = gb[r];
#pragma unroll
            for (int j = 0; j < 4; ++j) { const int c = 4 * lane + 256 * j; const u32x2 hb = hv[r][j]; f32x4 v = (f32x4){bflo(hb.x), bfhi(hb.x), bflo(hb.y), bfhi(hb.y)}; const u32x2 a = ya[r][j], b = yb[r][j];
                v[0] += g0 * bflo(a.x) + g1 * bflo(b.x); v[1] += g0 * bfhi(a.x) + g1 * bfhi(b.x); v[2] += g0 * bflo(a.y) + g1 * bflo(b.y); v[3] += g0 * bfhi(a.y) + g1 * bfhi(b.y);
                __builtin_nontemporal_store(v, (f32x4*)(o + c)); } }
    }
}

template <int RB, bool FP8OUT = false> __device__ __forceinline__ void norm_rows_b(const bf16_t* X, const float* gain, void* Uv, int m0, int mstride, int lane) {
    bf16_t* U = (bf16_t*)Uv;
    u32x4 x[RB][2];
#pragma unroll
    for (int r = 0; r < RB; ++r)
#pragma unroll
        for (int j = 0; j < 2; ++j) x[r][j] = *(const u32x4*)(X + (size_t)(m0 + r * mstride) * DM + 8 * lane + 512 * j);
    f32x4 gg[2][2];
#pragma unroll
    for (int j = 0; j < 2; ++j) { gg[j][0] = *(const f32x4*)(gain + 8 * lane + 512 * j); gg[j][1] = *(const f32x4*)(gain + 8 * lane + 512 * j + 4); }
#pragma unroll
    for (int r = 0; r < RB; ++r) {
        float v[2][8]; float s2 = 0.f;
#pragma unroll
        for (int j = 0; j < 2; ++j) { const u32x4 a = x[r][j]; v[j][0] = bflo(a.x); v[j][1] = bfhi(a.x); v[j][2] = bflo(a.y); v[j][3] = bfhi(a.y); v[j][4] = bflo(a.z); v[j][5] = bfhi(a.z); v[j][6] = bflo(a.w); v[j][7] = bfhi(a.w);
#pragma unroll
            for (int c = 0; c < 8; ++c) s2 += v[j][c] * v[j][c]; }
        const float rstd = __builtin_amdgcn_rsqf(wave_sum(s2) * (1.0f / DM) + RMS_EPS);
        if constexpr (FP8OUT) { unsigned char* orow = (unsigned char*)Uv + (size_t)(m0 + r * mstride) * DM; const float rs = rstd * FP8_ASCALE;
#pragma unroll
            for (int j = 0; j < 2; ++j) { u32x2 o; o.x = pk4_fp8(v[j][0] * rs * gg[j][0][0], v[j][1] * rs * gg[j][0][1], v[j][2] * rs * gg[j][0][2], v[j][3] * rs * gg[j][0][3]);
                o.y = pk4_fp8(v[j][4] * rs * gg[j][1][0], v[j][5] * rs * gg[j][1][1], v[j][6] * rs * gg[j][1][2], v[j][7] * rs * gg[j][1][3]); *(u32x2*)(orow + 8 * lane + 512 * j) = o; } }
        else { bf16_t* orow = U + (size_t)(m0 + r * mstride) * DM;
#pragma unroll
        for (int j = 0; j < 2; ++j) { u32x4 o; o.x = pk2(v[j][0] * rstd * gg[j][0][0], v[j][1] * rstd * gg[j][0][1]); o.y = pk2(v[j][2] * rstd * gg[j][0][2], v[j][3] * rstd * gg[j][0][3]);
            o.z = pk2(v[j][4] * rstd * gg[j][1][0], v[j][5] * rstd * gg[j][1][1]); o.w = pk2(v[j][6] * rstd * gg[j][1][2], v[j][7] * rstd * gg[j][1][3]); *(u32x4*)(orow + 8 * lane + 512 * j) = o; } }
    }
}

__device__ __forceinline__ void combine4(unsigned char* ws, const float* og, int lane, int mb, int mstr) {
    bf16_t* ON = (bf16_t*)(ws + WS_U);
    const float* SSA = (const float*)(ws + WS_SSA); float* RA = (float*)(ws + WS_RA); const unsigned char* OB8 = ws + WS_OB; const float* LSE = (const float*)(ws + WS_LSE);
    const f32x4 gb0 = *(const f32x4*)(og + 512 + 8 * lane), gb1 = *(const f32x4*)(og + 512 + 8 * lane + 4);
    const int hd = lane >> 3;
                f32x4 sa0[4], sa1[4]; u32x2 x0[4], x1[4], x2[4]; float q0[4], q1[4], q2[4];
#pragma unroll
                for (int r = 0; r < 4; ++r) { const size_t m = (size_t)(mb + r * mstr);
                    sa0[r] = *(const f32x4*)(SSA + m * 8); sa1[r] = *(const f32x4*)(SSA + m * 8 + 4);
                    x0[r] = *(const u32x2*)(OB8 + (m * 3 + 0) * 512 + 8 * lane); x1[r] = *(const u32x2*)(OB8 + (m * 3 + 1) * 512 + 8 * lane); x2[r] = *(const u32x2*)(OB8 + (m * 3 + 2) * 512 + 8 * lane);
                    q0[r] = LSE[(m * 3 + 0) * 8 + hd]; q1[r] = LSE[(m * 3 + 1) * 8 + hd]; q2[r] = LSE[(m * 3 + 2) * 8 + hd]; }
#pragma unroll
                for (int r = 0; r < 4; ++r) { const size_t m = (size_t)(mb + r * mstr);
                    const float msa = (((sa0[r][0] + sa0[r][1]) + (sa0[r][2] + sa0[r][3])) + ((sa1[r][0] + sa1[r][1]) + (sa1[r][2] + sa1[r][3]))) * (1.0f / 512.0f) + RMS_EPS;
                    const float rms_a = __builtin_sqrtf(msa);
                    if (lane == 0) RA[m] = 1.0f / rms_a;
                    { const float l0 = q0[r], l1 = q1[r], l2 = q2[r];
                      const float mx = fmaxf(l0, fmaxf(l1, l2)); const float e0 = __expf(l0 - mx), e1 = __expf(l1 - mx), e2 = __expf(l2 - mx); const float inv = __builtin_amdgcn_rcpf(e0 + e1 + e2);
                      const float w0 = e0 * inv * (1.0f / OB8_SCALE), w1 = e1 * inv * (1.0f / OB8_SCALE), w2 = e2 * inv * (1.0f / OB8_SCALE);
                      const u32x2 a0 = x0[r], a1 = x1[r], a2 = x2[r];
                      float v[8];
#pragma unroll
                      for (int h2 = 0; h2 < 2; ++h2) { const int d0 = h2 ? (int)a0.y : (int)a0.x, d1 = h2 ? (int)a1.y : (int)a1.x, d2 = h2 ? (int)a2.y : (int)a2.x;
                          const f32x2 p0 = __builtin_amdgcn_cvt_pk_f32_fp8(d0, false), p1 = __builtin_amdgcn_cvt_pk_f32_fp8(d0, true), q0_ = __builtin_amdgcn_cvt_pk_f32_fp8(d1, false), q1_ = __builtin_amdgcn_cvt_pk_f32_fp8(d1, true),
                                      t0 = __builtin_amdgcn_cvt_pk_f32_fp8(d2, false), t1 = __builtin_amdgcn_cvt_pk_f32_fp8(d2, true);
                          v[4 * h2 + 0] = w0 * p0[0] + w1 * q0_[0] + w2 * t0[0]; v[4 * h2 + 1] = w0 * p0[1] + w1 * q0_[1] + w2 * t0[1];
                          v[4 * h2 + 2] = w0 * p1[0] + w1 * q1_[0] + w2 * t1[0]; v[4 * h2 + 3] = w0 * p1[1] + w1 * q1_[1] + w2 * t1[1]; }
                      float s2 = 0.f;
#pragma unroll
                      for (int c = 0; c < 8; ++c) s2 += v[c] * v[c];
                      const float rstd = __builtin_amdgcn_rsqf(wave_sum(s2) * (1.0f / 512.0f) + RMS_EPS) * rms_a;
                      u32x4 o; o.x = pk2(v[0] * rstd * gb0[0], v[1] * rstd * gb0[1]); o.y = pk2(v[2] * rstd * gb0[2], v[3] * rstd * gb0[3]); o.z = pk2(v[4] * rstd * gb1[0], v[5] * rstd * gb1[1]); o.w = pk2(v[6] * rstd * gb1[2], v[7] * rstd * gb1[3]);
                      *(u32x4*)(ON + m * DM + 512 + 8 * lane) = o; }
                }
}

__global__ void __launch_bounds__(NTHR, 2) trunk_fwd(Args args) {
    extern __shared__ __attribute__((aligned(16))) unsigned char lds_raw[];
    Frame F;
    F.lds = (LAS unsigned char*)lds_raw;
    F.tid = threadIdx.x; F.lane = F.tid & 63; F.wave = __builtin_amdgcn_readfirstlane(F.tid >> 6);
    F.G = gridDim.x; F.wg = blockIdx.x; F.ws = args.ws; F.in = args.in; F.out = args.out;
    unsigned char* ws = args.ws;
    volatile LAS unsigned* MISC = (volatile LAS unsigned*)(F.lds + LDSCTL_OFF);
    for (int u = F.tid; u < (LDS_BYTES - LDSCTL_OFF) / 4; u += NTHR) ((LAS unsigned*)(F.lds + LDSCTL_OFF))[u] = 0u;
    __syncthreads();
    unsigned* ctl = (unsigned*)(ws + WS_CTL);
    XcdBarrier bar; bar.bar = ctl + CW_BAR + args.li * 4096; bar.x = 0; bar.st = nullptr;
    if (!MK_MULTI) bar = xcd_barrier_post(ctl + CW_BAR + args.li * 4096, MISC + 8);
    const int lo = args.ph_lo, hi_ = args.ph_hi;
#define IN(k) (lo <= (k) && (k) < hi_)
#define EN(g) (((PHMASK) >> (g)) & 1u)
#define NREP(g) ((((PROBE_DUP) >> (g)) & 1u) && L == 0 ? 2 : 1)
#define NREPX(g) ((((PROBE_DUP) >> (g)) & 1u) ? 2 : 1)
#define SEAM(k) SEAM_(k, 0)
#define SEAM_(k, MP) do { if (IN(k) && IN((k) + 1)) { if (MP && ((PROBE_MEAN >> (k)) & 1ull)) { const unsigned own_ = (unsigned)__builtin_amdgcn_s_memrealtime() - tprev_; if (threadIdx.x == 0) __hip_atomic_store(ctl + 16384 + (k) * 256 + F.wg, own_, RLX_AGENT); } \
        if ((PROBE_TM >> (k)) & 1ull) { const unsigned t1_ = (unsigned)__builtin_amdgcn_s_memrealtime(); while ((unsigned)__builtin_amdgcn_s_memrealtime() - t1_ < t1_ - tprev_) __builtin_amdgcn_s_sleep(8); } \
        xcd_barrier(bar); if (PROBE_BAR) xcd_barrier(bar); if ((PROBE_SLP >> (k)) & 1ull) { const unsigned t2_ = (unsigned)__builtin_amdgcn_s_memrealtime(); while ((unsigned)__builtin_amdgcn_s_memrealtime() - t2_ < 10000u) __builtin_amdgcn_s_sleep(8); } if (MP && ((PROBE_MEAN >> (k)) & 1ull)) { unsigned sm_ = 0u; int l0_ = (int)(threadIdx.x & 63); asm volatile("" : "+v"(l0_)); for (int j_ = l0_; j_ < 256; j_ += 64) sm_ += __hip_atomic_load(ctl + 16384 + (k) * 256 + j_, RLX_AGENT); \
            for (int o_ = 1; o_ < 64; o_ <<= 1) sm_ += __shfl_xor(sm_, o_); const unsigned mean_ = sm_ >> 8, t3_ = (unsigned)__builtin_amdgcn_s_memrealtime(); while ((unsigned)__builtin_amdgcn_s_memrealtime() - t3_ < mean_) __builtin_amdgcn_s_sleep(8); } \
        if (PROBE_TM != 0ull || PROBE_MEAN != 0ull) tprev_ = (unsigned)__builtin_amdgcn_s_memrealtime(); } } while (0)
    unsigned tprev_ = (PROBE_TM != 0ull || PROBE_MEAN != 0ull) ? (unsigned)__builtin_amdgcn_s_memrealtime() : 0u;
    const int NGW = F.G * NWAVES;
#define LAUNDER int tid_l_ = threadIdx.x; asm volatile("" : "+v"(tid_l_)); const int tid = tid_l_, lane = tid & 63, wave = __builtin_amdgcn_readfirstlane(tid >> 6), gw = F.wg * NWAVES + wave; (void)gw; (void)lane; (void)wave;

    if (EN(0) && IN(0)) { LAUNDER;
        LAS float* scr = (LAS float*)(F.lds + wave * 16384);
        for (int rep = 0; rep < NREPX(0); ++rep) {
            conv_blocks(args.in, ws, 0, true, scr, gw, NGW, lane);
            conv_gateup_f8(args.in[I_FG], args.in[I_FU], DM, DFF, ws + WS_WF1, scr, gw, NGW, lane);
        }
        { int* rowtok = (int*)(ws + RT_ROWTOK); for (int k = F.wg * NTHR + tid; k < MOE_ROWS_MAX; k += F.G * NTHR) rowtok[k] = -1; }
        { LAS float* bsh = (LAS float*)(F.lds + 8 * 16384);
          if (wave == 0) { const float* rb = args.in[I_RELB]; float bm = 0.f;
              for (int k = lane; k < 512; k += 64) bm = fmaxf(bm, fabsf(rb[k]));
              for (int L = 0; L < 2; ++L) { float gq = fmaxf(fabsf(args.in[I_QN][L * 64 + lane]), fabsf(args.in[I_DQN][L * 64 + lane]));
                  float gk = fmaxf(fmaxf(fabsf(args.in[I_KN][L * 192 + lane]), fabsf(args.in[I_KN][L * 192 + 64 + lane])), fmaxf(fabsf(args.in[I_KN][L * 192 + 128 + lane]), fabsf(args.in[I_DKN][L * 64 + lane])));
                  float bb = bm;
#pragma unroll
                  for (int o = 1; o < 64; o <<= 1) { gq = fmaxf(gq, __shfl_xor(gq, o)); gk = fmaxf(gk, __shfl_xor(gk, o)); bb = fmaxf(bb, __shfl_xor(bb, o)); }
                  const float B = (8.0f * LOG2E * gq * gk + LOG2E * bb) * 1.002f + 0.05f;
                  if (lane == 0) { bsh[L] = B; if (F.wg == 0) ((float*)(ws + WS_BSH))[L] = B; } } }
          __syncthreads();
          float* LUT = (float*)(ws + WS_LUT); const float* rb = args.in[I_RELB];
          for (int k = F.wg * NTHR + tid; k < 2 * 16 * LUTN; k += F.G * NTHR) { const int L = k / (16 * LUTN), h = (k / LUTN) & 15, d = k % LUTN; int bk;
              if (d < 16) bk = d; else { bk = 16; bk += (d >= 22); bk += (d >= 30); bk += (d >= 40); bk += (d >= 54); bk += (d >= 73); bk += (d >= 99); bk += (d >= 134); bk += (d >= 182);
                  bk += (d >= 246); bk += (d >= 332); bk += (d >= 450); bk += (d >= 609); bk += (d >= 825); bk += (d >= 1117); bk += (d >= 1513); }
              LUT[k] = rb[bk * 16 + h] * LOG2E - bsh[L]; } }
        { float* B1P = (float*)(ws + WS_B1P);
          for (int it = F.wg; it < 2 * 2 * 16 * 4; it += F.G) if (wave == (it & 7)) { const int cg = it & 3, s = (it >> 2) & 15, lk = it >> 6, pp = lane >> 4, c4 = (lane & 15) * 4;
              const float* pos = args.in[I_CPOS] + (size_t)lk * 2048 + s * 128 + pp; const float* w1 = args.in[I_CW1] + (size_t)lk * 2048 * 256 + (size_t)(s * 128 + pp) * 256 + cg * 64 + c4;
              f32x4 a = {0.f, 0.f, 0.f, 0.f};
#pragma unroll
              for (int i = 0; i < 32; ++i) a += *(const f32x4*)(w1 + (size_t)i * 4 * 256) * pos[4 * i];
#pragma unroll
              for (int c = 0; c < 4; ++c) { a[c] += __shfl_xor(a[c], 16); a[c] += __shfl_xor(a[c], 32); }
              if (pp == 0) *(f32x4*)(B1P + ((size_t)lk * 16 + s) * 256 + cg * 64 + c4) = a; } }
    }

    for (int L = 0; L < 2; ++L) {
        const int pb = 1 + 10 * L;
        bf16_t* HB = (bf16_t*)(ws + WS_HB);
        if (EN(1) && IN(pb + 0) && L == 0) { LAUNDER;
            bf16_t* U = (bf16_t*)(ws + WS_U); const float* gain = args.in[I_ANORM] + L * DM;
            for (int rep = 0; rep < NREP(1); ++rep) for (int m = gw; m < MTOK; m += 8 * NGW) norm_rows<8>(args.in[I_X], gain, U, m, NGW, lane);
        }
        if (L == 0) SEAM(pb + 0);
        if (EN(2) && IN(pb + 1)) {
            { LAUNDER;
            if (F.wg == 0) { const int kv = tid >> 8, j = tid & 255; const float* B1P = (const float*)(ws + WS_B1P) + (size_t)(L * 2 + kv) * 16 * 256;
                float a = args.in[I_CB1][(L * 2 + kv) * 256 + j];
                for (int s = 0; s < 16; ++s) a += B1P[s * 256 + j];
                ((float*)(ws + WS_B1E))[(L * 2 + kv) * 256 + j] = a; }
            }
            pg8::Dims g{DM, DM, DM}; pg8::StaticOrder S; S.init(MTOK, INP, F.G, F.wg, L == 0 ? ws + WS_U : ws + WS_HB, (bf16_t*)(ws + WS_WIN) + (size_t)L * INP * DM, DM, DM);
            EpiInProj E{ws, args.in[I_QN] + L * 64, args.in[I_KN] + L * 192, args.in[I_DQN] + L * 64, args.in[I_DKN] + L * 64, L == 1 ? (const float*)(ws + WS_SS) : nullptr};
            for (int rep = 0; rep < NREP(2); ++rep) pg8::gemm_phase<EpiInProj, pg8::StaticOrder, true, 11>(F.lds, g, S, E);
        }
        SEAM(pb + 1);
        if (IN(pb + 2)) {
            if (F.wg < 32) {
                if (EN(3)) {
                    pg8::Dims g{2048, 1024, 2048}; SchedCmp S{F.wg, (const char*)(ws + WS_KC), (const char*)(ws + WS_VC), (const char*)((bf16_t*)(ws + WS_WC1) + (size_t)L * 2 * 256 * 2048)};
                    EpiCmp1 E{(bf16_t*)(ws + WS_HC), (const float*)(ws + WS_B1E) + L * 2 * 256};
                    pg8::gemm_phase<EpiCmp1, SchedCmp>(F.lds, g, S, E);
                }
                if (EN(4)) { LAUNDER;
                    asm volatile("s_waitcnt vmcnt(0)" ::: "memory"); __syncthreads();
                    __builtin_amdgcn_fence(__ATOMIC_ACQUIRE, "agent"); asm volatile("s_waitcnt vmcnt(0)" ::: "memory");
                    const bf16_t* HC = (const bf16_t*)(ws + WS_HC);
                    const int kv = F.wg >> 4, row0 = kv * 4096 + (F.wg & 15) * 256 + wave * 32, r32 = lane & 31, hi = lane >> 5;
                    const bf16_t* hrow = HC + (size_t)(row0 + r32) * 256 + hi * 8;
                    const bf16_t* wT = (const bf16_t*)(ws + WS_WC2) + (size_t)(L * 2 + kv) * 64 * 256 + (size_t)r32 * 256 + hi * 8;
                    f32x16 o0, o1;
#pragma unroll
                    for (int r = 0; r < 16; ++r) { o0[r] = 0.f; o1[r] = 0.f; }
#pragma unroll
                    for (int sk = 0; sk < 16; ++sk) { const bf16x8 bf = *(const bf16x8*)(hrow + 16 * sk), a0 = *(const bf16x8*)(wT + 16 * sk), a1 = *(const bf16x8*)(wT + 32 * 256 + 16 * sk);
                        o0 = mfma32(a0, bf, o0); o1 = mfma32(a1, bf, o1); }
                    if (kv == 0) { float ss = 0.f;
#pragma unroll
                        for (int r = 0; r < 16; ++r) ss += o0[r] * o0[r] + o1[r] * o1[r];
                        ss += __shfl_xor(ss, 32); const float rs = __builtin_amdgcn_rsqf(ss * (1.0f / 64.0f) + RMS_EPS); const float* gn = args.in[I_KN] + L * 192;
#pragma unroll
                        for (int r = 0; r < 16; ++r) { const int d = (r & 3) + 8 * (r >> 2) + 4 * hi; o0[r] *= rs * gn[d]; o1[r] *= rs * gn[d + 32]; } }
                    const int rr = (row0 + r32) & 4095; const float z = ((rr & 255) == 255) ? 0.f : 1.f;
                    bf16_t* dst = (bf16_t*)(ws + (kv ? WS_VCC : WS_KCC)) + (size_t)rr * 64 + 4 * hi;
#pragma unroll
                    for (int g4 = 0; g4 < 4; ++g4) { u32x2 v; v.x = pk2(o0[4 * g4] * z, o0[4 * g4 + 1] * z); v.y = pk2(o0[4 * g4 + 2] * z, o0[4 * g4 + 3] * z); *(u32x2*)(dst + 8 * g4) = v;
                        u32x2 w2; w2.x = pk2(o1[4 * g4] * z, o1[4 * g4 + 1] * z); w2.y = pk2(o1[4 * g4 + 2] * z, o1[4 * g4 + 3] * z); *(u32x2*)(dst + 32 + 8 * g4) = w2; }
                }
                if (L == 0 && EN(0)) { LAUNDER;
                    __syncthreads();
                    conv_blocks(args.in, ws, 1, false, (LAS float*)(F.lds + wave * 16384), gw, 32 * NWAVES, lane);
                }
            } else if (EN(6)) {
                { const int X = F.wg & 7, nW = (F.G - X + 7) >> 3, ne = nW - 4, jp = (F.wg >> 3) - 4;
                  dil_stream(F, L, X, jp, ne, min(DIL_EARLY, (384 - jp + ne - 1) / ne)); }
                __syncthreads();
            }
        }
        SEAM(pb + 2);
        if (IN(pb + 4)) {
            if (EN(5)) { LAUNDER;
                const int b = F.wg & 7, s = F.wg >> 3; const float* og = args.in[I_ONORM] + L * DM;
                for (int g = 0; g < 2; ++g) {
                    nsa_prepare(F, L, g);
                    for (int h = 0; h < 2; ++h) { const int i = h ? 63 - s : s;
                        nsa_unit(F, L, b, g, i);
                        if (g == 1) {
                            asm volatile("s_waitcnt vmcnt(0)" ::: "memory"); __syncthreads();
                            const int m0 = b * SEQ + 64 * i + wave * 8;
                            combine4(ws, og, lane, m0, 1); combine4(ws, og, lane, m0 + 4, 1);
                        } }
                }
            }
            if (EN(6)) for (int rep = 0; rep < NREP(6); ++rep) { const int X = F.wg & 7, nW = (F.G - X + 7) >> 3, q0 = (nW - 4) * DIL_EARLY + (F.wg >> 3); dil_stream(F, L, X, q0, nW, q0 < 384 ? (384 - q0 + nW - 1) / nW : 0); }
            __syncthreads();
        }
        SEAM_(pb + 4, 1);
        if (EN(8) && IN(pb + 6)) {
            pg8::Dims g{DM, DM, DM}; pg8::StaticOrder S; S.init(MTOK, DM, F.G, F.wg, ws + WS_U, (bf16_t*)(ws + WS_WO) + (size_t)L * DM * DM, DM, DM);
            if (L == 0) { EpiRes<true> E{args.in[I_X], HB, (const float*)(ws + WS_RA)}; for (int rep = 0; rep < NREP(8); ++rep) pg8::gemm_phase<EpiRes<true>, pg8::StaticOrder>(F.lds, g, S, E); }
            else { EpiRes<false> E{HB, HB, (const float*)(ws + WS_RA)}; pg8::gemm_phase<EpiRes<false>, pg8::StaticOrder>(F.lds, g, S, E); }
        }
        SEAM(pb + 6);
        if (EN(9) && IN(pb + 7)) { LAUNDER;
            bf16_t* U = (bf16_t*)(ws + WS_U); const float* gain = args.in[I_FNORM] + L * DM;
            if (L == 0) {
                for (int m = gw; m < MTOK; m += 16 * NGW) norm_rows_b<16, true>(HB, gain, U, m, NGW, lane);
            } else {
                LAS int* lcnt = (LAS int*)(F.lds);
                if (tid < 8) lcnt[tid] = 0;
                __syncthreads();
                const float* rw = args.in[I_RW];
                int* topE = (int*)(ws + RT_TOPE); float* topG = (float*)(ws + RT_TOPG);
                const int per = MTOK / F.G, perw = per / NWAVES;
                f32x4 rwa[16], rwb[16];
#pragma unroll
                for (int j = 0; j < 4; ++j)
#pragma unroll
                    for (int c = 0; c < 4; ++c) { const float* rr = rw + (size_t)(4 * lane + 256 * j + c) * 8; rwa[4 * j + c] = *(const f32x4*)rr; rwb[4 * j + c] = *(const f32x4*)(rr + 4); }
                f32x4 gg[4];
#pragma unroll
                for (int j = 0; j < 4; ++j) gg[j] = *(const f32x4*)(gain + 4 * lane + 256 * j);
                const int mbase = F.wg * per + wave * perw;
                u32x2 raw[2][4], nraw[2][4];
#pragma unroll
                for (int t2 = 0; t2 < 2; ++t2)
#pragma unroll
                    for (int j = 0; j < 4; ++j) { raw[t2][j] = *(const u32x2*)(HB + (size_t)(mbase + t2) * DM + 4 * lane + 256 * j); nraw[t2][j] = raw[t2][j]; }
#pragma unroll 1
                for (int q = 0; q < perw; q += 2) { const int m0 = mbase + q;
                    if (q + 2 < perw) {
#pragma unroll
                        for (int t2 = 0; t2 < 2; ++t2)
#pragma unroll
                            for (int j = 0; j < 4; ++j) nraw[t2][j] = *(const u32x2*)(HB + (size_t)(m0 + 2 + t2) * DM + 4 * lane + 256 * j); }
                    f32x4 v[2][4];
#pragma unroll
                    for (int t2 = 0; t2 < 2; ++t2) { float sq = 0.f;
#pragma unroll
                        for (int j = 0; j < 4; ++j) { const u32x2 a = raw[t2][j]; v[t2][j] = (f32x4){bflo(a.x), bfhi(a.x), bflo(a.y), bfhi(a.y)}; sq += (v[t2][j][0] * v[t2][j][0] + v[t2][j][1] * v[t2][j][1]) + (v[t2][j][2] * v[t2][j][2] + v[t2][j][3] * v[t2][j][3]); }
                        const float rstd = __builtin_amdgcn_rsqf(wave_sum(sq) * (1.0f / DM) + RMS_EPS);
                        unsigned char* orow = (unsigned char*)U + (size_t)(m0 + t2) * DM;
#pragma unroll
                        for (int j = 0; j < 4; ++j) { v[t2][j] = v[t2][j] * rstd * gg[j];
                            *(unsigned*)(orow + 4 * lane + 256 * j) = pk4_fp8(v[t2][j][0] * FP8_ASCALE, v[t2][j][1] * FP8_ASCALE, v[t2][j][2] * FP8_ASCALE, v[t2][j][3] * FP8_ASCALE); } }
                    float lg[2][8];
#pragma unroll
                    for (int t2 = 0; t2 < 2; ++t2)
#pragma unroll
                        for (int e = 0; e < 8; ++e) lg[t2][e] = 0.f;
#pragma unroll
                    for (int j = 0; j < 4; ++j)
#pragma unroll
                        for (int c = 0; c < 4; ++c) { const f32x4 r0 = rwa[4 * j + c], r1 = rwb[4 * j + c];
#pragma unroll
                            for (int t2 = 0; t2 < 2; ++t2) { const float x = v[t2][j][c];
                                lg[t2][0] += x * r0[0]; lg[t2][1] += x * r0[1]; lg[t2][2] += x * r0[2]; lg[t2][3] += x * r0[3]; lg[t2][4] += x * r1[0]; lg[t2][5] += x * r1[1]; lg[t2][6] += x * r1[2]; lg[t2][7] += x * r1[3]; } }
                    { float r8[8], r4[4], r2[2], r1;
                      const bool h5 = (lane & 32) != 0, h4 = (lane & 16) != 0, h3 = (lane & 8) != 0, h2 = (lane & 4) != 0;
#pragma unroll
                      for (int i = 0; i < 8; ++i) { const float lo = lg[0][i], hi2 = lg[1][i]; r8[i] = (h5 ? hi2 : lo) + __shfl_xor(h5 ? lo : hi2, 32); }
#pragma unroll
                      for (int i = 0; i < 4; ++i) r4[i] = (h4 ? r8[i + 4] : r8[i]) + __shfl_xor(h4 ? r8[i] : r8[i + 4], 16);
#pragma unroll
                      for (int i = 0; i < 2; ++i) r2[i] = (h3 ? r4[i + 2] : r4[i]) + __shfl_xor(h3 ? r4[i] : r4[i + 2], 8);
                      r1 = (h2 ? r2[1] : r2[0]) + __shfl_xor(h2 ? r2[0] : r2[1], 4);
                      r1 += __shfl_xor(r1, 2); r1 += __shfl_xor(r1, 1);
#pragma unroll
                      for (int t2 = 0; t2 < 2; ++t2)
#pragma unroll
                          for (int e = 0; e < 8; ++e) lg[t2][e] = __builtin_bit_cast(float, __builtin_amdgcn_readlane(__builtin_bit_cast(int, r1), (t2 * 8 + e) << 2)); }
#pragma unroll
                    for (int t2 = 0; t2 < 2; ++t2) { const int m = m0 + t2;
                        int e1 = 0; float l1 = lg[t2][0];
#pragma unroll
                        for (int e = 1; e < 8; ++e) if (lg[t2][e] > l1) { l1 = lg[t2][e]; e1 = e; }
                        int e2 = -1; float l2 = -3.0e38f;
#pragma unroll
                        for (int e = 0; e < 8; ++e) if (e != e1 && lg[t2][e] > l2) { l2 = lg[t2][e]; e2 = e; }
                        const float g2 = 1.0f / (1.0f + __expf(l1 - l2)), g1 = 1.0f - g2;
                        if (lane == 0) { topE[m * 2] = e1; topE[m * 2 + 1] = e2; topG[m * 2] = g1; topG[m * 2 + 1] = g2; __hip_atomic_fetch_add(&lcnt[e1], 1, __ATOMIC_RELAXED, __HIP_MEMORY_SCOPE_WORKGROUP); __hip_atomic_fetch_add(&lcnt[e2], 1, __ATOMIC_RELAXED, __HIP_MEMORY_SCOPE_WORKGROUP); } }
#pragma unroll
                    for (int t2 = 0; t2 < 2; ++t2)
#pragma unroll
                        for (int j = 0; j < 4; ++j) raw[t2][j] = nraw[t2][j];
                }
                __syncthreads();
                if (tid < 8) ((int*)(ws + RT_CNT))[F.wg * 8 + tid] = lcnt[tid];
            }
        }
        SEAM(pb + 7);
        if (L == 0) {
            if (EN(10) && IN(pb + 8)) {
                pg8::Dims g{DM, DM, DM}; pg8::StaticOrder S; S.init(MTOK, 2 * DFF, F.G, F.wg, ws + WS_U, ws + WS_WF1, DM, DM, 1);
                EpiSwigluF8 E{ws + WS_ACT0, DFF, 0};
                for (int rep = 0; rep < NREP(10); ++rep) pg8::gemm_phase_f8d<EpiSwigluF8, pg8::StaticOrder>(F.lds, g, S, E);
            }
            SEAM(pb + 8);
            if (EN(11) && IN(pb + 9)) {
                pg8::Dims g{DFF, DFF, DFF}; pg8::StaticOrder S; S.init(MTOK, DM, F.G, F.wg, ws + WS_ACT0, ws + WS_WF2, DFF, DFF, 1);
                EpiResF8 E{HB, (float*)(ws + WS_SS)};
                pg8::gemm_phase_f8d<EpiResF8, pg8::StaticOrder>(F.lds, g, S, E);
            }
            SEAM(pb + 9);
        }
    }
    if (EN(12) && IN(19)) { LAUNDER;
        LAS int* lc = (LAS int*)(F.lds);
        LAS int* mybase = lc + 2048;
        LAS int* wcnt = mybase + 8;
        LAS int* posl = wcnt + 32;
        const int* cnt = (const int*)(ws + RT_CNT);
        const int nwg = F.G;
        for (int k = tid; k < nwg * 8; k += NTHR) lc[k] = cnt[k];
        __syncthreads();
        if (tid < 8) { int tot = 0, before = 0; for (int w2 = 0; w2 < nwg; ++w2) { if (w2 == F.wg) before = tot; tot += lc[w2 * 8 + tid]; } wcnt[tid] = tot; mybase[tid] = before; }
        __syncthreads();
        if (tid == 0) { int ps = 0; int pst[9]; for (int e = 0; e < 8; ++e) { pst[e] = ps; ps += (wcnt[e] + 255) & ~255; } pst[8] = ps;
            for (int e = 0; e < 8; ++e) mybase[e] += pst[e];
            if (F.wg == 0) { int* P = (int*)(ws + RT_PSTART); for (int e = 0; e < 9; ++e) P[e] = pst[e]; P[9] = ps >> 8; } }
        __syncthreads();
        const int per = MTOK / F.G;
        const int* topE = (const int*)(ws + RT_TOPE); const float* topG = (const float*)(ws + RT_TOPG);
        int myE = -1, myTok = 0; float myG = 0.f; int rank = 0;
        if (tid < 2 * per) { myTok = F.wg * per + (tid >> 1); myE = topE[myTok * 2 + (tid & 1)]; myG = topG[myTok * 2 + (tid & 1)]; }
        if (wave < 4) {
#pragma unroll
            for (int e = 0; e < 8; ++e) { const unsigned long long bm = __ballot(myE == e); if (myE == e) rank = __popcll(bm & ((1ull << lane) - 1ull)); if (lane == 0) wcnt[wave * 8 + e] = __popcll(bm); }
        }
        __syncthreads();
        if (tid < 2 * per) { int pos = mybase[myE] + rank; for (int w2 = 0; w2 < wave; ++w2) pos += wcnt[w2 * 8 + myE];
            ((int*)(ws + RT_ROWTOK))[pos] = myTok; ((float*)(ws + RT_ROWGATE))[pos] = myG; posl[tid] = pos; ((int*)(ws + RT_TOKPOS))[myTok * 2 + (tid & 1)] = pos; }
        __syncthreads();
    }
    __syncthreads();
    if (EN(13) && IN(20)) { LAUNDER;
        LAS float* scr = (LAS float*)(F.lds + wave * 16384);
        for (int rep = 0; rep < NREPX(13); ++rep) conv_experts_f8(args.in[I_EG], args.in[I_EU], args.in[I_ED], ws + WS_WE1, ws + WS_WE2, scr, gw, NGW, lane);
    }
    SEAM(20);
    for (int gi = 0; gi < MOE_NG; ++gi) {
        const int* P = (const int*)(ws + RT_PSTART);
        if (EN(14) && IN(21 + 2 * gi)) {
            const int nchunks = __builtin_amdgcn_readfirstlane(P[9]);
            pg8::Dims g{DM, 2 * DM, DM}; SchedMoe1 S{F.wg, F.G, gi * MOE_GROUP, MOE_GROUP, nchunks, P, (const char*)(ws + WS_U), (const char*)(ws + WS_WE1), (const int*)(ws + RT_ROWTOK), {}}; S.load();
            EpiSwigluF8 E{(unsigned char*)args.out, DFE, gi * MOE_GROUP};
            for (int rep = 0; rep < NREPX(14); ++rep) pg8::gemm_phase_f8d<EpiSwigluF8, SchedMoe1, true>(F.lds, g, S, E);
        }
        SEAM(21 + 2 * gi);
        if (EN(15) && IN(22 + 2 * gi)) {
            const int nchunks = __builtin_amdgcn_readfirstlane(P[9]);
            { pg8::Dims g{DFE, DFE, DFE}; SchedMoe2 S{F.wg, F.G, gi * MOE_GROUP, MOE_GROUP, nchunks, P, (const char*)args.out, (const char*)(ws + WS_WE2), {}}; S.load();
              EpiMoe2F8 E{(bf16_t*)(ws + WS_VSORT), gi * MOE_GROUP};
              for (int rep = 0; rep < NREPX(15); ++rep) pg8::gemm_phase_f8d<EpiMoe2F8, SchedMoe2>(F.lds, g, S, E); }
            if (gi == MOE_NG - 1) { pg8::Dims g{DM, 2 * DM, DM}; SchedMoe1 S{F.wg, F.G, 256, nchunks - 256, nchunks, P, (const char*)(ws + WS_U), (const char*)(ws + WS_WE1), (const int*)(ws + RT_ROWTOK), {}}; S.load();
              EpiSwigluF8 E{ws + WS_TACT, DFE, 256};
              pg8::gemm_phase_f8d<EpiSwigluF8, SchedMoe1, true>(F.lds, g, S, E); }
        }
        SEAM(22 + 2 * gi);
    }
    if (EN(16) && IN(21 + 2 * MOE_NG)) {
        const int* P = (const int*)(ws + RT_PSTART); const int nchunks = __builtin_amdgcn_readfirstlane(P[9]), ntail = nchunks - 256, nmoe = 4 * ntail;
        if ((int)F.wg < nmoe) {
            pg8::Dims g{DFE, DFE, DFE}; SchedMoe2 S{F.wg, F.G, 256, ntail, nchunks, P, (const char*)(ws + WS_TACT), (const char*)(ws + WS_WE2), {}}; S.load();
            EpiMoe2F8 E{(bf16_t*)(ws + WS_VSORT), 256};
            pg8::gemm_phase_f8d<EpiMoe2F8, SchedMoe2>(F.lds, g, S, E);
        } else moe_combine(ws, args.out, (F.G - nmoe) * NWAVES, (F.wg - nmoe) * NWAVES, false);
    }
    SEAM(21 + 2 * MOE_NG);
    if (EN(16) && IN(22 + 2 * MOE_NG)) moe_combine(ws, args.out, F.G * NWAVES, F.wg * NWAVES, true);
#undef IN
#undef SEAM
}

constexpr int N_PHASES = 23 + 2 * MOE_NG;

extern "C" void kernel_launch(void* const* d_in, const int* in_sizes, int n_in, void* d_out, int out_size, void* d_ws, size_t ws_size, hipStream_t stream) {
    static int grid = 0;
    if (grid == 0) {
        if (n_in != 22 || out_size != MTOK * DM || ws_size < WS_END) { fprintf(stderr, "kernel_launch: unexpected shapes (n_in %d out %d ws %zu need %zu)\n", n_in, out_size, ws_size, (size_t)WS_END); grid = -1; return; }
        int dev = 0, cus = 0, per_cu = 0;
        if (hipGetDevice(&dev) != hipSuccess || hipDeviceGetAttribute(&cus, hipDeviceAttributeMultiprocessorCount, dev) != hipSuccess) { grid = -1; return; }
        if (hipFuncSetAttribute((const void*)trunk_fwd, hipFuncAttributeMaxDynamicSharedMemorySize, LDS_BYTES) != hipSuccess) { fprintf(stderr, "kernel_launch: hipFuncSetAttribute failed\n"); grid = -1; return; }
        if (hipOccupancyMaxActiveBlocksPerMultiprocessor(&per_cu, (const void*)trunk_fwd, NTHR, LDS_BYTES) != hipSuccess || per_cu < 1) fprintf(stderr, "kernel_launch: occupancy query reports %d\n", per_cu);
        (void)hipGetLastError();
        grid = cus;
        if (grid > 256) grid = 256;
        if (grid != 256 || MTOK % (grid * NWAVES) != 0) { fprintf(stderr, "kernel_launch: grid %d unsupported (the unit maps assume 256 workgroups)\n", grid); grid = -1; return; }
    }
    if (grid < 0) return;
    if (hipMemsetAsync((char*)d_ws + WS_CTL, 0, CTL_BYTES, stream) != hipSuccess) return;
    Args a{};
    for (int i = 0; i < 22; ++i) a.in[i] = (const float*)d_in[i];
    a.out = (float*)d_out; a.ws = (unsigned char*)d_ws; a.pad = 0;
#if MK_MULTI
    for (int p = 0; p < N_PHASES; ++p) { a.ph_lo = p; a.ph_hi = p + 1; a.li = 0; hipLaunchKernelGGL(trunk_fwd, dim3(grid), dim3(NTHR), LDS_BYTES, stream, a); }
#else
    a.ph_lo = 0; a.ph_hi = N_PHASES; a.li = 0;
    hipLaunchKernelGGL(trunk_fwd, dim3(grid), dim3(NTHR), LDS_BYTES, stream, a);
#endif
}
```
